# Optimizing an MI355X kernel written in HIP

```python
import math
import jax, jax.numpy as jnp
from jax import lax
import numpy as np

D_MODEL = 1024
BATCH = 8
SEQ = 4096
DEPTH = 2

CHUNK = 64
N_META = 16
Q_BLOCK = 128
EPS = 1e-6
N_BRANCH = 4

CONV_W = D_MODEL // 4
CONV_K = 3
MLSTM_HEADS = 4
MLSTM_HEAD_DIM = D_MODEL // 16
MLSTM_W = MLSTM_HEADS * MLSTM_HEAD_DIM
S5_GROUP_CH = 16
S5_W = D_MODEL // 4
S5_GROUPS = S5_W // S5_GROUP_CH
S5_STATE = 64
S5_DT_MIN = 1e-3
S5_DT_MAX = 1e-1
S5_C_SCALE = 0.5
MLA_HEADS = 8
MLA_NOPE = 64
MLA_ROPE = 32
MLA_V = 64
MLA_Q_LORA = 3 * D_MODEL // 8
MLA_KV_LORA = D_MODEL // 4
ROPE_THETA = 10000.0
MLA_W = MLA_HEADS * MLA_V

BRANCH_WIDTHS = (CONV_W, MLSTM_W, S5_W, MLA_W)
MIX_W = CONV_W + MLSTM_W + S5_W + MLA_W
D_FF = 4 * D_MODEL

IN_SPLITS = (
    N_BRANCH * D_MODEL,
    CONV_W, CONV_W, CONV_W,
    MLSTM_W, MLSTM_W, MLSTM_W, MLSTM_W,
    MLSTM_HEADS, MLSTM_HEADS,
    S5_W,
    MLA_Q_LORA, MLA_KV_LORA, MLA_ROPE,
)
IN_W = sum(IN_SPLITS)

kernel_name = "chunk_causal_gated_hybrid_encoder"


def rmsnorm(x, g):
    xf = x.astype(jnp.float32)
    var = jnp.mean(xf * xf, axis=-1, keepdims=True)
    return (xf * lax.rsqrt(var + EPS) * g.astype(jnp.float32)).astype(x.dtype)


def split_cols(h):
    parts, start = [], 0
    for w in IN_SPLITS:
        parts.append(h[..., start:start + w])
        start += w
    return parts


def apply_rope(x, cos, sin):
    xf = x.astype(jnp.float32)
    half = xf.shape[-1] // 2
    x1, x2 = xf[..., :half], xf[..., half:]
    return jnp.concatenate([x1 * cos - x2 * sin, x2 * cos + x1 * sin], axis=-1).astype(x.dtype)


def short_conv_mixer(b_gate, c_gate, val, conv_w):
    u = c_gate * val
    y = lax.conv_general_dilated(
        u, conv_w[:, None, :].astype(u.dtype), window_strides=(1,),
        padding=[(CONV_K - 1, 0)], dimension_numbers=("NWC", "WIO", "NWC"),
        feature_group_count=CONV_W)
    return b_gate * y


def mlstm_mixer(q, k, v, o, ig_pre, fg_pre, gate_b, norm_g):
    bsz, L, _ = q.shape
    H, d = MLSTM_HEADS, MLSTM_HEAD_DIM
    n_chunks = L // CHUNK
    f32 = jnp.float32
    qf = q.astype(f32).reshape(bsz, L, H, d)
    kf = k.astype(f32).reshape(bsz, L, H, d) * (d ** -0.5)
    vf = v.astype(f32).reshape(bsz, L, H, d)
    gb = gate_b.astype(f32)
    ig = ig_pre.astype(f32) + gb[:H]
    lf = jax.nn.log_sigmoid(fg_pre.astype(f32) + gb[H:])

    def to_chunks(t):
        return t.reshape(bsz, n_chunks, CHUNK, H, d).transpose(1, 0, 3, 2, 4)

    def gate_chunks(t):
        return t.reshape(bsz, n_chunks, CHUNK, H).transpose(1, 0, 3, 2)

    tril = jnp.tril(jnp.ones((CHUNK, CHUNK), dtype=bool))

    def step(carry, inp):
        C, n, m = carry
        qc, kc, vc, igc, lfc = inp
        b = jnp.cumsum(lfc, axis=-1)
        logw = b[..., :, None] - b[..., None, :] + igc[..., None, :]
        logw = jnp.where(tril, logw, -jnp.inf)
        inter = b + m[..., None]
        m_s = jnp.maximum(inter, jnp.max(logw, axis=-1))
        w_intra = jnp.exp(logw - m_s[..., None])
        w_inter = jnp.exp(inter - m_s)
        s = jnp.einsum("bhsd,bhrd->bhsr", qc, kc) * w_intra
        num = (jnp.einsum("bhsr,bhrd->bhsd", s, vc)
               + w_inter[..., None] * jnp.einsum("bhvk,bhsk->bhsv", C, qc))
        den = jnp.sum(s, axis=-1) + w_inter * jnp.einsum("bhsk,bhk->bhs", qc, n)
        h = num / jnp.maximum(jnp.abs(den), jnp.exp(-m_s))[..., None]
        b_last = b[..., -1]
        g = b_last[..., None] - b + igc
        m_new = jnp.maximum(b_last + m, jnp.max(g, axis=-1))
        wr = jnp.exp(g - m_new[..., None])
        decay = jnp.exp(b_last + m - m_new)
        C_new = decay[..., None, None] * C + jnp.einsum("bhr,bhrv,bhrk->bhvk", wr, vc, kc)
        n_new = decay[..., None] * n + jnp.einsum("bhr,bhrk->bhk", wr, kc)
        return (C_new, n_new, m_new), h

    init = (jnp.zeros((bsz, H, d, d), f32), jnp.zeros((bsz, H, d), f32), jnp.zeros((bsz, H), f32))
    _, hs = lax.scan(step, init, (to_chunks(qf), to_chunks(kf), to_chunks(vf),
                                  gate_chunks(ig), gate_chunks(lf)))
    h = hs.transpose(1, 0, 3, 2, 4).reshape(bsz, L, H, d)
    h = h * jax.nn.sigmoid(o.astype(f32).reshape(bsz, L, H, d))
    h = h * lax.rsqrt(jnp.mean(h * h, axis=-1, keepdims=True) + EPS)
    h = h.reshape(bsz, L, MLSTM_W) * norm_g.astype(f32)
    return h.astype(q.dtype)


def s5_mixer(u, a_re, a_im, log_step, b_re, b_im, c_re, c_im, d_skip, w_glu):
    bsz, L, _ = u.shape
    f32 = jnp.float32
    uf = u.astype(f32)
    a_re, a_im = a_re.astype(f32), a_im.astype(f32)
    b_re, b_im = b_re.astype(f32), b_im.astype(f32)
    dt = jnp.exp(log_step.astype(f32))[:, None]
    mag = jnp.exp(a_re * dt)
    lb_re, lb_im = mag * jnp.cos(a_im * dt), mag * jnp.sin(a_im * dt)
    den = a_re * a_re + a_im * a_im
    xr, xi = lb_re - 1.0, lb_im
    z_re = (xr * a_re + xi * a_im) / den
    z_im = (xi * a_re - xr * a_im) / den
    bb_re = z_re[..., None] * b_re - z_im[..., None] * b_im
    bb_im = z_re[..., None] * b_im + z_im[..., None] * b_re
    ug = uf.reshape(bsz, L, S5_GROUPS, S5_GROUP_CH)
    bu_re = jnp.einsum("blgh,gph->blgp", ug, bb_re)
    bu_im = jnp.einsum("blgh,gph->blgp", ug, bb_im)
    at_re = jnp.broadcast_to(lb_re, bu_re.shape)
    at_im = jnp.broadcast_to(lb_im, bu_im.shape)

    def combine(e1, e2):
        ar1, ai1, br1, bi1 = e1
        ar2, ai2, br2, bi2 = e2
        return (ar2 * ar1 - ai2 * ai1, ar2 * ai1 + ai2 * ar1,
                ar2 * br1 - ai2 * bi1 + br2, ar2 * bi1 + ai2 * br1 + bi2)

    _, _, s_re, s_im = lax.associative_scan(combine, (at_re, at_im, bu_re, bu_im), axis=1)
    y = (jnp.einsum("blgp,ghp->blgh", s_re, c_re.astype(f32))
         - jnp.einsum("blgp,ghp->blgh", s_im, c_im.astype(f32)))
    y = y.reshape(bsz, L, S5_W) + d_skip.astype(f32) * uf
    ag = y @ w_glu.astype(f32)
    out = ag[..., :S5_W] * jax.nn.sigmoid(ag[..., S5_W:])
    return out.astype(u.dtype)


def mla_mixer(cq, ckv, kr, q_norm, kv_norm, w_uq, w_ukv, cos, sin, cid):
    bsz, L, _ = cq.shape
    H = MLA_HEADS
    q = (rmsnorm(cq, q_norm) @ w_uq).reshape(bsz, L, H, MLA_NOPE + MLA_ROPE)
    qn = q[..., :MLA_NOPE]
    qr = apply_rope(q[..., MLA_NOPE:], cos[None, :, None, :], sin[None, :, None, :])
    kv = (rmsnorm(ckv, kv_norm) @ w_ukv).reshape(bsz, L, H, MLA_NOPE + MLA_V)
    kn, v = kv[..., :MLA_NOPE], kv[..., MLA_NOPE:]
    krr = apply_rope(kr, cos[None], sin[None])
    scale = (MLA_NOPE + MLA_ROPE) ** -0.5
    nb = L // Q_BLOCK
    qnb = qn.reshape(bsz, nb, Q_BLOCK, H, MLA_NOPE).transpose(1, 0, 2, 3, 4)
    qrb = qr.reshape(bsz, nb, Q_BLOCK, H, MLA_ROPE).transpose(1, 0, 2, 3, 4)
    cidb = cid.reshape(nb, Q_BLOCK)

    def attend(blk):
        qn_b, qr_b, cq_b = blk
        s = (jnp.einsum("bqhd,bkhd->bhqk", qn_b, kn, preferred_element_type=jnp.float32)
             + jnp.einsum("bqhr,bkr->bhqk", qr_b, krr, preferred_element_type=jnp.float32)) * scale
        mask = cid[None, :] <= cq_b[:, None]
        p = jax.nn.softmax(jnp.where(mask, s, -jnp.inf), axis=-1).astype(v.dtype)
        return jnp.einsum("bhqk,bkhd->bqhd", p, v)

    o = lax.map(attend, (qnb, qrb, cidb))
    return o.transpose(1, 0, 2, 3, 4).reshape(bsz, L, MLA_W)


def hybrid_layer(h, cid, cos, sin, norm_g, w_in, conv_w, gate_b, m_norm, a_re, a_im, log_step,
                 b_re, b_im, c_re, c_im, d_skip, w_glu, q_norm, kv_norm, w_uq, w_ukv,
                 w_branch, w_out, w1, w2):
    bsz, L, D = h.shape
    hn = rmsnorm(h, norm_g[0])
    (gate_pre, cb, cc, cv, mq, mk, mv, mo, mi, mf, su, cq, ckv, kr) = split_cols(hn @ w_in)
    gates = jax.nn.sigmoid(gate_pre).reshape(bsz, L, N_BRANCH, D)
    ys = (short_conv_mixer(cb, cc, cv, conv_w),
          mlstm_mixer(mq, mk, mv, mo, mi, mf, gate_b, m_norm),
          s5_mixer(su, a_re, a_im, log_step, b_re, b_im, c_re, c_im, d_skip, w_glu),
          mla_mixer(cq, ckv, kr, q_norm, kv_norm, w_uq, w_ukv, cos, sin, cid))
    start = 0
    merged = None
    for bi in range(N_BRANCH):
        w = BRANCH_WIDTHS[bi]
        term = gates[:, :, bi] * (ys[bi] @ w_branch[start:start + w])
        start += w
        merged = term if merged is None else merged + term
    h = h + rmsnorm(merged @ w_out, norm_g[1])
    hn = rmsnorm(h, norm_g[2])
    ff = jnp.square(jax.nn.relu(hn @ w1)) @ w2
    return h + rmsnorm(ff, norm_g[3])


def setup_inputs(seed: int = 0) -> dict:
    key = jax.random.key(seed)
    ks = jax.random.split(key, 24)
    f32 = jnp.float32

    def nrm(k, shape, scale):
        return jax.random.normal(k, shape, f32) * scale

    H, G, P, Hg = MLSTM_HEADS, S5_GROUPS, S5_STATE, S5_GROUP_CH
    x = nrm(ks[0], (BATCH, SEQ, D_MODEL), 1.0)
    meta = nrm(ks[1], (N_META, D_MODEL), 1.0)
    norm_gains = 1.0 + nrm(ks[2], (DEPTH, 4, D_MODEL), 0.05)
    w_in = nrm(ks[3], (DEPTH, D_MODEL, IN_W), D_MODEL ** -0.5)
    conv_w = nrm(ks[4], (DEPTH, CONV_K, CONV_W), CONV_K ** -0.5)
    gate_base = jnp.concatenate([jnp.zeros((H,), f32), jnp.linspace(3.0, 6.0, H, dtype=f32)])
    mlstm_gate_b = gate_base + nrm(ks[5], (DEPTH, 2 * H), 0.1)
    mlstm_norm = 1.0 + nrm(ks[6], (DEPTH, MLSTM_W), 0.05)
    s5_a_re = -0.5 + nrm(ks[7], (DEPTH, G, P), 0.01)
    s5_a_im = math.pi * jnp.arange(P, dtype=f32) + nrm(ks[8], (DEPTH, G, P), 0.01)
    s5_log_step = jax.random.uniform(ks[9], (DEPTH, G), f32, math.log(S5_DT_MIN), math.log(S5_DT_MAX))
    s5_b_re = nrm(ks[10], (DEPTH, G, P, Hg), (2 * Hg) ** -0.5)
    s5_b_im = nrm(ks[11], (DEPTH, G, P, Hg), (2 * Hg) ** -0.5)
    s5_c_re = nrm(ks[12], (DEPTH, G, Hg, P), S5_C_SCALE)
    s5_c_im = nrm(ks[13], (DEPTH, G, Hg, P), S5_C_SCALE)
    s5_d = nrm(ks[14], (DEPTH, S5_W), 0.5)
    s5_glu = nrm(ks[15], (DEPTH, S5_W, 2 * S5_W), S5_W ** -0.5)
    mla_q_norm = 1.0 + nrm(ks[16], (DEPTH, MLA_Q_LORA), 0.05)
    mla_kv_norm = 1.0 + nrm(ks[17], (DEPTH, MLA_KV_LORA), 0.05)
    mla_w_uq = nrm(ks[18], (DEPTH, MLA_Q_LORA, MLA_HEADS * (MLA_NOPE + MLA_ROPE)), MLA_Q_LORA ** -0.5)
    mla_w_ukv = nrm(ks[19], (DEPTH, MLA_KV_LORA, MLA_HEADS * (MLA_NOPE + MLA_V)), MLA_KV_LORA ** -0.5)
    bks = jax.random.split(ks[20], N_BRANCH)
    w_branch = jnp.concatenate(
        [nrm(bks[i], (DEPTH, BRANCH_WIDTHS[i], D_MODEL), BRANCH_WIDTHS[i] ** -0.5) for i in range(N_BRANCH)],
        axis=1)
    w_out = nrm(ks[21], (DEPTH, D_MODEL, D_MODEL), D_MODEL ** -0.5)
    mlp_w1 = nrm(ks[22], (DEPTH, D_MODEL, D_FF), D_MODEL ** -0.5)
    mlp_w2 = nrm(ks[23], (DEPTH, D_FF, D_MODEL), D_FF ** -0.5)
    return {"x": x, "meta": meta, "norm_gains": norm_gains, "w_in": w_in, "conv_w": conv_w,
            "mlstm_gate_b": mlstm_gate_b, "mlstm_norm": mlstm_norm,
            "s5_a_re": s5_a_re, "s5_a_im": s5_a_im, "s5_log_step": s5_log_step,
            "s5_b_re": s5_b_re, "s5_b_im": s5_b_im, "s5_c_re": s5_c_re, "s5_c_im": s5_c_im,
            "s5_d": s5_d, "s5_glu": s5_glu, "mla_q_norm": mla_q_norm, "mla_kv_norm": mla_kv_norm,
            "mla_w_uq": mla_w_uq, "mla_w_ukv": mla_w_ukv, "w_branch": w_branch, "w_out": w_out,
            "mlp_w1": mlp_w1, "mlp_w2": mlp_w2}


def reference(x, meta, norm_gains, w_in, conv_w, mlstm_gate_b, mlstm_norm, s5_a_re, s5_a_im,
              s5_log_step, s5_b_re, s5_b_im, s5_c_re, s5_c_im, s5_d, s5_glu, mla_q_norm,
              mla_kv_norm, mla_w_uq, mla_w_ukv, w_branch, w_out, mlp_w1, mlp_w2):
    bsz, S, D = x.shape
    L = S + N_META
    Lp = ((L + Q_BLOCK - 1) // Q_BLOCK) * Q_BLOCK
    h = jnp.concatenate([
        jnp.broadcast_to(meta.astype(x.dtype)[None], (bsz, N_META, D)),
        x,
        jnp.zeros((bsz, Lp - L, D), x.dtype)], axis=1)
    pos = jnp.arange(Lp)
    cid = (pos + CHUNK - N_META) // CHUNK
    inv_freq = ROPE_THETA ** (-jnp.arange(0, MLA_ROPE, 2, dtype=jnp.float32) / MLA_ROPE)
    ang = pos.astype(jnp.float32)[:, None] * inv_freq[None, :]
    cos, sin = jnp.cos(ang), jnp.sin(ang)
    for l in range(DEPTH):
        h = hybrid_layer(h, cid, cos, sin, norm_gains[l], w_in[l], conv_w[l], mlstm_gate_b[l],
                         mlstm_norm[l], s5_a_re[l], s5_a_im[l], s5_log_step[l], s5_b_re[l],
                         s5_b_im[l], s5_c_re[l], s5_c_im[l], s5_d[l], s5_glu[l], mla_q_norm[l],
                         mla_kv_norm[l], mla_w_uq[l], mla_w_ukv[l], w_branch[l], w_out[l],
                         mlp_w1[l], mlp_w2[l])
    return h[:, N_META:N_META + S]
```

```cpp
#include <hip/hip_runtime.h>
#include <hip/hip_cooperative_groups.h>
#include <cstdio>
namespace cg = cooperative_groups;

typedef unsigned short u16;
typedef unsigned char u8;
using bf16x8 = __attribute__((ext_vector_type(8))) short;
using s16x4 = __attribute__((ext_vector_type(4))) short;
using f32x4 = __attribute__((ext_vector_type(4))) float;
using f32x16 = __attribute__((ext_vector_type(16))) float;
using u32x4 = __attribute__((ext_vector_type(4))) unsigned;
using u32x2 = __attribute__((ext_vector_type(2))) unsigned;
#define DEVI __device__ __forceinline__

constexpr int DM = 1024, SEQ = 4096, NB = 8, NMETA = 16;
constexpr int MROWS = 33024, NREAL = 32768, METAROW = 32768;
constexpr int NIN = 6912, NREST = 2816, INW = 6824;
constexpr int RC_CB = 0, RC_CC = 256, RC_CV = 512, RC_MQ = 768, RC_MK = 1024, RC_MV = 1280, RC_MO = 1536, RC_SU = 1792,
              RC_CQ = 2048, RC_CKV = 2432, RC_KR = 2688, RC_MI = 2720;
constexpr float EPS = 1e-6f;
constexpr int NCH = 65;

constexpr size_t al256(size_t x) { return (x + 255) & ~(size_t)255; }
constexpr size_t WS_CTL = 0;
constexpr size_t WS_W = 32768;
constexpr size_t W_IN = 0, W_UQ = W_IN + (size_t)NIN * 1024 * 2, W_UKV = W_UQ + 768 * 384 * 2, W_GLU = W_UKV + 1024 * 256 * 2,
                 W_BR = W_GLU + 512 * 256 * 2, W_OUT = W_BR + 1024 * 1280 * 2, W_1 = W_OUT + 1024 * 1024 * 2, W_2 = W_1 + 4096 * 1024 * 2,
                 W_END = W_2 + 4096 * 1024 * 2;
constexpr size_t WS_GATES = al256(WS_W + W_END);
constexpr size_t WS_REST = al256(WS_GATES + (size_t)MROWS * 4096);
constexpr size_t WS_HB = al256(WS_REST + (size_t)MROWS * NREST * 2);
constexpr size_t WS_KN = al256(WS_HB + (size_t)MROWS * 1024 * 2);
constexpr size_t WS_KR = al256(WS_KN + (size_t)MROWS * 512 * 2);
constexpr size_t WS_VT = al256(WS_KR + (size_t)MROWS * 32 * 2);
constexpr size_t WS_RS = al256(WS_VT + (size_t)MROWS * 512 * 2);
constexpr size_t WS_HM = al256(WS_RS + (size_t)MROWS * 4);
constexpr size_t WS_S5 = al256(WS_HM + (size_t)256 * 1024 * 4);
constexpr size_t WS_ROPE = al256(WS_S5 + (size_t)(NB * NCH + 1) * 16 * 128 * 4);
constexpr size_t WS_GP = al256(WS_ROPE + (size_t)4112 * 16 * 8);
constexpr size_t WS_MSUM = al256(WS_GP + (size_t)MROWS * 8 * 4 + (size_t)MROWS * 20 * 4);
constexpr size_t WS_MSC = al256(WS_MSUM + (size_t)32 * NCH * 4160 * 2);
constexpr size_t WS_END = al256(WS_MSC + (size_t)32 * NCH * 4 * 4);
constexpr size_t WS_Q = WS_HB;
constexpr size_t WS_MERGED = WS_KN;
constexpr size_t WS_YOUT = WS_GATES;
constexpr size_t WS_FF1 = WS_GATES;
static_assert(WS_RS - WS_KN >= (size_t)MROWS * 1024 * 2, "merged alias");
static_assert(WS_HB - WS_GATES >= (size_t)MROWS * 4096 * 2, "ff1 alias");

constexpr int LDS_BYTES = 147456;
constexpr int LDS_MISC = 131072;

struct Params {
  const float* in[24];
  float* out;
  unsigned char* ws;
};
typedef const __attribute__((address_space(4))) Params& PRef;
DEVI const __attribute__((address_space(4))) Params* kparams() { auto k = __builtin_amdgcn_kernarg_segment_ptr(); asm volatile("" : "+s"(k)); return (const __attribute__((address_space(4))) Params*)k; }
enum { I_X = 0, I_META, I_NG, I_WIN, I_CONVW, I_GATEB, I_MNORM, I_ARE, I_AIM, I_LSTEP, I_BRE, I_BIM, I_CRE, I_CIM, I_SD, I_GLU,
       I_QN, I_KVN, I_WUQ, I_WUKV, I_WBR, I_WOUT, I_W1, I_W2 };

typedef __bf16 bf16x2_t __attribute__((ext_vector_type(2)));
DEVI unsigned cvtpk(float lo, float hi) { bf16x2_t v = {(__bf16)lo, (__bf16)hi}; return __builtin_bit_cast(unsigned, v); }
DEVI unsigned cvtpk_v(float lo, float hi) { unsigned r; asm volatile("v_cvt_pk_bf16_f32 %0, %1, %2\n\ts_nop 1" : "=v"(r) : "v"(lo), "v"(hi)); return r; }
DEVI u16 f2b(float f) { return (u16)(cvtpk(f, f) & 0xffffu); }
DEVI float b2f(u16 b) { return __uint_as_float(((unsigned)b) << 16); }
DEVI unsigned pack2(float a, float b) { return cvtpk(a, b); }
DEVI float blo(unsigned u) { return __uint_as_float(u << 16); }
DEVI float bhi(unsigned u) { return __uint_as_float(u & 0xffff0000u); }
DEVI float sigm(float x) { return __builtin_amdgcn_rcpf(1.f + __builtin_amdgcn_exp2f(-1.4426950408889634f * x)); }
DEVI float wave_sum(float v) { for (int o = 32; o > 0; o >>= 1) v += __shfl_xor(v, o); return v; }
DEVI int opaque_tid() { int t = threadIdx.x; asm volatile("" : "+v"(t)); return t; }
DEVI unsigned char* opq(unsigned char* p) { asm volatile("" : "+s"(p)); return p; }
DEVI int row_pos(int row) { return row < NREAL ? NMETA + (row & (SEQ - 1)) : row - METAROW; }

#define LAS __attribute__((address_space(3)))
constexpr int BM = 256, BK = 64, HALF = 128, HTB = HALF * BK * 2, NXCD = 8, WGM = 8;
DEVI int lds_byte(int r, int c) { const int st = (r >> 4) * 2 + (c >> 5), rr = r & 15, cc = c & 31, ob = rr * 64 + cc * 2; return st * 1024 + (ob ^ (((ob >> 9) & 1) << 5)); }
DEVI void stage_rc(int b, int& R, int& C) { const int st = b / 1024, sb = b % 1024, swz = sb ^ (((sb >> 9) & 1) << 5); R = (st >> 1) * 16 + swz / 64; C = (st & 1) * 32 + (swz % 64) / 2; }
DEVI int perm32(int rho) { const int n = rho >> 4, i = rho & 15; return 8 * (i >> 2) + 4 * n + (i & 3); }
struct Unit { int pm, pn; };
struct Gemm { const u16* A; const u16* Bt; int lda, ldb, K; };
struct StaticOrder {
  int nM, nN, nwg, G, c;
  DEVI void init(int nM_, int nN_, int G_, int c_) { nM = nM_; nN = nN_; nwg = nM * nN; G = G_; c = c_; }
  DEVI bool next(int i, Unit& u) const {
    const long L = (long)i * G + c; if (L >= nwg) return false;
    int wgid = (int)L; { const int q = nwg / NXCD, r = nwg % NXCD, xcd = wgid % NXCD, off = wgid / NXCD; wgid = (xcd < r ? xcd * (q + 1) : r * (q + 1) + (xcd - r) * q) + off; }
    const int nig = WGM * nN, gid = wgid / nig, fm = gid * WGM, gsz = (nM - fm) < WGM ? (nM - fm) : WGM;
    u.pm = fm + ((wgid % nig) % gsz); u.pn = (wgid % nig) / gsz; return true;
  }
};
template <class Epi>
DEVI void gemm_phase(LAS unsigned char* lds, const Gemm g, const StaticOrder& S, const Epi& E) { const int TX = opaque_tid();
  const int tid = TX, wid = __builtin_amdgcn_readfirstlane(tid >> 6), lane = tid & 63, wr = wid >> 2, wc = wid & 3, fr = lane & 15, fq = lane >> 4;
  int K = g.K; asm volatile("" : "+s"(K));
  const int nt = K / BK;
  unsigned voffA[2], voffB[2];
#pragma unroll
  for (int i = 0; i < 2; ++i) { int R, C; stage_rc(tid * 16 + i * 8192, R, C); const int Rb = (R & ~31) + perm32(R & 31);
    voffA[i] = (unsigned)(R * g.lda + C) * 2u; voffB[i] = (unsigned)(Rb * g.ldb + C) * 2u; }
  const size_t kstep = (size_t)(BK * 2);
  const size_t hstepA = (size_t)HALF * g.lda * 2, hstepB = (size_t)HALF * g.ldb * 2;
  const unsigned ldsw = (unsigned)wid * 1024u;
  const int aoff = lds_byte(wr * 64 + fr, fq * 8), boff = lds_byte(wc * 32 + fr, fq * 8);
#define PG8_SA(b, h) (((b) * 2 + (h)) * HTB)
#define PG8_SB(b, h) ((4 + (b) * 2 + (h)) * HTB)
#define PG8_STAGE(bufoff, gbase, voff) do { _Pragma("unroll") for (int _i = 0; _i < 2; ++_i) \
    __builtin_amdgcn_global_load_lds((const unsigned*)((const char*)(gbase) + (voff)[_i]), (LAS unsigned*)(lds + (bufoff) + ldsw + _i * 8192), 16, 0, 0); } while (0)
#define PG8_LDA(dst, b, h) do { _Pragma("unroll") for (int m = 0; m < 4; ++m) _Pragma("unroll") for (int k = 0; k < 2; ++k) dst[m][k] = *(const LAS bf16x8*)(lds + PG8_SA(b, h) + aoff + m * 2048 + k * 1024); } while (0)
#define PG8_LDB(dst, b, h) do { _Pragma("unroll") for (int n = 0; n < 2; ++n) _Pragma("unroll") for (int k = 0; k < 2; ++k) dst[n][k] = *(const LAS bf16x8*)(lds + PG8_SB(b, h) + boff + n * 2048 + k * 1024); } while (0)
#define PG8_MMA(ai, bj, At, Bt) do { __builtin_amdgcn_s_setprio(1); _Pragma("unroll") for (int m = 0; m < 4; ++m) _Pragma("unroll") for (int n = 0; n < 2; ++n) _Pragma("unroll") for (int k = 0; k < 2; ++k) \
    acc[ai][bj][m][n] = __builtin_amdgcn_mfma_f32_16x16x32_bf16(Bt[n][k], At[m][k], acc[ai][bj][m][n], 0, 0, 0); __builtin_amdgcn_s_setprio(0); } while (0)
#define PG8_WAIT_V(n) asm volatile("s_waitcnt vmcnt(" #n ")" ::: "memory")
#define PG8_WAIT_L(n) asm volatile("s_waitcnt lgkmcnt(" #n ")" ::: "memory")
#define PG8_BAR __builtin_amdgcn_s_barrier()
#define PG8_SCHED __builtin_amdgcn_sched_barrier(0)
  Unit cur, nxt; int ui = 0;
  if (!S.next(0, cur)) return;
  f32x4 acc[2][2][4][2];
#pragma unroll
  for (int a = 0; a < 2; ++a)
#pragma unroll
    for (int b = 0; b < 2; ++b)
#pragma unroll
      for (int m = 0; m < 4; ++m)
#pragma unroll
        for (int n = 0; n < 2; ++n) acc[a][b][m][n] = (f32x4){0.f, 0.f, 0.f, 0.f};
  bf16x8 At[4][2], B0[2][2], B1[2][2];
  const char* cA = (const char*)g.A + (size_t)cur.pm * 2 * hstepA; const char* cB = (const char*)g.Bt + (size_t)cur.pn * 2 * hstepB;
  PG8_STAGE(PG8_SB(0, 0), cB, voffB); PG8_STAGE(PG8_SA(0, 0), cA, voffA); PG8_STAGE(PG8_SB(0, 1), cB + hstepB, voffB); PG8_STAGE(PG8_SA(0, 1), cA + hstepA, voffA);
  if (wr == 1) PG8_BAR;
  PG8_WAIT_V(4); PG8_BAR;
  PG8_STAGE(PG8_SB(1, 0), cB + kstep, voffB); PG8_STAGE(PG8_SA(1, 0), cA + kstep, voffA); PG8_STAGE(PG8_SB(1, 1), cB + hstepB + kstep, voffB);
  PG8_WAIT_V(6); PG8_BAR;
  for (;;) {
    const bool has_next = S.next(ui + 1, nxt);
    const char* nA = has_next ? (const char*)g.A + (size_t)nxt.pm * 2 * hstepA : cA; const char* nB = has_next ? (const char*)g.Bt + (size_t)nxt.pn * 2 * hstepB : cB;
#pragma nounroll
    for (int t = 0; t < nt; t += 2) {
      const bool last = (t == nt - 2);
      const char* a1 = cA + (size_t)(t + 1) * kstep;
      const char* a2 = last ? nA : cA + (size_t)(t + 2) * kstep; const char* b2 = last ? nB : cB + (size_t)(t + 2) * kstep;
      const char* a3 = a2 + kstep; const char* b3 = b2 + kstep;
      PG8_LDB(B0, 0, 0); PG8_SCHED; PG8_LDA(At, 0, 0); PG8_STAGE(PG8_SA(1, 1), a1 + hstepA, voffA);
      PG8_WAIT_L(8); PG8_BAR; PG8_WAIT_L(0); PG8_MMA(0, 0, At, B0); PG8_BAR; PG8_SCHED;
      PG8_LDB(B1, 0, 1); PG8_STAGE(PG8_SB(0, 0), b2, voffB);
      PG8_BAR; PG8_WAIT_L(0); PG8_MMA(0, 1, At, B1); PG8_BAR;
      PG8_LDA(At, 0, 1); PG8_STAGE(PG8_SA(0, 0), a2, voffA);
      PG8_BAR; PG8_WAIT_L(0); PG8_MMA(1, 0, At, B0); PG8_BAR; PG8_SCHED;
      PG8_STAGE(PG8_SB(0, 1), b2 + hstepB, voffB);
      PG8_WAIT_V(6); PG8_BAR; PG8_MMA(1, 1, At, B1); PG8_BAR;
      PG8_LDB(B0, 1, 0); PG8_SCHED; PG8_LDA(At, 1, 0); PG8_STAGE(PG8_SA(0, 1), a2 + hstepA, voffA);
      PG8_WAIT_L(8); PG8_BAR; PG8_WAIT_L(0); PG8_MMA(0, 0, At, B0); PG8_BAR; PG8_SCHED;
      PG8_LDB(B1, 1, 1); PG8_STAGE(PG8_SB(1, 0), b3, voffB);
      PG8_BAR; PG8_WAIT_L(0); PG8_MMA(0, 1, At, B1); PG8_BAR;
      PG8_LDA(At, 1, 1); PG8_STAGE(PG8_SA(1, 0), a3, voffA);
      PG8_BAR; PG8_WAIT_L(0); PG8_MMA(1, 0, At, B0); PG8_BAR; PG8_SCHED;
      PG8_STAGE(PG8_SB(1, 1), b3 + hstepB, voffB);
      PG8_WAIT_V(6); PG8_BAR; PG8_MMA(1, 1, At, B1); PG8_BAR;
    }
    E(acc, cur, wr, wc, fr, fq);
    if (!has_next) break;
#pragma unroll
    for (int a = 0; a < 2; ++a)
#pragma unroll
      for (int b = 0; b < 2; ++b)
#pragma unroll
        for (int m = 0; m < 4; ++m)
#pragma unroll
          for (int n = 0; n < 2; ++n) acc[a][b][m][n] = (f32x4){0.f, 0.f, 0.f, 0.f};
    cur = nxt; cA = nA; cB = nB; ++ui;
  }
  PG8_WAIT_V(0);
  if (wr == 0) PG8_BAR;
  PG8_BAR;
#undef PG8_SA
#undef PG8_SB
#undef PG8_STAGE
#undef PG8_LDA
#undef PG8_LDB
#undef PG8_MMA
#undef PG8_WAIT_V
#undef PG8_WAIT_L
#undef PG8_BAR
#undef PG8_SCHED
}
typedef const f32x4 (&AccRef)[2][2][4][2];
DEVI unsigned cvtpk_e(float lo, float hi) { unsigned r; asm volatile("v_cvt_pk_bf16_f32 %0, %1, %2" : "=v"(r) : "v"(lo), "v"(hi)); return r; }
#define EPI_ROWS(...) _Pragma("unroll") for (int ai = 0; ai < (THIN ? 1 : 2); ++ai) _Pragma("unroll") for (int m = 0; m < (THIN ? 1 : 4); ++m) { const int row = u.pm * 256 + ai * 128 + wr * 64 + m * 16 + fr; __VA_ARGS__ }

template <int MAPT> DEVI int cmap(int n) {
  if (MAPT == 1) {
    if (n < 4096 + 1792) return n;
    int rc = n - 4096;
    if (rc < 2720) return 5896 + (rc - 1792);
    if (rc < 2728) return 5888 + (rc - 2720);
    return -1;
  } else if (MAPT == 2) {
    int nt = n >> 8, r = n & 255;
    return r < 128 ? nt * 128 + r : 256 + nt * 128 + (r - 128);
  }
  return n;
}
template <int MAPT> DEVI void prep_matrix(float* tile, const float* src, int K, int Nsrc, int Ndst, const float* g, u16* dst) { const int TX = opaque_tid();
  const int tk = K / 64, tn = Ndst / 64, tid = TX, ntile = tk * tn;
  float v[8];
  auto ld = [&](int t) { const int k0 = (t % tk) * 64, n0 = (t / tk) * 64;
    for (int i = 0; i < 8; ++i) { int idx = tid + i * 512, kk = idx >> 6, nn = idx & 63; int sc = cmap<MAPT>(n0 + nn);
      float x = sc >= 0 ? src[(size_t)(k0 + kk) * Nsrc + sc] : 0.f; if (g) x *= g[k0 + kk]; v[i] = x; } };
  int t = blockIdx.x;
  if (t < ntile) ld(t);
  for (; t < ntile; t += gridDim.x) {
    const int k0 = (t % tk) * 64, n0 = (t / tk) * 64;
    __syncthreads();
    for (int i = 0; i < 8; ++i) { int idx = tid + i * 512, kk = idx >> 6, nn = idx & 63; tile[kk * 65 + nn] = v[i]; }
    __syncthreads();
    if (t + (int)gridDim.x < ntile) ld(t + gridDim.x);
    { int nn = tid >> 3, k8 = (tid & 7) * 8; u32x4 o;
      for (int j = 0; j < 4; ++j) o[j] = pack2(tile[(k8 + 2 * j) * 65 + nn], tile[(k8 + 2 * j + 1) * 65 + nn]);
      *(u32x4*)(dst + (size_t)(n0 + nn) * K + k0 + k8) = o; }
  }
}
DEVI void prep_layer(PRef p, int l, float* tile) { unsigned char* const wsb = opq(p.ws);
  u16* W = (u16*)(wsb + WS_W);
  const float* ng = p.in[I_NG] + (size_t)l * 4 * DM;
  prep_matrix<1>(tile, p.in[I_WIN] + (size_t)l * DM * INW, 1024, INW, NIN, ng, W + W_IN / 2);
  prep_matrix<0>(tile, p.in[I_W1] + (size_t)l * DM * 4096, 1024, 4096, 4096, ng + 2 * DM, W + W_1 / 2);
  prep_matrix<0>(tile, p.in[I_W2] + (size_t)l * DM * 4096, 4096, 1024, 1024, nullptr, W + W_2 / 2);
  prep_matrix<0>(tile, p.in[I_WBR] + (size_t)l * 1280 * DM, 1280, 1024, 1024, nullptr, W + W_BR / 2);
  prep_matrix<0>(tile, p.in[I_WOUT] + (size_t)l * DM * DM, 1024, 1024, 1024, nullptr, W + W_OUT / 2);
  prep_matrix<0>(tile, p.in[I_WUQ] + (size_t)l * 384 * 768, 384, 768, 768, p.in[I_QN] + l * 384, W + W_UQ / 2);
  prep_matrix<0>(tile, p.in[I_WUKV] + (size_t)l * 256 * 1024, 256, 1024, 1024, p.in[I_KVN] + l * 256, W + W_UKV / 2);
  prep_matrix<2>(tile, p.in[I_GLU] + (size_t)l * 256 * 512, 256, 512, 512, nullptr, W + W_GLU / 2);
}

DEVI void phase0_act(PRef p) { const int TX = opaque_tid(); unsigned char* const wsb = opq(p.ws);
  const int lane = TX & 63, gw = blockIdx.x * 8 + (TX >> 6), NW = gridDim.x * 8;
  u16* hb = (u16*)(wsb + WS_HB); float* rs = (float*)(wsb + WS_RS); float* hm = (float*)(wsb + WS_HM);
  for (int row = gw; row < NREAL + NMETA; row += NW) {
    const float* src = row < NREAL ? p.in[I_X] + (size_t)row * DM : (row < METAROW + NMETA ? p.in[I_META] + (size_t)(row - METAROW) * DM : nullptr);
    float ss = 0.f;
    for (int i = 0; i < 4; ++i) {
      f32x4 v = src ? *(const f32x4*)(src + i * 256 + lane * 4) : (f32x4){0.f, 0.f, 0.f, 0.f};
      ss += v[0] * v[0] + v[1] * v[1] + v[2] * v[2] + v[3] * v[3];
      u32x2 o; o[0] = pack2(v[0], v[1]); o[1] = pack2(v[2], v[3]);
      *(u32x2*)(hb + (size_t)row * DM + i * 256 + lane * 4) = o;
      if (row >= NREAL) *(f32x4*)(hm + (size_t)(row - METAROW) * DM + i * 256 + lane * 4) = v;
    }
    ss = wave_sum(ss);
    if (lane == 0) rs[row] = rsqrtf(ss * (1.f / DM) + EPS);
  }
  float* rope = (float*)(wsb + WS_ROPE);
  for (int i = blockIdx.x * 512 + TX; i < 4112 * 16; i += gridDim.x * 512) {
    int pos = i >> 4, f = i & 15;
    float inv = exp2f(-(float)(2 * f) * (13.287712379549449f / 32.f));
    float ang = (float)pos * inv;
    rope[2 * i] = cosf(ang); rope[2 * i + 1] = sinf(ang);
  }
}

DEVI void row_pass(PRef p, const u16* y, const float* hsrc_real, const float* g, bool fin) { const int TX = opaque_tid(); unsigned char* const wsb = opq(p.ws);
  const int lane = TX & 63, gw = blockIdx.x * 8 + (TX >> 6), NW = gridDim.x * 8;
  u16* hb = (u16*)(wsb + WS_HB); float* rs = (float*)(wsb + WS_RS); float* hm = (float*)(wsb + WS_HM);
  const int NR = NREAL + NMETA;
  u32x2 yr[4]; f32x4 hr[4];
  if (gw < NR) { const float* hs = gw < NREAL ? hsrc_real + (size_t)gw * DM : hm + (size_t)(gw - METAROW) * DM;
    for (int i = 0; i < 4; ++i) { yr[i] = *(const u32x2*)(y + (size_t)gw * DM + i * 256 + lane * 4); hr[i] = *(const f32x4*)(hs + i * 256 + lane * 4); } }
  f32x4 gg[4]; for (int i = 0; i < 4; ++i) gg[i] = *(const f32x4*)(g + i * 256 + lane * 4);
  for (int row = gw; row < NR; row += NW) {
    const int nx = row + NW; u32x2 yn[4]; f32x4 hn[4];
    if (nx < NR) { const float* hs = nx < NREAL ? hsrc_real + (size_t)nx * DM : hm + (size_t)(nx - METAROW) * DM;
      for (int i = 0; i < 4; ++i) { yn[i] = *(const u32x2*)(y + (size_t)nx * DM + i * 256 + lane * 4); hn[i] = *(const f32x4*)(hs + i * 256 + lane * 4); } }
    float* hd = row < NREAL ? p.out + (size_t)row * DM : hm + (size_t)(row - METAROW) * DM;
    float yv[16]; float ss = 0.f;
    for (int i = 0; i < 4; ++i) { yv[4 * i] = blo(yr[i][0]); yv[4 * i + 1] = bhi(yr[i][0]); yv[4 * i + 2] = blo(yr[i][1]); yv[4 * i + 3] = bhi(yr[i][1]);
      for (int j = 0; j < 4; ++j) ss += yv[4 * i + j] * yv[4 * i + j]; }
    ss = wave_sum(ss);
    const float r = rsqrtf(ss * (1.f / DM) + EPS);
    float s2 = 0.f;
    for (int i = 0; i < 4; ++i) {
      f32x4 h = hr[i];
      for (int j = 0; j < 4; ++j) { h[j] += yv[4 * i + j] * r * gg[i][j]; s2 += h[j] * h[j]; }
      *(f32x4*)(hd + i * 256 + lane * 4) = h;
      if (!fin) { u32x2 o; o[0] = pack2(h[0], h[1]); o[1] = pack2(h[2], h[3]);
        *(u32x2*)(hb + (size_t)row * DM + i * 256 + lane * 4) = o; }
    }
    if (!fin) { s2 = wave_sum(s2);
      if (lane == 0) rs[row] = rsqrtf(s2 * (1.f / DM) + EPS); }
    for (int i = 0; i < 4; ++i) { yr[i] = yn[i]; hr[i] = hn[i]; }
  }
}

DEVI int prev_row(int t, int d) {
  if (t < NREAL) { int s = t & (SEQ - 1); return s >= d ? t - d : METAROW + NMETA + s - d; }
  int pp = t - METAROW; return pp >= d ? t - d : -1;
}
DEVI void phase_conv(PRef p, int l) { const int TX = opaque_tid(); unsigned char* const wsb = opq(p.ws);
  const int lane = TX & 63, gw = blockIdx.x * 8 + (TX >> 6), NW = gridDim.x * 8;
  u16* rest = (u16*)(wsb + WS_REST); u16* kr = (u16*)(wsb + WS_KR); const float* rope = (const float*)(wsb + WS_ROPE);
  const float* cw = p.in[I_CONVW] + (size_t)l * 3 * 256;
  float w0[4], w1[4], w2[4];
  for (int j = 0; j < 4; ++j) { w0[j] = cw[lane * 4 + j]; w1[j] = cw[256 + lane * 4 + j]; w2[j] = cw[512 + lane * 4 + j]; }
  auto ld = [&](int row, u32x2 (&d)[7]) {
    const u16* rr = rest + (size_t)row * NREST; const int r1 = prev_row(row, 1), r2 = prev_row(row, 2);
    d[0] = *(const u32x2*)(rr + RC_CB + lane * 4); d[1] = *(const u32x2*)(rr + RC_CC + lane * 4); d[2] = *(const u32x2*)(rr + RC_CV + lane * 4);
    d[3] = (u32x2){0, 0}; d[4] = d[3]; d[5] = d[3]; d[6] = d[3];
    if (r1 >= 0) { d[3] = *(const u32x2*)(rest + (size_t)r1 * NREST + RC_CC + lane * 4); d[4] = *(const u32x2*)(rest + (size_t)r1 * NREST + RC_CV + lane * 4); }
    if (r2 >= 0) { d[5] = *(const u32x2*)(rest + (size_t)r2 * NREST + RC_CC + lane * 4); d[6] = *(const u32x2*)(rest + (size_t)r2 * NREST + RC_CV + lane * 4); } };
  const int NR = NREAL + NMETA;
  u32x2 cur[7]; unsigned kcur = 0;
  if (gw < NR) { ld(gw, cur); if (lane < 32) kcur = rest[(size_t)gw * NREST + RC_KR + lane]; }
  for (int row = gw; row < NR; row += NW) {
    const int nx = row + NW; u32x2 nxt[7]; unsigned knx = 0;
    if (nx < NR) { ld(nx, nxt); if (lane < 32) knx = rest[(size_t)nx * NREST + RC_KR + lane]; }
    u16* rr = rest + (size_t)row * NREST;
    float o[4];
    for (int j = 0; j < 4; ++j) {
      unsigned a0 = cur[1][j >> 1], b0 = cur[2][j >> 1], a1 = cur[3][j >> 1], b1 = cur[4][j >> 1], a2 = cur[5][j >> 1], b2 = cur[6][j >> 1], g = cur[0][j >> 1];
      float u0 = (j & 1) ? bhi(a0) * bhi(b0) : blo(a0) * blo(b0);
      float u1 = (j & 1) ? bhi(a1) * bhi(b1) : blo(a1) * blo(b1);
      float u2 = (j & 1) ? bhi(a2) * bhi(b2) : blo(a2) * blo(b2);
      float gg = (j & 1) ? bhi(g) : blo(g);
      o[j] = gg * (w0[j] * u2 + w1[j] * u1 + w2[j] * u0);
    }
    u32x2 ov; ov[0] = pack2(o[0], o[1]); ov[1] = pack2(o[2], o[3]);
    *(u32x2*)(rr + RC_CB + lane * 4) = ov;
    { const int pos = row_pos(row);
      const float xm = b2f((u16)kcur), xo = b2f((u16)__shfl_xor((int)kcur, 16));
      if (lane < 32) { const int f = lane & 15; const float c = rope[(pos * 16 + f) * 2], sn = rope[(pos * 16 + f) * 2 + 1];
        kr[(size_t)row * 32 + lane] = f2b(lane < 16 ? xm * c - xo * sn : xm * c + xo * sn); } }
    for (int i = 0; i < 7; ++i) cur[i] = nxt[i]; kcur = knx;
  }
}

DEVI void chunk_rows(int b, int c, int& row0, int& len) { if (c == 0) { row0 = METAROW; len = NMETA; } else { row0 = b * SEQ + (c - 1) * 64; len = 64; } }
struct S5Const { float lr, li; float bre[16], bim[16]; };
DEVI void s5_consts(PRef p, int l, int g, int pp, S5Const& k) {
  const float are = p.in[I_ARE][(l * 16 + g) * 64 + pp], aim = p.in[I_AIM][(l * 16 + g) * 64 + pp];
  const float dt = expf(p.in[I_LSTEP][l * 16 + g]);
  const float mag = expf(are * dt);
  k.lr = mag * cosf(aim * dt); k.li = mag * sinf(aim * dt);
  const float den = are * are + aim * aim, xr = k.lr - 1.f, xi = k.li;
  const float zr = (xr * are + xi * aim) / den, zi = (xi * are - xr * aim) / den;
  const float* br = p.in[I_BRE] + ((size_t)(l * 16 + g) * 64 + pp) * 16; const float* bi = p.in[I_BIM] + ((size_t)(l * 16 + g) * 64 + pp) * 16;
  for (int i = 0; i < 16; ++i) { float a = br[i], b = bi[i]; k.bre[i] = zr * a - zi * b; k.bim[i] = zr * b + zi * a; }
}
DEVI void s5_load_u(PRef p, float* ul, int row0, int len) { const int TX = opaque_tid(); unsigned char* const wsb = opq(p.ws);
  const u16* rest = (const u16*)(wsb + WS_REST);
  for (int i = TX; i < 64 * 32; i += 512) { int r = i >> 5, c8 = (i & 31) * 8;
    u32x4 v = {0, 0, 0, 0}; if (r < len) v = *(const u32x4*)(rest + (size_t)(row0 + r) * NREST + RC_SU + c8);
    *(f32x4*)(ul + r * 256 + c8) = (f32x4){blo(v[0]), bhi(v[0]), blo(v[1]), bhi(v[1])}; *(f32x4*)(ul + r * 256 + c8 + 4) = (f32x4){blo(v[2]), bhi(v[2]), blo(v[3]), bhi(v[3])}; }
}
DEVI void s5_bu(const float* urow, const S5Const& k, float& bur, float& bui) {
  bur = 0.f; bui = 0.f;
#pragma unroll
  for (int q = 0; q < 4; ++q) { const f32x4 x = *(const f32x4*)(urow + 4 * q);
#pragma unroll
    for (int i = 0; i < 4; ++i) { bur += k.bre[4 * q + i] * x[i]; bui += k.bim[4 * q + i] * x[i]; } }
}
DEVI void s5_passA(PRef p, int l, unsigned char* lds) { const int TX = opaque_tid(); unsigned char* const wsb = opq(p.ws);
  u16* ulb = (u16*)lds; float* buL = (float*)(lds + 32768); float* send = (float*)(wsb + WS_S5);
  const u16* rest = (const u16*)(wsb + WS_REST);
  const int wave = TX >> 6, lane = TX & 63, fr = lane & 15, fq = lane >> 4;
  float* bw = buL + wave * 16 * 132;
  for (int it = blockIdx.x; it < NB * 64 + 1; it += gridDim.x) {
    const int b = it < NB * 64 ? it >> 6 : 0, c = it < NB * 64 ? 1 + (it & 63) : 0; int row0, len; chunk_rows(b, c, row0, len);
    __syncthreads();
    for (int i = TX; i < 64 * 32; i += 512) { int r = i >> 5, c8 = (i & 31) * 8;
      u32x4 v = {0, 0, 0, 0}; if (r < len) v = *(const u32x4*)(rest + (size_t)(row0 + r) * NREST + RC_SU + c8);
      *(u32x4*)(ulb + r * 256 + c8) = v; }
    __syncthreads();
    for (int gi = 0; gi < 2; ++gi) { const int g = wave * 2 + gi;
      const float are = p.in[I_ARE][(l * 16 + g) * 64 + lane], aim = p.in[I_AIM][(l * 16 + g) * 64 + lane];
      const float dt = expf(p.in[I_LSTEP][l * 16 + g]); const float mag = expf(are * dt);
      const float lr = mag * cosf(aim * dt), li = mag * sinf(aim * dt);
      { const float den = are * are + aim * aim, xr = lr - 1.f, xi = li;
        __builtin_amdgcn_wave_barrier();
        bw[lane] = (xr * are + xi * aim) / den; bw[64 + lane] = (xi * are - xr * aim) / den;
        __builtin_amdgcn_wave_barrier(); }
      bf16x8 bfr[4], bfi[4];
#pragma unroll
      for (int nt = 0; nt < 4; ++nt) { const int ps = 16 * nt + fr; const float zr = bw[ps], zi = bw[64 + ps];
        u32x4 wr4 = {0, 0, 0, 0}, wi4 = {0, 0, 0, 0};
        if (fq < 2) { const float* br = p.in[I_BRE] + ((size_t)(l * 16 + g) * 64 + ps) * 16 + 8 * fq; const float* bi = p.in[I_BIM] + ((size_t)(l * 16 + g) * 64 + ps) * 16 + 8 * fq;
          const f32x4 r0 = *(const f32x4*)br, r1 = *(const f32x4*)(br + 4), i0 = *(const f32x4*)bi, i1 = *(const f32x4*)(bi + 4);
          wr4[0] = cvtpk(zr * r0[0] - zi * i0[0], zr * r0[1] - zi * i0[1]); wr4[1] = cvtpk(zr * r0[2] - zi * i0[2], zr * r0[3] - zi * i0[3]);
          wr4[2] = cvtpk(zr * r1[0] - zi * i1[0], zr * r1[1] - zi * i1[1]); wr4[3] = cvtpk(zr * r1[2] - zi * i1[2], zr * r1[3] - zi * i1[3]);
          wi4[0] = cvtpk(zr * i0[0] + zi * r0[0], zr * i0[1] + zi * r0[1]); wi4[1] = cvtpk(zr * i0[2] + zi * r0[2], zr * i0[3] + zi * r0[3]);
          wi4[2] = cvtpk(zr * i1[0] + zi * r1[0], zr * i1[1] + zi * r1[1]); wi4[3] = cvtpk(zr * i1[2] + zi * r1[2], zr * i1[3] + zi * r1[3]); }
        bfr[nt] = __builtin_bit_cast(bf16x8, wr4); bfi[nt] = __builtin_bit_cast(bf16x8, wi4); }
      float sr = 0.f, si = 0.f;
      for (int sb = 0; sb < len; sb += 16) {
        u32x4 au = {0, 0, 0, 0}; if (fq < 2) au = *(const u32x4*)(ulb + (sb + fr) * 256 + g * 16 + 8 * fq);
        const bf16x8 af = __builtin_bit_cast(bf16x8, au);
        __builtin_amdgcn_wave_barrier();
#pragma unroll
        for (int nt = 0; nt < 4; ++nt) { const f32x4 z4 = {0.f, 0.f, 0.f, 0.f};
          const f32x4 dr = __builtin_amdgcn_mfma_f32_16x16x32_bf16(af, bfr[nt], z4, 0, 0, 0), di = __builtin_amdgcn_mfma_f32_16x16x32_bf16(af, bfi[nt], z4, 0, 0, 0);
#pragma unroll
          for (int r = 0; r < 4; ++r) { bw[(4 * fq + r) * 132 + 16 * nt + fr] = dr[r]; bw[(4 * fq + r) * 132 + 64 + 16 * nt + fr] = di[r]; } }
        __builtin_amdgcn_wave_barrier();
        for (int tt = 0; tt < 16; ++tt) { const float bur = bw[tt * 132 + lane], bui = bw[tt * 132 + 64 + lane];
          float nr = lr * sr - li * si + bur, ni = lr * si + li * sr + bui; sr = nr; si = ni; }
      }
      float* o = send + ((size_t)(c == 0 ? NB * NCH : b * NCH + c) * 16 + g) * 128; o[lane] = sr; o[64 + lane] = si; }
  }
}
DEVI void s5_scan(PRef p, int l, int blk0) { const int TX = opaque_tid(); unsigned char* const wsb = opq(p.ws);
  float* send = (float*)(wsb + WS_S5);
  const int lane = TX & 63, gw = ((int)blockIdx.x - blk0) * 8 + (TX >> 6);
  if (gw < 0 || gw >= NB * 16) return;
  const int b = gw >> 4, g = gw & 15;
  const float are = p.in[I_ARE][(l * 16 + g) * 64 + lane], aim = p.in[I_AIM][(l * 16 + g) * 64 + lane];
  const float dt = expf(p.in[I_LSTEP][l * 16 + g]); const float mag = expf(are * dt);
  float l16r = mag * cosf(aim * dt), l16i = mag * sinf(aim * dt);
  for (int i = 0; i < 4; ++i) { float a = l16r * l16r - l16i * l16i, bb = l16r * l16i; l16r = a; l16i = bb + bb; }
  float l64r = l16r, l64i = l16i; for (int i = 0; i < 2; ++i) { float a = l64r * l64r - l64i * l64i, bb = l64r * l64i; l64r = a; l64i = bb + bb; }
  float sr = 0.f, si = 0.f;
  for (int c0 = 0; c0 < NCH; c0 += 5) {
    float er[5], ei[5];
    for (int i = 0; i < 5; ++i) { const float* e = send + ((size_t)((c0 + i) == 0 ? NB * NCH : b * NCH + c0 + i) * 16 + g) * 128; er[i] = e[lane]; ei[i] = e[64 + lane]; }
    for (int i = 0; i < 5; ++i) { float* e = send + ((size_t)(b * NCH + c0 + i) * 16 + g) * 128; e[lane] = sr; e[64 + lane] = si;
      const float pr = (c0 + i) == 0 ? l16r : l64r, pi = (c0 + i) == 0 ? l16i : l64i;
      const float nr = pr * sr - pi * si + er[i], ni = pr * si + pi * sr + ei[i]; sr = nr; si = ni; }
  }
}
DEVI void s5_passB_item(PRef p, int l, int b, int c, unsigned char* lds) { const int TX = opaque_tid(); unsigned char* const wsb = opq(p.ws);
  constexpr int UP = 264;
  u16* ulb = (u16*)lds;
  unsigned* sst = (unsigned*)(lds + 33792);
  float* buL = (float*)(lds + 33792 + 34816);
  const float* send = (const float*)(wsb + WS_S5); u16* rest = (u16*)(wsb + WS_REST);
  const int wave = TX >> 6, lane = TX & 63, fr = lane & 15, fq = lane >> 4;
  int row0, len; chunk_rows(b, c, row0, len);
  __syncthreads();
  for (int i = TX; i < 64 * 32; i += 512) { int r = i >> 5, c8 = (i & 31) * 8;
    u32x4 v = {0, 0, 0, 0}; if (r < len) v = *(const u32x4*)(rest + (size_t)(row0 + r) * NREST + RC_SU + c8);
    *(u32x4*)(ulb + r * UP + c8) = v; }
  __syncthreads();
  unsigned* sw = sst + wave * 16 * 68; float* bw = buL + wave * 16 * 132;
  for (int gi = 0; gi < 2; ++gi) { const int g = wave * 2 + gi;
    const float are = p.in[I_ARE][(l * 16 + g) * 64 + lane], aim = p.in[I_AIM][(l * 16 + g) * 64 + lane];
    const float dt = expf(p.in[I_LSTEP][l * 16 + g]); const float mag = expf(are * dt);
    const float lr = mag * cosf(aim * dt), li = mag * sinf(aim * dt);
    { const float den = are * are + aim * aim, xr = lr - 1.f, xi = li;
      __builtin_amdgcn_wave_barrier();
      bw[lane] = (xr * are + xi * aim) / den; bw[64 + lane] = (xi * are - xr * aim) / den;
      __builtin_amdgcn_wave_barrier(); }
    bf16x8 bfr[4], bfi[4];
#pragma unroll
    for (int nt = 0; nt < 4; ++nt) { const int ps = 16 * nt + fr; const float zr = bw[ps], zi = bw[64 + ps];
      u32x4 wr4 = {0, 0, 0, 0}, wi4 = {0, 0, 0, 0};
      if (fq < 2) { const float* br = p.in[I_BRE] + ((size_t)(l * 16 + g) * 64 + ps) * 16 + 8 * fq; const float* bi = p.in[I_BIM] + ((size_t)(l * 16 + g) * 64 + ps) * 16 + 8 * fq;
        const f32x4 r0 = *(const f32x4*)br, r1 = *(const f32x4*)(br + 4), i0 = *(const f32x4*)bi, i1 = *(const f32x4*)(bi + 4);
        wr4[0] = cvtpk(zr * r0[0] - zi * i0[0], zr * r0[1] - zi * i0[1]); wr4[1] = cvtpk(zr * r0[2] - zi * i0[2], zr * r0[3] - zi * i0[3]);
        wr4[2] = cvtpk(zr * r1[0] - zi * i1[0], zr * r1[1] - zi * i1[1]); wr4[3] = cvtpk(zr * r1[2] - zi * i1[2], zr * r1[3] - zi * i1[3]);
        wi4[0] = cvtpk(zr * i0[0] + zi * r0[0], zr * i0[1] + zi * r0[1]); wi4[1] = cvtpk(zr * i0[2] + zi * r0[2], zr * i0[3] + zi * r0[3]);
        wi4[2] = cvtpk(zr * i1[0] + zi * r1[0], zr * i1[1] + zi * r1[1]); wi4[3] = cvtpk(zr * i1[2] + zi * r1[2], zr * i1[3] + zi * r1[3]); }
      bfr[nt] = __builtin_bit_cast(bf16x8, wr4); bfi[nt] = __builtin_bit_cast(bf16x8, wi4); }
    const float* e0 = send + ((size_t)(b * NCH + c) * 16 + g) * 128; float sr = e0[lane], si = e0[64 + lane];
    bf16x8 cf[4];
    for (int ks = 0; ks < 4; ++ks) { const int p0 = (32 * ks + 8 * fq) >> 1;
      const f32x4 cr = *(const f32x4*)(p.in[I_CRE] + ((size_t)(l * 16 + g) * 16 + fr) * 64 + p0), ci = *(const f32x4*)(p.in[I_CIM] + ((size_t)(l * 16 + g) * 16 + fr) * 64 + p0);
      u32x4 t4; for (int j = 0; j < 4; ++j) t4[j] = cvtpk(cr[j], -ci[j]);
      cf[ks] = __builtin_bit_cast(bf16x8, t4); }
    const float dsk = p.in[I_SD][l * 256 + g * 16 + fr];
    for (int sb = 0; sb < len; sb += 16) {
      u32x4 au = {0, 0, 0, 0}; if (fq < 2) au = *(const u32x4*)(ulb + (sb + fr) * UP + g * 16 + 8 * fq);
      const bf16x8 af = __builtin_bit_cast(bf16x8, au);
      __builtin_amdgcn_wave_barrier();
#pragma unroll
      for (int nt = 0; nt < 4; ++nt) { const f32x4 z4 = {0.f, 0.f, 0.f, 0.f};
        const f32x4 dr = __builtin_amdgcn_mfma_f32_16x16x32_bf16(af, bfr[nt], z4, 0, 0, 0), di = __builtin_amdgcn_mfma_f32_16x16x32_bf16(af, bfi[nt], z4, 0, 0, 0);
#pragma unroll
        for (int r = 0; r < 4; ++r) { bw[(4 * fq + r) * 132 + 16 * nt + fr] = dr[r]; bw[(4 * fq + r) * 132 + 64 + 16 * nt + fr] = di[r]; } }
      __builtin_amdgcn_wave_barrier();
      for (int tt = 0; tt < 16; ++tt) { const float bur = bw[tt * 132 + lane], bui = bw[tt * 132 + 64 + lane];
        float nr = lr * sr - li * si + bur, ni = lr * si + li * sr + bui; sr = nr; si = ni;
        sw[tt * 68 + lane] = cvtpk(sr, si); }
      __builtin_amdgcn_wave_barrier();
      f32x4 d = {0.f, 0.f, 0.f, 0.f};
      for (int ks = 0; ks < 4; ++ks) { bf16x8 a = *(const bf16x8*)(sw + fr * 68 + 16 * ks + 4 * fq); d = __builtin_amdgcn_mfma_f32_16x16x32_bf16(a, cf[ks], d, 0, 0, 0); }
      for (int r = 0; r < 4; ++r) { const int t = sb + 4 * fq + r; u16* up = ulb + t * UP + g * 16 + fr; const float u = b2f(*up);
        *up = f2b(d[r] + dsk * u); }
    }
  }
  __syncthreads();
  { const u16* Wg = (const u16*)(wsb + WS_W + W_GLU);
    const int cb = 32 * wave;
    f32x4 acc[4][4];
#pragma unroll
    for (int mt = 0; mt < 4; ++mt)
#pragma unroll
      for (int nt = 0; nt < 4; ++nt) acc[mt][nt] = (f32x4){0.f, 0.f, 0.f, 0.f};
    const u16* wrow[4];
#pragma unroll
    for (int nt = 0; nt < 4; ++nt) { const int ch = cb + 16 * (nt & 1) + fr; wrow[nt] = Wg + (size_t)((ch >> 7) * 256 + (ch & 127) + (nt >= 2 ? 128 : 0)) * 256 + 8 * fq; }
#pragma unroll 2
    for (int ks = 0; ks < 8; ++ks) {
      bf16x8 bfr4[4], afr[4];
#pragma unroll
      for (int nt = 0; nt < 4; ++nt) bfr4[nt] = *(const bf16x8*)(wrow[nt] + 32 * ks);
#pragma unroll
      for (int mt = 0; mt < 4; ++mt) afr[mt] = *(const bf16x8*)(ulb + (16 * mt + fr) * UP + 32 * ks + 8 * fq);
#pragma unroll
      for (int mt = 0; mt < 4; ++mt)
#pragma unroll
        for (int nt = 0; nt < 4; ++nt) acc[mt][nt] = __builtin_amdgcn_mfma_f32_16x16x32_bf16(afr[mt], bfr4[nt], acc[mt][nt], 0, 0, 0);
    }
#pragma unroll
    for (int mt = 0; mt < 4; ++mt)
#pragma unroll
      for (int j = 0; j < 2; ++j)
#pragma unroll
        for (int r = 0; r < 4; ++r) { const int t = 16 * mt + 4 * fq + r;
          if (t < len) rest[(size_t)(row0 + t) * NREST + RC_SU + cb + 16 * j + fr] = f2b(acc[mt][j][r] * sigm(acc[mt][2 + j][r])); }
  }
}

constexpr int MP = 72;
DEVI void mlstm_item(PRef p, int l, int b, int h, unsigned char* lds) { const int TX = opaque_tid(); unsigned char* const wsb = opq(p.ws);
  u16* Qs = (u16*)lds; u16* Ks = Qs + 64 * MP; u16* KTs = Ks + 64 * MP; u16* VTs = KTs + 64 * MP; u16* Cs = VTs + 80 * MP; u16* Ps = Cs + 80 * MP; u16* Os = Ps + 64 * MP;
  float* Hs = (float*)(Os + 64 * MP);
  float* sa = Hs + 64 * 65; float* sM = sa + 64; float* swi = sM + 64; float* sem = swi + 64; float* sden = sem + 64; float* swr = sden + 64; float* sdec = swr + 64; u16* VTw = (u16*)(sdec + 64);
  u16* rest = (u16*)(wsb + WS_REST); const float* gp = (const float*)(wsb + WS_GP);
  const int tid = TX, wave = tid >> 6, lane = tid & 63, fr = lane & 15, fq = lane >> 4;
  const float gbi = p.in[I_GATEB][l * 8 + h], gbf = p.in[I_GATEB][l * 8 + 4 + h];
  const int mt = wave >> 1, nh = wave & 1;
  __syncthreads();
  for (int i = tid; i < 80 * MP; i += 512) { Cs[i] = 0; int r = i / MP; VTs[i] = (r == 64) ? (u16)0x3F80 : (u16)0; }
  __syncthreads();
  f32x4 cst[3]; for (int i = 0; i < 3; ++i) cst[i] = (f32x4){0.f, 0.f, 0.f, 0.f};
  float m_prev = 0.f;
  const int lr = tid >> 3, c8 = (tid & 7) * 8;
  u32x4 qn = {0, 0, 0, 0}, kn = qn, vn = qn, on = qn; float gin = 0.f, gfn = 0.f;
  { int row0, len; chunk_rows(b, 0, row0, len);
    if (lr < len) { const u16* rp = rest + (size_t)(row0 + lr) * NREST + h * 64 + c8;
      qn = *(const u32x4*)(rp + RC_MQ); kn = *(const u32x4*)(rp + RC_MK); vn = *(const u32x4*)(rp + RC_MV); on = *(const u32x4*)(rp + RC_MO); }
    if (wave == 0 && lane < len) { const float* g8 = gp + (size_t)(row0 + lane) * 8; gin = g8[h]; gfn = g8[4 + h]; } }
  for (int c = 0; c < NCH; ++c) {
    int row0, len; chunk_rows(b, c, row0, len);
    const float gic = gin, gfc = gfn;
    { u32x4 q = qn, k = kn, v = vn, o = on;
      if (c + 1 < NCH) { int r1, l1; chunk_rows(b, c + 1, r1, l1); qn = (u32x4){0, 0, 0, 0}; kn = qn; vn = qn; on = qn;
        if (lr < l1) { const u16* rp = rest + (size_t)(r1 + lr) * NREST + h * 64 + c8;
          qn = *(const u32x4*)(rp + RC_MQ); kn = *(const u32x4*)(rp + RC_MK); vn = *(const u32x4*)(rp + RC_MV); on = *(const u32x4*)(rp + RC_MO); }
        if (wave == 0 && lane < l1) { const float* g8 = gp + (size_t)(r1 + lane) * 8; gin = g8[h]; gfn = g8[4 + h]; } }
      for (int j = 0; j < 4; ++j) k[j] = pack2(blo(k[j]) * 0.125f, bhi(k[j]) * 0.125f);
      *(u32x4*)(Qs + lr * MP + c8) = q; *(u32x4*)(Ks + lr * MP + c8) = k; *(u32x4*)(Os + lr * MP + c8) = o;
      for (int j = 0; j < 4; ++j) { KTs[(c8 + 2 * j) * MP + lr] = (u16)(k[j] & 0xffff); KTs[(c8 + 2 * j + 1) * MP + lr] = (u16)(k[j] >> 16);
        VTs[(c8 + 2 * j) * MP + lr] = (u16)(v[j] & 0xffff); VTs[(c8 + 2 * j + 1) * MP + lr] = (u16)(v[j] >> 16); } }
    if (wave == 0) {
      float ig = -INFINITY, lf = 0.f;
      if (lane < len) { ig = gic + gbi; float x = gfc + gbf; lf = fminf(x, 0.f) - __logf(1.f + __expf(-fabsf(x))); }
      float bc = lf; for (int o = 1; o < 64; o <<= 1) { float t = __shfl_up(bc, o); if (lane >= o) bc += t; }
      float a = ig - bc;
      float pm = a; for (int o = 1; o < 64; o <<= 1) { float t = __shfl_up(pm, o); if (lane >= o) pm = fmaxf(pm, t); }
      float M = fmaxf(m_prev, pm);
      float Mlast = __shfl(M, 63), blast = __shfl(bc, 63);
      sa[lane] = a; sM[lane] = M; swi[lane] = __expf(m_prev - M); sem[lane] = __expf(-(bc + M)); swr[lane] = __expf(a - Mlast);
      if (lane == 0) sdec[0] = __expf(m_prev - Mlast);
      m_prev = blast + Mlast;
    }
    __syncthreads();
    {
      for (int i = tid; i < 80 * 8; i += 512) { const int v = i >> 3, r8 = (i & 7) * 8; u32x4 x = *(const u32x4*)(VTs + v * MP + r8); u32x4 o;
        for (int j = 0; j < 4; ++j) o[j] = cvtpk(blo(x[j]) * swr[r8 + 2 * j], bhi(x[j]) * swr[r8 + 2 * j + 1]);
        *(u32x4*)(VTw + v * MP + r8) = o; } }
    for (int ni = 0; ni < 2; ++ni) { const int nt = nh * 2 + ni; f32x4 s = {0.f, 0.f, 0.f, 0.f};
      for (int ks = 0; ks < 2; ++ks) { bf16x8 a = *(const bf16x8*)(Qs + (mt * 16 + fr) * MP + 32 * ks + 8 * fq); bf16x8 bb = *(const bf16x8*)(Ks + (nt * 16 + fr) * MP + 32 * ks + 8 * fq);
        s = __builtin_amdgcn_mfma_f32_16x16x32_bf16(a, bb, s, 0, 0, 0); }
      const int r = nt * 16 + fr; const float ar = sa[r];
      for (int j = 0; j < 4; ++j) { const int srow = mt * 16 + 4 * fq + j; float w = (r <= srow) ? __expf(ar - sM[srow]) : 0.f; Ps[srow * MP + r] = f2b(s[j] * w); } }
    __syncthreads();
    f32x4 a1[3], a2[3]; const int ntl[3] = {nh * 2, nh * 2 + 1, 4}; const int ncnt = nh == 0 ? 3 : 2;
    for (int i = 0; i < 3; ++i) { a1[i] = (f32x4){0.f, 0.f, 0.f, 0.f}; a2[i] = a1[i]; }
    for (int ks = 0; ks < 2; ++ks) { bf16x8 pa = *(const bf16x8*)(Ps + (mt * 16 + fr) * MP + 32 * ks + 8 * fq); bf16x8 qa = *(const bf16x8*)(Qs + (mt * 16 + fr) * MP + 32 * ks + 8 * fq);
      for (int i = 0; i < 3; ++i) if (i < ncnt) { bf16x8 vb = *(const bf16x8*)(VTs + (ntl[i] * 16 + fr) * MP + 32 * ks + 8 * fq); bf16x8 cb = *(const bf16x8*)(Cs + (ntl[i] * 16 + fr) * MP + 32 * ks + 8 * fq);
        a1[i] = __builtin_amdgcn_mfma_f32_16x16x32_bf16(pa, vb, a1[i], 0, 0, 0); a2[i] = __builtin_amdgcn_mfma_f32_16x16x32_bf16(qa, cb, a2[i], 0, 0, 0); } }
    if (nh == 0 && fr == 0) for (int j = 0; j < 4; ++j) { const int srow = mt * 16 + 4 * fq + j; sden[srow] = a1[2][j] + swi[srow] * a2[2][j]; }
    __syncthreads();
    for (int i = 0; i < 2; ++i) for (int j = 0; j < 4; ++j) { const int srow = mt * 16 + 4 * fq + j, v = ntl[i] * 16 + fr;
      float num = a1[i][j] + swi[srow] * a2[i][j]; float hv = num * __builtin_amdgcn_rcpf(fmaxf(fabsf(sden[srow]), sem[srow]));
      hv *= sigm(b2f(Os[srow * MP + v])); Hs[srow * 65 + v] = hv; }
    { const float dec = sdec[0];
      const int tm[3] = {mt, mt, 4}, tn[3] = {nh * 2, nh * 2 + 1, wave}; const int tc = wave < 4 ? 3 : 2;
      for (int i = 0; i < 3; ++i) if (i < tc) { f32x4 acc = cst[i] * dec;
        for (int ks = 0; ks < 2; ++ks) { bf16x8 va = *(const bf16x8*)(VTw + (tm[i] * 16 + fr) * MP + 32 * ks + 8 * fq);
          bf16x8 kb = *(const bf16x8*)(KTs + (tn[i] * 16 + fr) * MP + 32 * ks + 8 * fq);
          acc = __builtin_amdgcn_mfma_f32_16x16x32_bf16(va, kb, acc, 0, 0, 0); }
        cst[i] = acc; } }
    __syncthreads();
    { const int tm[3] = {mt, mt, 4}, tn[3] = {nh * 2, nh * 2 + 1, wave}; const int tc = wave < 4 ? 3 : 2;
      for (int i = 0; i < 3; ++i) if (i < tc) for (int j = 0; j < 4; ++j) Cs[(tm[i] * 16 + 4 * fq + j) * MP + tn[i] * 16 + fr] = f2b(cst[i][j]); }
    { float hv[8]; float ss = 0.f; for (int j = 0; j < 8; ++j) { hv[j] = Hs[lr * 65 + c8 + j]; ss += hv[j] * hv[j]; }
      ss += __shfl_xor(ss, 1); ss += __shfl_xor(ss, 2); ss += __shfl_xor(ss, 4);
      const float r = rsqrtf(ss * (1.f / 64.f) + EPS); const float* ng = p.in[I_MNORM] + l * 256 + h * 64 + c8;
      if (lr < len && (c > 0 || b == 0)) { u32x4 o; for (int j = 0; j < 4; ++j) o[j] = pack2(hv[2 * j] * r * ng[2 * j], hv[2 * j + 1] * r * ng[2 * j + 1]);
        *(u32x4*)(rest + (size_t)(row0 + lr) * NREST + RC_CC + h * 64 + c8) = o; } }
  }
}

constexpr int MREC = 4160;
DEVI void mlstm_gates(PRef p, int l, int h, int row0, int len, int lane, const float* gp, float& a, float& bc) {
  const float gbi = p.in[I_GATEB][l * 8 + h], gbf = p.in[I_GATEB][l * 8 + 4 + h];
  float ig = -INFINITY, lf = 0.f;
  if (lane < len) { const float* g8 = gp + (size_t)(row0 + lane) * 8; ig = g8[h] + gbi; float x = g8[4 + h] + gbf; lf = fminf(x, 0.f) - __logf(1.f + __expf(-fabsf(x))); }
  bc = lf; for (int o = 1; o < 64; o <<= 1) { float t = __shfl_up(bc, o); if (lane >= o) bc += t; }
  a = ig - bc;
}
DEVI void mlstm_stepA(PRef p, int l, int b, int h, int c, unsigned char* lds) { const int TX = opaque_tid(); unsigned char* const wsb = opq(p.ws);
  u16* KTs = (u16*)lds; u16* VTs = KTs + 64 * MP; float* swr = (float*)(VTs + 80 * MP);
  const u16* rest = (const u16*)(wsb + WS_REST); const float* gp = (const float*)(wsb + WS_GP);
  u16* rec = (u16*)(wsb + WS_MSUM) + (size_t)((b * 4 + h) * NCH + c) * MREC; float* msc = (float*)(wsb + WS_MSC) + (size_t)((b * 4 + h) * NCH + c) * 4;
  const int tid = TX, wave = tid >> 6, lane = tid & 63, fr = lane & 15, fq = lane >> 4, mt = wave >> 1, nh = wave & 1;
  int row0, len; chunk_rows(b, c, row0, len);
  const int lr = tid >> 3, c8 = (tid & 7) * 8;
  __syncthreads();
  for (int i = tid; i < 16 * MP; i += 512) VTs[64 * MP + i] = (i < MP) ? (u16)0x3F80 : (u16)0;
  { u32x4 k = {0, 0, 0, 0}, v = k;
    if (lr < len) { const u16* rp = rest + (size_t)(row0 + lr) * NREST + h * 64 + c8; k = *(const u32x4*)(rp + RC_MK); v = *(const u32x4*)(rp + RC_MV); }
    for (int j = 0; j < 4; ++j) { const unsigned kk = pack2(blo(k[j]) * 0.125f, bhi(k[j]) * 0.125f);
      KTs[(c8 + 2 * j) * MP + lr] = (u16)(kk & 0xffff); KTs[(c8 + 2 * j + 1) * MP + lr] = (u16)(kk >> 16);
      VTs[(c8 + 2 * j) * MP + lr] = (u16)(v[j] & 0xffff); VTs[(c8 + 2 * j + 1) * MP + lr] = (u16)(v[j] >> 16); } }
  if (wave == 0) { float a, bc; mlstm_gates(p, l, h, row0, len, lane, gp, a, bc);
    float mx = a; for (int o = 32; o > 0; o >>= 1) mx = fmaxf(mx, __shfl_xor(mx, o));
    swr[lane] = expf(a - mx);
    if (lane == 0) msc[1] = mx;
    if (lane == 63) msc[0] = bc; }
  __syncthreads();
  const int tm[3] = {mt, mt, 4}, tn[3] = {nh * 2, nh * 2 + 1, wave}; const int tc = wave < 4 ? 3 : 2;
  for (int i = 0; i < 3; ++i) if (i < tc) { f32x4 acc = {0.f, 0.f, 0.f, 0.f};
    for (int ks = 0; ks < 2; ++ks) { bf16x8 va = *(const bf16x8*)(VTs + (tm[i] * 16 + fr) * MP + 32 * ks + 8 * fq);
      for (int j = 0; j < 8; ++j) va[j] = (short)f2b(b2f((u16)va[j]) * swr[32 * ks + 8 * fq + j]);
      bf16x8 kb = *(const bf16x8*)(KTs + (tn[i] * 16 + fr) * MP + 32 * ks + 8 * fq);
      acc = __builtin_amdgcn_mfma_f32_16x16x32_bf16(va, kb, acc, 0, 0, 0); }
    for (int j = 0; j < 4; ++j) { const int v = tm[i] * 16 + 4 * fq + j; if (v <= 64) rec[v * 64 + tn[i] * 16 + fr] = f2b(acc[j]); } }
}
DEVI void mlstm_scan(PRef p) { const int TX = opaque_tid(); unsigned char* const wsb = opq(p.ws);
  if (TX >= 64) return;
  const int lane = TX;
  for (int it = blockIdx.x; it < 256; it += gridDim.x) {
    const int bh = it >> 3, vs = it & 7;
    u16* base = (u16*)(wsb + WS_MSUM) + (size_t)bh * NCH * MREC; float* msc = (float*)(wsb + WS_MSC) + (size_t)bh * NCH * 4;
    const bool hasn = (vs == 0) && lane < 8;
    float st[8], sn[8]; for (int j = 0; j < 8; ++j) { st[j] = 0.f; sn[j] = 0.f; }
    float m_prev = 0.f;
    for (int c0 = 0; c0 < NCH; c0 += 5) {
      u32x4 d[5], dn[5]; float bl[5], ml[5];
      for (int i = 0; i < 5; ++i) { u16* r = base + (size_t)(c0 + i) * MREC; d[i] = *(const u32x4*)(r + vs * 512 + lane * 8);
        dn[i] = hasn ? *(const u32x4*)(r + 4096 + lane * 8) : (u32x4){0, 0, 0, 0}; bl[i] = msc[(c0 + i) * 4]; ml[i] = msc[(c0 + i) * 4 + 1]; }
      for (int i = 0; i < 5; ++i) { u16* r = base + (size_t)(c0 + i) * MREC;
        u32x4 o; for (int j = 0; j < 4; ++j) o[j] = pack2(st[2 * j], st[2 * j + 1]); *(u32x4*)(r + vs * 512 + lane * 8) = o;
        if (hasn) { u32x4 on; for (int j = 0; j < 4; ++j) on[j] = pack2(sn[2 * j], sn[2 * j + 1]); *(u32x4*)(r + 4096 + lane * 8) = on; }
        if (vs == 0 && lane == 0) msc[(c0 + i) * 4 + 2] = m_prev;
        const float Mx = fmaxf(m_prev, ml[i]), f1 = expf(m_prev - Mx), f2 = expf(ml[i] - Mx);
        for (int j = 0; j < 4; ++j) { st[2 * j] = f1 * st[2 * j] + f2 * blo(d[i][j]); st[2 * j + 1] = f1 * st[2 * j + 1] + f2 * bhi(d[i][j]);
          sn[2 * j] = f1 * sn[2 * j] + f2 * blo(dn[i][j]); sn[2 * j + 1] = f1 * sn[2 * j + 1] + f2 * bhi(dn[i][j]); }
        m_prev = bl[i] + Mx; }
    }
  }
}
DEVI void mlstm_stepC(PRef p, int l, int b, int h, int c, unsigned char* lds) { const int TX = opaque_tid(); unsigned char* const wsb = opq(p.ws);
  u16* Qs = (u16*)lds; u16* Ks = Qs + 64 * MP; u16* VTs = Ks + 64 * MP; u16* Cs = VTs + 80 * MP; u16* Ps = Cs + 80 * MP; u16* Os = Ps + 64 * MP;
  float* Hs = (float*)(Os + 64 * MP);
  float* sa = Hs + 64 * 65; float* sM = sa + 64; float* swi = sM + 64; float* sem = swi + 64; float* sden = sem + 64;
  u16* rest = (u16*)(wsb + WS_REST); const float* gp = (const float*)(wsb + WS_GP);
  const u16* rec = (const u16*)(wsb + WS_MSUM) + (size_t)((b * 4 + h) * NCH + c) * MREC; const float* msc = (const float*)(wsb + WS_MSC) + (size_t)((b * 4 + h) * NCH + c) * 4;
  const int tid = TX, wave = tid >> 6, lane = tid & 63, fr = lane & 15, fq = lane >> 4;
  const int mt = wave >> 1, nh = wave & 1;
  int row0, len; chunk_rows(b, c, row0, len);
  const int lr = tid >> 3, c8 = (tid & 7) * 8;
  __syncthreads();
  for (int i = tid; i < 16 * MP; i += 512) { VTs[64 * MP + i] = (i < MP) ? (u16)0x3F80 : (u16)0; if (i >= MP) Cs[64 * MP + i] = 0; }
  { u32x4 q = {0, 0, 0, 0}, k = q, v = q, o = q;
    if (lr < len) { const u16* rp = rest + (size_t)(row0 + lr) * NREST + h * 64 + c8;
      q = *(const u32x4*)(rp + RC_MQ); k = *(const u32x4*)(rp + RC_MK); v = *(const u32x4*)(rp + RC_MV); o = *(const u32x4*)(rp + RC_MO); }
    const u32x4 cin = *(const u32x4*)(rec + lr * 64 + c8);
    for (int j = 0; j < 4; ++j) k[j] = pack2(blo(k[j]) * 0.125f, bhi(k[j]) * 0.125f);
    *(u32x4*)(Qs + lr * MP + c8) = q; *(u32x4*)(Ks + lr * MP + c8) = k; *(u32x4*)(Os + lr * MP + c8) = o; *(u32x4*)(Cs + lr * MP + c8) = cin;
    if (tid < 8) *(u32x4*)(Cs + 64 * MP + tid * 8) = *(const u32x4*)(rec + 4096 + tid * 8);
    for (int j = 0; j < 4; ++j) { VTs[(c8 + 2 * j) * MP + lr] = (u16)(v[j] & 0xffff); VTs[(c8 + 2 * j + 1) * MP + lr] = (u16)(v[j] >> 16); } }
  if (wave == 0) { float a, bc; mlstm_gates(p, l, h, row0, len, lane, gp, a, bc);
    const float m_prev = msc[2];
    float pm = a; for (int o = 1; o < 64; o <<= 1) { float t = __shfl_up(pm, o); if (lane >= o) pm = fmaxf(pm, t); }
    const float M = fmaxf(m_prev, pm);
    sa[lane] = a; sM[lane] = M; swi[lane] = expf(m_prev - M); sem[lane] = expf(-(bc + M)); }
  __syncthreads();
  for (int ni = 0; ni < 2; ++ni) { const int nt = nh * 2 + ni; f32x4 s = {0.f, 0.f, 0.f, 0.f};
    for (int ks = 0; ks < 2; ++ks) { bf16x8 a = *(const bf16x8*)(Qs + (mt * 16 + fr) * MP + 32 * ks + 8 * fq); bf16x8 bb = *(const bf16x8*)(Ks + (nt * 16 + fr) * MP + 32 * ks + 8 * fq);
      s = __builtin_amdgcn_mfma_f32_16x16x32_bf16(a, bb, s, 0, 0, 0); }
    const int r = nt * 16 + fr; const float ar = sa[r];
    for (int j = 0; j < 4; ++j) { const int srow = mt * 16 + 4 * fq + j; float w = (r <= srow) ? expf(ar - sM[srow]) : 0.f; Ps[srow * MP + r] = f2b(s[j] * w); } }
  __syncthreads();
  f32x4 a1[3], a2[3]; const int ntl[3] = {nh * 2, nh * 2 + 1, 4}; const int ncnt = nh == 0 ? 3 : 2;
  for (int i = 0; i < 3; ++i) { a1[i] = (f32x4){0.f, 0.f, 0.f, 0.f}; a2[i] = a1[i]; }
  for (int ks = 0; ks < 2; ++ks) { bf16x8 pa = *(const bf16x8*)(Ps + (mt * 16 + fr) * MP + 32 * ks + 8 * fq); bf16x8 qa = *(const bf16x8*)(Qs + (mt * 16 + fr) * MP + 32 * ks + 8 * fq);
    for (int i = 0; i < 3; ++i) if (i < ncnt) { bf16x8 vb = *(const bf16x8*)(VTs + (ntl[i] * 16 + fr) * MP + 32 * ks + 8 * fq); bf16x8 cb = *(const bf16x8*)(Cs + (ntl[i] * 16 + fr) * MP + 32 * ks + 8 * fq);
      a1[i] = __builtin_amdgcn_mfma_f32_16x16x32_bf16(pa, vb, a1[i], 0, 0, 0); a2[i] = __builtin_amdgcn_mfma_f32_16x16x32_bf16(qa, cb, a2[i], 0, 0, 0); } }
  if (nh == 0 && fr == 0) for (int j = 0; j < 4; ++j) { const int srow = mt * 16 + 4 * fq + j; sden[srow] = a1[2][j] + swi[srow] * a2[2][j]; }
  __syncthreads();
  for (int i = 0; i < 2; ++i) for (int j = 0; j < 4; ++j) { const int srow = mt * 16 + 4 * fq + j, v = ntl[i] * 16 + fr;
    float num = a1[i][j] + swi[srow] * a2[i][j]; float hv = num / fmaxf(fabsf(sden[srow]), sem[srow]);
    hv *= sigm(b2f(Os[srow * MP + v])); Hs[srow * 65 + v] = hv; }
  __syncthreads();
  { float hv[8]; float ss = 0.f; for (int j = 0; j < 8; ++j) { hv[j] = Hs[lr * 65 + c8 + j]; ss += hv[j] * hv[j]; }
    ss += __shfl_xor(ss, 1); ss += __shfl_xor(ss, 2); ss += __shfl_xor(ss, 4);
    const float r = rsqrtf(ss * (1.f / 64.f) + EPS); const float* ng = p.in[I_MNORM] + l * 256 + h * 64 + c8;
    if (lr < len) { u32x4 o; for (int j = 0; j < 4; ++j) o[j] = pack2(hv[2 * j] * r * ng[2 * j], hv[2 * j + 1] * r * ng[2 * j + 1]);
      *(u32x4*)(rest + (size_t)(row0 + lr) * NREST + RC_CC + h * 64 + c8) = o; } }
}

constexpr int KP = 104, VP = 72;
DEVI void attn_item(PRef p, int b, int hh, int qb, bool meta, unsigned char* lds) { const int TX = opaque_tid(); unsigned char* const wsb = opq(p.ws);
  u16* Kl = (u16*)lds;
  u16* Vl = Kl + 2 * 64 * KP;
  const u16* Q = (const u16*)(wsb + WS_Q); const u16* KN = (const u16*)(wsb + WS_KN); const u16* KR = (const u16*)(wsb + WS_KR); const u16* VT = (const u16*)(wsb + WS_VT);
  u16* rest = (u16*)(wsb + WS_REST);
  const int tid = TX, wave = tid >> 6, lane = tid & 63, r31 = lane & 31, h2 = lane >> 5;
  const int ntile = meta ? 1 : 4 * qb + 5;
  const int mychunk = meta ? (wave == 0 ? 0 : -1) : 4 * qb + 1 + (wave >> 1);
  const int qrow = meta ? METAROW + r31 : b * SEQ + qb * 256 + wave * 32 + r31;
  bf16x8 qf[6];
  for (int ks = 0; ks < 6; ++ks) qf[ks] = *(const bf16x8*)(Q + (size_t)qrow * 768 + hh * 96 + 16 * ks + 8 * h2);
  f32x16 o0, o1; for (int i = 0; i < 16; ++i) { o0[i] = 0.f; o1[i] = 0.f; }
  float mrun = 0.f, lsum = 0.f;
  u32x4 kreg0, kreg1, vreg;
  auto gload = [&](int j) {
    const int krow0 = j == 0 ? METAROW : b * SEQ + (j - 1) * 64;
    { int i = tid; int r = i / 12, c = i % 12; kreg0 = c < 8 ? *(const u32x4*)(KN + (size_t)(krow0 + r) * 512 + hh * 64 + c * 8) : *(const u32x4*)(KR + (size_t)(krow0 + r) * 32 + (c - 8) * 8); }
    if (tid < 256) { int i = tid + 512; int r = i / 12, c = i % 12; kreg1 = c < 8 ? *(const u32x4*)(KN + (size_t)(krow0 + r) * 512 + hh * 64 + c * 8) : *(const u32x4*)(KR + (size_t)(krow0 + r) * 32 + (c - 8) * 8); }
    { int v = tid >> 3, c = tid & 7; vreg = *(const u32x4*)(VT + (size_t)(hh * 64 + v) * MROWS + krow0 + c * 8); }
  };
  auto lstore = [&](int buf) {
    u16* kl = Kl + buf * 64 * KP; u16* vl = Vl + buf * 64 * VP;
    { int i = tid; int r = i / 12, c = i % 12; *(u32x4*)(kl + r * KP + c * 8) = kreg0; }
    if (tid < 256) { int i = tid + 512; int r = i / 12, c = i % 12; *(u32x4*)(kl + r * KP + c * 8) = kreg1; }
    { int v = tid >> 3, c = tid & 7; *(u32x4*)(vl + v * VP + c * 8) = vreg; }
  };
  __syncthreads();
  gload(0); lstore(0);
  for (int j = 0; j < ntile; ++j) {
    __syncthreads();
    if (j + 1 < ntile) gload(j + 1);
    if (j <= mychunk) {
      const u16* kl = Kl + (j & 1) * 64 * KP; const u16* vl = Vl + (j & 1) * 64 * VP;
      const float ninit = (j == 0) ? 0.f : -mrun;
      f32x16 s0, s1; for (int i = 0; i < 16; ++i) { s0[i] = ninit; s1[i] = ninit; }
      for (int ks = 0; ks < 6; ++ks) {
        bf16x8 k0 = *(const bf16x8*)(kl + r31 * KP + 16 * ks + 8 * h2); bf16x8 k1 = *(const bf16x8*)(kl + (32 + r31) * KP + 16 * ks + 8 * h2);
        s0 = __builtin_amdgcn_mfma_f32_32x32x16_bf16(k0, qf[ks], s0, 0, 0, 0); s1 = __builtin_amdgcn_mfma_f32_32x32x16_bf16(k1, qf[ks], s1, 0, 0, 0);
      }
      if (j == 0) { for (int i = 8; i < 16; ++i) s0[i] = -INFINITY; for (int i = 0; i < 16; ++i) s1[i] = -INFINITY; }
      float mx = s0[0]; for (int i = 1; i < 16; ++i) mx = fmaxf(mx, s0[i]); for (int i = 0; i < 16; ++i) mx = fmaxf(mx, s1[i]);
      mx = fmaxf(mx, __shfl_xor(mx, 32));
      const float d = (j == 0) ? mx : fmaxf(mx, 0.f);
      float ps = 0.f;
      if (__any(d != 0.f)) {
        const float alpha = (j == 0) ? 1.f : __builtin_amdgcn_exp2f(-d);
        for (int i = 0; i < 16; ++i) { s0[i] = __builtin_amdgcn_exp2f(s0[i] - d); ps += s0[i]; s1[i] = __builtin_amdgcn_exp2f(s1[i] - d); ps += s1[i]; }
        lsum = lsum * alpha + ps;
        for (int i = 0; i < 16; ++i) { o0[i] *= alpha; o1[i] *= alpha; }
        mrun = (j == 0) ? d : mrun + d;
      } else {
        for (int i = 0; i < 16; ++i) { s0[i] = __builtin_amdgcn_exp2f(s0[i]); ps += s0[i]; s1[i] = __builtin_amdgcn_exp2f(s1[i]); ps += s1[i]; }
        lsum += ps;
      }
      for (int kt = 0; kt < 2; ++kt) for (int s = 0; s < 2; ++s) {
        u32x4 pp; for (int jj = 0; jj < 4; ++jj) pp[jj] = kt == 0 ? cvtpk_v(s0[8 * s + 2 * jj], s0[8 * s + 2 * jj + 1]) : cvtpk_v(s1[8 * s + 2 * jj], s1[8 * s + 2 * jj + 1]);
        bf16x8 pb = __builtin_bit_cast(bf16x8, pp);
        const int key0 = 32 * kt + 16 * s + 4 * h2;
        u32x2 a0 = *(const u32x2*)(vl + r31 * VP + key0), a1 = *(const u32x2*)(vl + r31 * VP + key0 + 8);
        u32x2 c0 = *(const u32x2*)(vl + (32 + r31) * VP + key0), c1 = *(const u32x2*)(vl + (32 + r31) * VP + key0 + 8);
        u32x4 va = {a0[0], a0[1], a1[0], a1[1]}, vc = {c0[0], c0[1], c1[0], c1[1]};
        o0 = __builtin_amdgcn_mfma_f32_32x32x16_bf16(__builtin_bit_cast(bf16x8, va), pb, o0, 0, 0, 0);
        o1 = __builtin_amdgcn_mfma_f32_32x32x16_bf16(__builtin_bit_cast(bf16x8, vc), pb, o1, 0, 0, 0);
      }
    }
    if (j + 1 < ntile) lstore((j + 1) & 1);
  }
  if (mychunk >= 0) {
    lsum += __shfl_xor(lsum, 32);
    const float inv = __builtin_amdgcn_rcpf(lsum);
    u16* orow = rest + (size_t)qrow * NREST + RC_CQ + hh * 64;
    for (int g = 0; g < 4; ++g) { const int v0 = 8 * g + 4 * h2;
      u32x2 w0; w0[0] = cvtpk_v(o0[4 * g] * inv, o0[4 * g + 1] * inv); w0[1] = cvtpk_v(o0[4 * g + 2] * inv, o0[4 * g + 3] * inv); *(u32x2*)(orow + v0) = w0;
      u32x2 w1; w1[0] = cvtpk_v(o1[4 * g] * inv, o1[4 * g + 1] * inv); w1[1] = cvtpk_v(o1[4 * g + 2] * inv, o1[4 * g + 3] * inv); *(u32x2*)(orow + 32 + v0) = w1; }
  }
}

template <class Epi>
DEVI void thin_gemm(unsigned char* lds, const Gemm g, int nN, const Epi& E, int wg0 = 0) { const int TX = opaque_tid();
  const int wid = __builtin_amdgcn_readfirstlane(TX >> 6), lane = TX & 63, fr = lane & 15, fq = lane >> 4;
  int K = g.K; asm volatile("" : "+s"(K));
  f32x4* P = (f32x4*)lds;
  for (int un = (int)((blockIdx.x + gridDim.x - wg0) % gridDim.x); un < nN * 4; un += gridDim.x) {
    const int pn = un >> 2, wc = un & 3;
    f32x4 pacc[4];
#pragma unroll
    for (int t = 0; t < 4; ++t) pacc[t] = (f32x4){0.f, 0.f, 0.f, 0.f};
    const u16* ap = g.A + (size_t)(METAROW + fr) * g.lda + fq * 8;
    const u16* bp = g.Bt + (size_t)(pn * 256 + wc * 32) * g.ldb + fq * 8;
    const unsigned o0 = (unsigned)(perm32(fr) * g.ldb), o1 = (unsigned)(perm32(16 + fr) * g.ldb);
#pragma unroll 4
    for (int k = wid * 32; k < K; k += 256) {
      const bf16x8 a = *(const bf16x8*)(ap + k);
      bf16x8 bv[4];
#pragma unroll
      for (int t = 0; t < 4; ++t) { const int bj = t >> 1, n = t & 1; bv[t] = *(const bf16x8*)(bp + (size_t)(bj * 128) * g.ldb + (n ? o1 : o0) + k); }
#pragma unroll
      for (int t = 0; t < 4; ++t) pacc[t] = __builtin_amdgcn_mfma_f32_16x16x32_bf16(bv[t], a, pacc[t], 0, 0, 0);
    }
    __syncthreads();
#pragma unroll
    for (int t = 0; t < 4; ++t) P[(wid * 4 + t) * 64 + lane] = pacc[t];
    __syncthreads();
    if (wid == 0) {
      f32x4 acc[2][2][4][2];
#pragma unroll
      for (int bj = 0; bj < 2; ++bj)
#pragma unroll
        for (int n = 0; n < 2; ++n) { f32x4 sum = {0.f, 0.f, 0.f, 0.f};
#pragma unroll
          for (int w = 0; w < 8; ++w) sum += P[(w * 4 + bj * 2 + n) * 64 + lane];
          acc[0][bj][0][n] = sum; }
      Unit u; u.pm = 128; u.pn = pn;
      E.template run<true>(acc, u, 0, wc, fr, fq);
    }
    __syncthreads();
  }
}
#define LDS3 ((LAS unsigned char*)lds)
constexpr size_t WS_SSQ = WS_GP + (size_t)MROWS * 8 * 4;
struct EpiIn {
  const float* rs; u8* gates; u16* rest; float* gp; float* ssq;
  DEVI void operator()(AccRef acc, const Unit& u, int wr, int wc, int fr, int fq) const { run<false>(acc, u, wr, wc, fr, fq); }
  template <bool THIN> DEVI void run(AccRef acc, const Unit& u, int wr, int wc, int fr, int fq) const {
    const int pn = u.pn;
    float rsv[2][4];
    EPI_ROWS({ rsv[ai][m] = rs[row]; })
    EPI_ROWS({ const float r = rsv[ai][m];
      _Pragma("unroll") for (int bj = 0; bj < 2; ++bj) { const int col0 = pn * 256 + bj * 128 + wc * 32 + 8 * fq;
        float x[8]; _Pragma("unroll") for (int e = 0; e < 4; ++e) { x[e] = acc[ai][bj][m][0][e] * r; x[4 + e] = acc[ai][bj][m][1][e] * r; }
        if (pn < 16) { unsigned b[8]; _Pragma("unroll") for (int e = 0; e < 8; ++e) b[e] = (unsigned)(sigm(x[e]) * 255.f + 0.5f);
          u32x2 o; o[0] = b[0] | (b[1] << 8) | (b[2] << 16) | (b[3] << 24); o[1] = b[4] | (b[5] << 8) | (b[6] << 16) | (b[7] << 24);
          *(u32x2*)(gates + (size_t)row * 4096 + col0) = o; }
        else { const int rc = col0 - 4096; u32x4 o; _Pragma("unroll") for (int e = 0; e < 4; ++e) o[e] = cvtpk_e(x[2 * e], x[2 * e + 1]);
          *(u32x4*)(rest + (size_t)row * NREST + rc) = o;
          if (rc == RC_MI) { *(f32x4*)(gp + (size_t)row * 8) = (f32x4){x[0], x[1], x[2], x[3]}; *(f32x4*)(gp + (size_t)row * 8 + 4) = (f32x4){x[4], x[5], x[6], x[7]}; }
          const int slot = pn == 24 ? bj : (pn == 25 ? (bj == 0 ? 2 : 3) : (pn == 26 && bj == 0 ? 4 : -1));
          if (slot >= 0) { float ss = 0.f; _Pragma("unroll") for (int e = 0; e < 8; ++e) ss += x[e] * x[e];
            ss += __shfl_xor(ss, 16); ss += __shfl_xor(ss, 32);
            if (fq == 0) ssq[(size_t)row * 20 + slot * 4 + wc] = ss; } } } })
  }
};
struct EpiQ {
  const float* ssq; const float* rope; u16* Q;
  DEVI void operator()(AccRef acc, const Unit& u, int wr, int wc, int fr, int fq) const { run<false>(acc, u, wr, wc, fr, fq); }
  template <bool THIN> DEVI void run(AccRef acc, const Unit& u, int wr, int wc, int fr, int fq) const {
    const float QS = 0.10206207261596577f * 1.4426950408889634f;
    constexpr int NA = THIN ? 1 : 2, NMM = THIN ? 1 : 4;
#pragma unroll
    for (int ai = 0; ai < NA; ++ai) {
      float ssv[NMM];
#pragma unroll
      for (int m = 0; m < NMM; ++m) { const int row = u.pm * 256 + ai * 128 + wr * 64 + m * 16 + fr; const float* sp = ssq + (size_t)row * 20;
        const f32x4 s0 = *(const f32x4*)sp, s1 = *(const f32x4*)(sp + 4), s2 = *(const f32x4*)(sp + 8);
        ssv[m] = (s0[0] + s0[1] + s0[2] + s0[3]) + (s1[0] + s1[1] + s1[2] + s1[3]) + (s2[0] + s2[1] + s2[2] + s2[3]); }
#pragma unroll
      for (int m = 0; m < NMM; ++m) { const int row = u.pm * 256 + ai * 128 + wr * 64 + m * 16 + fr;
        const float sc = rsqrtf(ssv[m] * (1.f / 384.f) + EPS) * QS; const int pos = row_pos(row);
#pragma unroll
        for (int bj = 0; bj < 2; ++bj) { const int cb = u.pn * 256 + bj * 128 + wc * 32, col0 = cb + 8 * fq;
          float x[8];
#pragma unroll
          for (int e = 0; e < 4; ++e) { x[e] = acc[ai][bj][m][0][e] * sc; x[4 + e] = acc[ai][bj][m][1][e] * sc; }
          if ((cb % 96) == 64) {
#pragma unroll
            for (int e = 0; e < 8; ++e) { const float other = __shfl_xor(x[e], 32); const int i = 8 * (fq & 1) + e;
              const float c = rope[(pos * 16 + i) * 2], s = rope[(pos * 16 + i) * 2 + 1];
              x[e] = fq < 2 ? x[e] * c - other * s : x[e] * c + other * s; } }
          u32x4 o;
#pragma unroll
          for (int e = 0; e < 4; ++e) o[e] = cvtpk_e(x[2 * e], x[2 * e + 1]);
          *(u32x4*)(Q + (size_t)row * 768 + col0) = o; }
        __builtin_amdgcn_sched_barrier(0); }
    }
  }
};
struct EpiKV {
  const float* ssq; u16* KN; u16* VT;
  DEVI void operator()(AccRef acc, const Unit& u, int wr, int wc, int fr, int fq) const { run<false>(acc, u, wr, wc, fr, fq); }
  template <bool THIN> DEVI void run(AccRef acc, const Unit& u, int wr, int wc, int fr, int fq) const {
    constexpr int NA = THIN ? 1 : 2, NMM = THIN ? 1 : 4;
#pragma unroll
    for (int ai = 0; ai < NA; ++ai) {
      float ssv[NMM];
#pragma unroll
      for (int m = 0; m < NMM; ++m) { const int row = u.pm * 256 + ai * 128 + wr * 64 + m * 16 + fr; const float* sp = ssq + (size_t)row * 20 + 12;
        const f32x4 s0 = *(const f32x4*)sp, s1 = *(const f32x4*)(sp + 4);
        ssv[m] = (s0[0] + s0[1] + s0[2] + s0[3]) + (s1[0] + s1[1] + s1[2] + s1[3]); }
#pragma unroll
      for (int m = 0; m < NMM; ++m) { const int row = u.pm * 256 + ai * 128 + wr * 64 + m * 16 + fr;
        const float sc = rsqrtf(ssv[m] * (1.f / 256.f) + EPS);
#pragma unroll
        for (int bj = 0; bj < 2; ++bj) { const int col0 = u.pn * 256 + bj * 128 + wc * 32 + 8 * fq, hd = col0 >> 7, d0 = col0 & 127;
          float x[8];
#pragma unroll
          for (int e = 0; e < 4; ++e) { x[e] = acc[ai][bj][m][0][e] * sc; x[4 + e] = acc[ai][bj][m][1][e] * sc; }
          if (d0 < 64) { u32x4 o;
#pragma unroll
            for (int e = 0; e < 4; ++e) o[e] = cvtpk_e(x[2 * e], x[2 * e + 1]);
            *(u32x4*)(KN + (size_t)row * 512 + hd * 64 + d0) = o; }
          else {
#pragma unroll
            for (int e = 0; e < 8; ++e) VT[(size_t)(hd * 64 + d0 - 64 + e) * MROWS + row] = (u16)cvtpk_e(x[e], x[e]); } }
        __builtin_amdgcn_sched_barrier(0); }
    }
  }
};
struct EpiGlu {
  u16* rest;
  DEVI void operator()(AccRef acc, const Unit& u, int wr, int wc, int fr, int fq) const { run<false>(acc, u, wr, wc, fr, fq); }
  template <bool THIN> DEVI void run(AccRef acc, const Unit& u, int wr, int wc, int fr, int fq) const {
    EPI_ROWS({ float x[8]; _Pragma("unroll") for (int e = 0; e < 4; ++e) { x[e] = acc[ai][0][m][0][e] * sigm(acc[ai][1][m][0][e]); x[4 + e] = acc[ai][0][m][1][e] * sigm(acc[ai][1][m][1][e]); }
      u32x4 o; _Pragma("unroll") for (int e = 0; e < 4; ++e) o[e] = cvtpk_e(x[2 * e], x[2 * e + 1]);
      *(u32x4*)(rest + (size_t)row * NREST + RC_SU + u.pn * 128 + wc * 32 + 8 * fq) = o; })
  }
};
struct EpiMerge {
  const u8* gates; u16* mg; int bi;
  DEVI void operator()(AccRef acc, const Unit& u, int wr, int wc, int fr, int fq) const { run<false>(acc, u, wr, wc, fr, fq); }
  template <bool THIN> DEVI void run(AccRef acc, const Unit& u, int wr, int wc, int fr, int fq) const {
    constexpr int NA = THIN ? 1 : 2, NMM = THIN ? 1 : 4;
    u32x2 gb[NA][NMM][2];
#pragma unroll
    for (int ai = 0; ai < NA; ++ai)
#pragma unroll
      for (int m = 0; m < NMM; ++m)
#pragma unroll
        for (int bj = 0; bj < 2; ++bj) { const int row = u.pm * 256 + ai * 128 + wr * 64 + m * 16 + fr, col0 = u.pn * 256 + bj * 128 + wc * 32 + 8 * fq;
          gb[ai][m][bj] = *(const u32x2*)(gates + (size_t)row * 4096 + bi * 1024 + col0); }
#pragma unroll
    for (int ai = 0; ai < NA; ++ai) {
      u32x4 old[NMM][2];
#pragma unroll
      for (int m = 0; m < NMM; ++m)
#pragma unroll
        for (int bj = 0; bj < 2; ++bj) { const int row = u.pm * 256 + ai * 128 + wr * 64 + m * 16 + fr, col0 = u.pn * 256 + bj * 128 + wc * 32 + 8 * fq;
          old[m][bj] = bi ? *(const u32x4*)(mg + (size_t)row * 1024 + col0) : (u32x4){0, 0, 0, 0}; }
#pragma unroll
      for (int m = 0; m < NMM; ++m)
#pragma unroll
        for (int bj = 0; bj < 2; ++bj) { const int row = u.pm * 256 + ai * 128 + wr * 64 + m * 16 + fr, col0 = u.pn * 256 + bj * 128 + wc * 32 + 8 * fq;
          float x[8];
#pragma unroll
          for (int e = 0; e < 8; ++e) { const float g = (float)((gb[ai][m][bj][e >> 2] >> (8 * (e & 3))) & 255u) * (1.f / 255.f); x[e] = g * (e < 4 ? acc[ai][bj][m][0][e] : acc[ai][bj][m][1][e - 4]); }
#pragma unroll
          for (int e = 0; e < 4; ++e) { x[2 * e] += blo(old[m][bj][e]); x[2 * e + 1] += bhi(old[m][bj][e]); }
          u32x4 o;
#pragma unroll
          for (int e = 0; e < 4; ++e) o[e] = cvtpk_e(x[2 * e], x[2 * e + 1]);
          *(u32x4*)(mg + (size_t)row * 1024 + col0) = o; }
    }
  }
};
template <int MODE> struct EpiPlain {
  const float* rs; u16* out; int ldo;
  DEVI void operator()(AccRef acc, const Unit& u, int wr, int wc, int fr, int fq) const { run<false>(acc, u, wr, wc, fr, fq); }
  template <bool THIN> DEVI void run(AccRef acc, const Unit& u, int wr, int wc, int fr, int fq) const {
    float rsv[2][4];
    EPI_ROWS({ rsv[ai][m] = MODE == 1 ? rs[row] : 1.f; })
    EPI_ROWS({ const float r = rsv[ai][m];
      _Pragma("unroll") for (int bj = 0; bj < 2; ++bj) { const int col0 = u.pn * 256 + bj * 128 + wc * 32 + 8 * fq;
        float x[8]; _Pragma("unroll") for (int e = 0; e < 4; ++e) { x[e] = acc[ai][bj][m][0][e]; x[4 + e] = acc[ai][bj][m][1][e]; }
        if (MODE == 1) { _Pragma("unroll") for (int e = 0; e < 8; ++e) { float t = fmaxf(x[e] * r, 0.f); x[e] = t * t; } }
        u32x4 o; _Pragma("unroll") for (int e = 0; e < 4; ++e) o[e] = cvtpk_e(x[2 * e], x[2 * e + 1]);
        *(u32x4*)(out + (size_t)row * ldo + col0) = o; } })
  }
};
DEVI void phase_inproj(PRef p, unsigned char* lds) { unsigned char* const wsb = opq(p.ws);
  Gemm g{(const u16*)(wsb + WS_HB), (const u16*)(wsb + WS_W + W_IN), 1024, 1024, 1024};
  StaticOrder S; S.init(129, NIN / 256, gridDim.x, blockIdx.x);
  EpiIn E{(const float*)(wsb + WS_RS), wsb + WS_GATES, (u16*)(wsb + WS_REST), (float*)(wsb + WS_GP), (float*)(wsb + WS_SSQ)};
  gemm_phase(LDS3, g, S, E);
}
DEVI void phase_upq(PRef p, unsigned char* lds) { unsigned char* const wsb = opq(p.ws);
  Gemm g{(const u16*)(wsb + WS_REST) + RC_CQ, (const u16*)(wsb + WS_W + W_UQ), NREST, 384, 384};
  StaticOrder S; S.init(129, 3, gridDim.x, blockIdx.x);
  EpiQ E{(const float*)(wsb + WS_SSQ), (const float*)(wsb + WS_ROPE), (u16*)(wsb + WS_Q)};
  gemm_phase(LDS3, g, S, E);
}
DEVI void phase_upkv(PRef p, unsigned char* lds) { unsigned char* const wsb = opq(p.ws);
  Gemm g{(const u16*)(wsb + WS_REST) + RC_CKV, (const u16*)(wsb + WS_W + W_UKV), NREST, 256, 256};
  StaticOrder S; S.init(128, 4, gridDim.x, blockIdx.x);
  EpiKV E{(const float*)(wsb + WS_SSQ), (u16*)(wsb + WS_KN), (u16*)(wsb + WS_VT)};
  thin_gemm(lds, g, S.nN, E);
  gemm_phase(LDS3, g, S, E);
}
DEVI void phase_glu(PRef p, unsigned char* lds, bool meta) { unsigned char* const wsb = opq(p.ws);
  Gemm g{(const u16*)(wsb + WS_REST) + RC_CV, (const u16*)(wsb + WS_W + W_GLU), NREST, 256, 256};
  StaticOrder S; S.init(128, 2, gridDim.x, blockIdx.x);
  EpiGlu E{(u16*)(wsb + WS_REST)};
  if (meta) thin_gemm(lds, g, S.nN, E);
  gemm_phase(LDS3, g, S, E);
}
DEVI void phase_merge(PRef p, unsigned char* lds, bool meta) { unsigned char* const wsb = opq(p.ws);
  const u16* rest = (const u16*)(wsb + WS_REST); const u16* Bt = (const u16*)(wsb + WS_W + W_BR);
  const int aoff[4] = {RC_CB, RC_CC, RC_SU, RC_CQ}; const int koff[4] = {0, 256, 512, 768}; const int kk[4] = {256, 256, 256, 512};
  StaticOrder S; S.init(128, 4, gridDim.x, blockIdx.x);
  for (int bi = 0; bi < 4; ++bi) {
    Gemm g{rest + aoff[bi], Bt + koff[bi], NREST, 1280, kk[bi]};
    EpiMerge E{wsb + WS_GATES, (u16*)(wsb + WS_MERGED), bi};
    if (meta) thin_gemm(lds, g, S.nN, E);
  gemm_phase(LDS3, g, S, E);
  }
}
template <int MODE> DEVI void phase_gemm_plain(PRef p, unsigned char* lds, const u16* A, int lda, const u16* Bt, int K, int N, u16* out, int ldo, bool meta) { unsigned char* const wsb = opq(p.ws);
  Gemm g{A, Bt, lda, K, K};
  StaticOrder S; S.init(128, N / 256, gridDim.x, blockIdx.x);
  EpiPlain<MODE> E{(const float*)(wsb + WS_RS), out, ldo};
  if (meta) thin_gemm(lds, g, S.nN, E);
  gemm_phase(LDS3, g, S, E);
}

#define XB_TMO      128
#define XB_XCNT(j)  (256  + 64 * (j))
#define XB_XSUB(j)  (1280 + 64 * (j))
#define XB_XGEN(j)  (2304 + 64 * (j))
#define XB_TOP      3328
#define XB_TOPGEN   3392
#define XCD_BAR_WORDS 3456
#define XB_SPIN_CAP (1u << 18)
DEVI unsigned xb_ld(unsigned* p) { return __hip_atomic_load(p, __ATOMIC_RELAXED, __HIP_MEMORY_SCOPE_AGENT); }
DEVI unsigned xb_add(unsigned* p, unsigned v) { return __hip_atomic_fetch_add(p, v, __ATOMIC_RELAXED, __HIP_MEMORY_SCOPE_AGENT); }
DEVI unsigned xb_xcc_id() { return (unsigned)__builtin_amdgcn_s_getreg((3 << 11) | 20) & 0xFu; }
#define XB_SPIN(cond, bar) do { unsigned _sp = 0; while (cond) { __builtin_amdgcn_s_sleep(1); \
    if ((++_sp & 255u) == 0u) { if (xb_ld(&(bar)[XB_TMO])) break; if (_sp > XB_SPIN_CAP) { atomicAdd(&(bar)[XB_TMO], 1u); break; } } } } while (0)
struct XcdBarrier { unsigned* bar; unsigned x; volatile __attribute__((address_space(3))) unsigned* st; };
DEVI XcdBarrier xcd_barrier_post(unsigned* bar, volatile __attribute__((address_space(3))) unsigned* st) {
  XcdBarrier b; b.bar = bar; b.x = xb_xcc_id(); b.st = st;
  if (threadIdx.x == 0) (void)xb_add(&bar[XB_XCNT(b.x)], 1u);
  return b;
}
DEVI void xcd_barrier_complete(unsigned* bar, unsigned x, unsigned& nloc, unsigned& nx) {
  const unsigned G = gridDim.x * gridDim.y * gridDim.z;
  unsigned sum, cnt, mine, sp = 0u;
  for (;;) {
    sum = 0u; cnt = 0u; mine = 0u;
#pragma unroll
    for (unsigned j = 0; j < 16; ++j) { const unsigned c = xb_ld(&bar[XB_XCNT(j)]); sum += c; cnt += (c > 0u) ? 1u : 0u; mine = (j == x) ? c : mine; }
    if (sum == G) break;
    __builtin_amdgcn_s_sleep(1);
    if ((++sp & 255u) == 0u) { if (xb_ld(&bar[XB_TMO])) break; if (sp > XB_SPIN_CAP) { atomicAdd(&bar[XB_TMO], 1u); break; } }
  }
  nloc = mine > 0u ? mine : 1u; nx = cnt > 0u ? cnt : 1u;
}
__device__ __attribute__((noinline)) void xcd_barrier(const XcdBarrier b) {
  asm volatile("s_waitcnt vmcnt(0)" ::: "memory");
  __syncthreads();
  if (threadIdx.x == 0) {
    unsigned* bar = b.bar;
    __builtin_amdgcn_s_waitcnt(0);
    unsigned nloc = b.st[0], nx = b.st[1];
    if (nloc == 0u) { xcd_barrier_complete(bar, b.x, nloc, nx); b.st[0] = nloc; b.st[1] = nx; }
    const unsigned old = xb_add(&bar[XB_XSUB(b.x)], 1u);
    const unsigned gen = old / nloc;
    if (old + 1u == (gen + 1u) * nloc) {
      __builtin_amdgcn_fence(__ATOMIC_RELEASE, "agent");
      asm volatile("s_waitcnt vmcnt(0)" ::: "memory");
      const unsigned og = xb_add(&bar[XB_TOP], 1u);
      const unsigned tg = og / nx;
      if (og + 1u == (tg + 1u) * nx) xb_add(&bar[XB_TOPGEN], 1u);
      else XB_SPIN(xb_ld(&bar[XB_TOPGEN]) == tg, bar);
      __builtin_amdgcn_fence(__ATOMIC_ACQUIRE, "agent");
      xb_add(&bar[XB_XGEN(b.x)], 1u);
      asm volatile("s_waitcnt vmcnt(0)" ::: "memory");
    } else {
      XB_SPIN(xb_ld(&bar[XB_XGEN(b.x)]) == gen, bar);
      __builtin_amdgcn_fence(__ATOMIC_ACQUIRE, "agent");
      asm volatile("s_waitcnt vmcnt(0)" ::: "memory");
    }
  }
  __syncthreads();
}

#ifndef PHM
#define PHM 0xFFFF
#endif
__global__ void __launch_bounds__(512, 2) mega(Params p_unused) {
#define p (*kparams())
  extern __shared__ __attribute__((aligned(16))) unsigned char lds[];
  cg::grid_group grid = cg::this_grid();
  unsigned* ctl = (unsigned*)(p.ws + WS_CTL);
  __shared__ uint4 s_misc;
  if (threadIdx.x == 0) s_misc = make_uint4(0u, 0u, 0u, 0u);
  __syncthreads();
  XcdBarrier xbar = xcd_barrier_post(ctl, (volatile __attribute__((address_space(3))) unsigned*)&s_misc);
  u16* W = (u16*)(p.ws + WS_W);
  if (PHM & 1) { prep_layer(p, 0, (float*)lds);
  phase0_act(p); }
  if (p.ws == nullptr) grid.sync();
  xcd_barrier(xbar);
  for (int l = 0; l < 2; ++l) {
    if (PHM & 2) phase_inproj(p, lds);
    xcd_barrier(xbar);
    if (PHM & 4) { phase_upq(p, lds);
    phase_upkv(p, lds); }
    if (PHM & 8) phase_conv(p, l);
    if (PHM & 16) s5_passA(p, l, lds);
    xcd_barrier(xbar);
    if (blockIdx.x < 32) mlstm_item(p, l, blockIdx.x >> 2, blockIdx.x & 3, lds);
    else if (blockIdx.x < 48) {
      s5_scan(p, l, 32);
      __threadfence(); __syncthreads();
      if (threadIdx.x == 0) __hip_atomic_fetch_add(ctl + 24 + l, 1u, __ATOMIC_RELEASE, __HIP_MEMORY_SCOPE_AGENT);
    }
    for (;;) {
      __syncthreads();
      if (threadIdx.x == 0) s_misc.z = atomicAdd(ctl + 16 + l, 1u);
      __syncthreads();
      int it = (int)s_misc.z;
      if (it >= 1032 + 513) break;
      if (it < 1024) { const int qb = 15 - it / 64, bh = it % 64; attn_item(p, bh >> 3, bh & 7, qb, false, lds); }
      else if (it < 1032) attn_item(p, 0, it - 1024, 0, true, lds);
      else { const int k = it - 1032;
        if (threadIdx.x == 0) { unsigned spins = 0; while (__hip_atomic_load(ctl + 24 + l, __ATOMIC_RELAXED, __HIP_MEMORY_SCOPE_AGENT) < 16u && ++spins < (1u << 22)) __builtin_amdgcn_s_sleep(2); }
        __syncthreads(); __builtin_amdgcn_fence(__ATOMIC_ACQUIRE, "agent");
        if (k == 0) s5_passB_item(p, l, 0, 0, lds); else s5_passB_item(p, l, (k - 1) >> 6, 1 + ((k - 1) & 63), lds); }
    }
    xcd_barrier(xbar);
    const bool meta_live = (l == 0);
    if (PHM & 512) phase_merge(p, lds, meta_live);
    xcd_barrier(xbar);
    if (PHM & 1024) phase_gemm_plain<0>(p, lds, (const u16*)(p.ws + WS_MERGED), 1024, W + W_OUT / 2, 1024, 1024, (u16*)(p.ws + WS_YOUT), 1024, meta_live);
    xcd_barrier(xbar);
    row_pass(p, (const u16*)(p.ws + WS_YOUT), l == 0 ? p.in[I_X] : p.out, p.in[I_NG] + (size_t)(l * 4 + 1) * DM, false);
    xcd_barrier(xbar);
    if (PHM & 4096) phase_gemm_plain<1>(p, lds, (const u16*)(p.ws + WS_HB), 1024, W + W_1 / 2, 1024, 4096, (u16*)(p.ws + WS_FF1), 4096, meta_live);
    xcd_barrier(xbar);
    if (PHM & 8192) phase_gemm_plain<0>(p, lds, (const u16*)(p.ws + WS_FF1), 4096, W + W_2 / 2, 4096, 1024, (u16*)(p.ws + WS_MERGED), 1024, meta_live);
    xcd_barrier(xbar);
    row_pass(p, (const u16*)(p.ws + WS_MERGED), p.out, p.in[I_NG] + (size_t)(l * 4 + 3) * DM, l == 1);
    if ((PHM & 1) && l == 0) prep_layer(p, 1, (float*)lds);
    xcd_barrier(xbar);
  }
}

#undef p
extern "C" void kernel_launch(void* const* d_in, const int* in_sizes, int n_in, void* d_out, int out_size, void* d_ws, size_t ws_size, hipStream_t stream) {
  static int grid = 0;
  if (grid == 0) {
    if (ws_size < WS_END) { fprintf(stderr, "workspace too small: %zu < %zu\n", ws_size, (size_t)WS_END); grid = -1; return; }
    int dev = 0, cus = 0, per_cu = 0;
    (void)hipGetDevice(&dev);
    (void)hipDeviceGetAttribute(&cus, hipDeviceAttributeMultiprocessorCount, dev);
    (void)hipFuncSetAttribute((const void*)mega, hipFuncAttributeMaxDynamicSharedMemorySize, LDS_BYTES);
    (void)hipOccupancyMaxActiveBlocksPerMultiprocessor(&per_cu, (const void*)mega, 512, LDS_BYTES);
    if (per_cu < 1) per_cu = 1;
    grid = cus * 1;
    (void)hipGetLastError();
  }
  if (grid < 0) return;
  (void)hipMemsetAsync((char*)d_ws + WS_CTL, 0, 32768, stream);
  Params p{};
  for (int i = 0; i < 24; ++i) p.in[i] = (const float*)d_in[i];
  p.out = (float*)d_out; p.ws = (unsigned char*)d_ws;
  void* args[] = {&p};
  hipError_t e = hipLaunchCooperativeKernel((const void*)mega, dim3(grid), dim3(512), args, LDS_BYTES, stream);
  if (e != hipSuccess) fprintf(stderr, "cooperative launch failed: %s (grid %d)\n", hipGetErrorString(e), grid);
}
```

```cpp
#include <hip/hip_runtime.h>
#include <hip/hip_cooperative_groups.h>
#include <cstdio>
namespace cg = cooperative_groups;

typedef unsigned short u16;
typedef unsigned char u8;
using bf16x8 = __attribute__((ext_vector_type(8))) short;
using s16x4 = __attribute__((ext_vector_type(4))) short;
using f32x4 = __attribute__((ext_vector_type(4))) float;
using f32x16 = __attribute__((ext_vector_type(16))) float;
using u32x4 = __attribute__((ext_vector_type(4))) unsigned;
using u32x2 = __attribute__((ext_vector_type(2))) unsigned;
#define DEVI __device__ __forceinline__

constexpr int DM = 1024, SEQ = 4096, NB = 8, NMETA = 16;
constexpr int MROWS = 33024, NREAL = 32768, METAROW = 32768;
constexpr int NIN = 6912, NREST = 2816, INW = 6824;
constexpr int RC_CB = 0, RC_CC = 256, RC_CV = 512, RC_MQ = 768, RC_MK = 1024, RC_MV = 1280, RC_MO = 1536, RC_SU = 1792,
              RC_CQ = 2048, RC_CKV = 2432, RC_KR = 2688, RC_MI = 2720;
constexpr float EPS = 1e-6f;
constexpr int NCH = 65;

constexpr size_t al256(size_t x) { return (x + 255) & ~(size_t)255; }
constexpr size_t WS_CTL = 0;
constexpr size_t WS_W = 32768;
constexpr size_t W_IN = 0, W_UQ = W_IN + (size_t)NIN * 1024 * 2, W_UKV = W_UQ + 768 * 384 * 2, W_GLU = W_UKV + 1024 * 256 * 2,
                 W_BR = W_GLU + 512 * 256 * 2, W_OUT = W_BR + 1024 * 1280 * 2, W_1 = W_OUT + 1024 * 1024 * 2, W_2 = W_1 + 4096 * 1024 * 2,
                 W_END = W_2 + 4096 * 1024 * 2;
constexpr size_t WS_GATES = al256(WS_W + W_END);
constexpr size_t WS_REST = al256(WS_GATES + (size_t)MROWS * 4096);
constexpr size_t WS_HB = al256(WS_REST + (size_t)MROWS * NREST * 2);
constexpr size_t WS_KN = al256(WS_HB + (size_t)MROWS * 1024 * 2);
constexpr size_t WS_KR = al256(WS_KN + (size_t)MROWS * 512 * 2);
constexpr size_t WS_VT = al256(WS_KR + (size_t)MROWS * 32 * 2);
constexpr size_t WS_RS = al256(WS_VT + (size_t)MROWS * 512 * 2);
constexpr size_t WS_HM = al256(WS_RS + (size_t)MROWS * 4);
constexpr size_t WS_S5 = al256(WS_HM + (size_t)256 * 1024 * 4);
constexpr size_t WS_ROPE = al256(WS_S5 + (size_t)(NB * NCH + 1) * 16 * 128 * 4);
constexpr size_t WS_GP = al256(WS_ROPE + (size_t)4112 * 16 * 8);
constexpr size_t WS_MSUM = al256(WS_GP + (size_t)MROWS * 8 * 4 + (size_t)MROWS * 20 * 4);
constexpr size_t WS_MSC = al256(WS_MSUM + (size_t)32 * NCH * 4160 * 2);
constexpr size_t WS_END = al256(WS_MSC + (size_t)32 * NCH * 4 * 4);
constexpr size_t WS_Q = WS_HB;
constexpr size_t WS_MERGED = WS_KN;
constexpr size_t WS_YOUT = WS_GATES;
constexpr size_t WS_FF1 = WS_GATES;
static_assert(WS_RS - WS_KN >= (size_t)MROWS * 1024 * 2, "merged alias");
static_assert(WS_HB - WS_GATES >= (size_t)MROWS * 4096 * 2, "ff1 alias");

constexpr int LDS_BYTES = 147456;
constexpr int LDS_MISC = 131072;

struct Params {
  const float* in[24];
  float* out;
  unsigned char* ws;
};
typedef const __attribute__((address_space(4))) Params& PRef;
DEVI const __attribute__((address_space(4))) Params* kparams() { auto k = __builtin_amdgcn_kernarg_segment_ptr(); asm volatile("" : "+s"(k)); return (const __attribute__((address_space(4))) Params*)k; }
enum { I_X = 0, I_META, I_NG, I_WIN, I_CONVW, I_GATEB, I_MNORM, I_ARE, I_AIM, I_LSTEP, I_BRE, I_BIM, I_CRE, I_CIM, I_SD, I_GLU,
       I_QN, I_KVN, I_WUQ, I_WUKV, I_WBR, I_WOUT, I_W1, I_W2 };

typedef __bf16 bf16x2_t __attribute__((ext_vector_type(2)));
DEVI unsigned cvtpk(float lo, float hi) { bf16x2_t v = {(__bf16)lo, (__bf16)hi}; return __builtin_bit_cast(unsigned, v); }
DEVI unsigned cvtpk_v(float lo, float hi) { unsigned r; asm volatile("v_cvt_pk_bf16_f32 %0, %1, %2\n\ts_nop 1" : "=v"(r) : "v"(lo), "v"(hi)); return r; }
DEVI u16 f2b(float f) { return (u16)(cvtpk(f, f) & 0xffffu); }
DEVI float b2f(u16 b) { return __uint_as_float(((unsigned)b) << 16); }
DEVI unsigned pack2(float a, float b) { return cvtpk(a, b); }
DEVI float blo(unsigned u) { return __uint_as_float(u << 16); }
DEVI float bhi(unsigned u) { return __uint_as_float(u & 0xffff0000u); }
DEVI float sigm(float x) { return __builtin_amdgcn_rcpf(1.f + __builtin_amdgcn_exp2f(-1.4426950408889634f * x)); }
DEVI float wave_sum(float v) { for (int o = 32; o > 0; o >>= 1) v += __shfl_xor(v, o); return v; }
DEVI int opaque_tid() { int t = threadIdx.x; asm volatile("" : "+v"(t)); return t; }
DEVI unsigned char* opq(unsigned char* p) { asm volatile("" : "+s"(p)); return p; }
DEVI int row_pos(int row) { return row < NREAL ? NMETA + (row & (SEQ - 1)) : row - METAROW; }

#define LAS __attribute__((address_space(3)))
constexpr int BM = 256, BK = 64, HALF = 128, HTB = HALF * BK * 2, NXCD = 8, WGM = 8;
DEVI int lds_byte(int r, int c) { const int st = (r >> 4) * 2 + (c >> 5), rr = r & 15, cc = c & 31, ob = rr * 64 + cc * 2; return st * 1024 + (ob ^ (((ob >> 9) & 1) << 5)); }
DEVI void stage_rc(int b, int& R, int& C) { const int st = b / 1024, sb = b % 1024, swz = sb ^ (((sb >> 9) & 1) << 5); R = (st >> 1) * 16 + swz / 64; C = (st & 1) * 32 + (swz % 64) / 2; }
DEVI int perm32(int rho) { const int n = rho >> 4, i = rho & 15; return 8 * (i >> 2) + 4 * n + (i & 3); }
struct Unit { int pm, pn; };
struct Gemm { const u16* A; const u16* Bt; int lda, ldb, K; };
struct StaticOrder {
  int nM, nN, nwg, G, c;
  DEVI void init(int nM_, int nN_, int G_, int c_) { nM = nM_; nN = nN_; nwg = nM * nN; G = G_; c = c_; }
  DEVI bool next(int i, Unit& u) const {
    const long L = (long)i * G + c; if (L >= nwg) return false;
    int wgid = (int)L; { const int q = nwg / NXCD, r = nwg % NXCD, xcd = wgid % NXCD, off = wgid / NXCD; wgid = (xcd < r ? xcd * (q + 1) : r * (q + 1) + (xcd - r) * q) + off; }
    const int nig = WGM * nN, gid = wgid / nig, fm = gid * WGM, gsz = (nM - fm) < WGM ? (nM - fm) : WGM;
    u.pm = fm + ((wgid % nig) % gsz); u.pn = (wgid % nig) / gsz; return true;
  }
};
template <class Epi>
DEVI void gemm_phase(LAS unsigned char* lds, const Gemm g, const StaticOrder& S, const Epi& E) { const int TX = opaque_tid();
  const int tid = TX, wid = __builtin_amdgcn_readfirstlane(tid >> 6), lane = tid & 63, wr = wid >> 2, wc = wid & 3, fr = lane & 15, fq = lane >> 4;
  int K = g.K; asm volatile("" : "+s"(K));
  const int nt = K / BK;
  unsigned voffA[2], voffB[2];
#pragma unroll
  for (int i = 0; i < 2; ++i) { int R, C; stage_rc(tid * 16 + i * 8192, R, C); const int Rb = (R & ~31) + perm32(R & 31);
    voffA[i] = (unsigned)(R * g.lda + C) * 2u; voffB[i] = (unsigned)(Rb * g.ldb + C) * 2u; }
  const size_t kstep = (size_t)(BK * 2);
  const size_t hstepA = (size_t)HALF * g.lda * 2, hstepB = (size_t)HALF * g.ldb * 2;
  const unsigned ldsw = (unsigned)wid * 1024u;
  const int aoff = lds_byte(wr * 64 + fr, fq * 8), boff = lds_byte(wc * 32 + fr, fq * 8);
#define PG8_SA(b, h) (((b) * 2 + (h)) * HTB)
#define PG8_SB(b, h) ((4 + (b) * 2 + (h)) * HTB)
#define PG8_STAGE(bufoff, gbase, voff) do { _Pragma("unroll") for (int _i = 0; _i < 2; ++_i) \
    __builtin_amdgcn_global_load_lds((const unsigned*)((const char*)(gbase) + (voff)[_i]), (LAS unsigned*)(lds + (bufoff) + ldsw + _i * 8192), 16, 0, 0); } while (0)
#define PG8_LDA(dst, b, h) do { _Pragma("unroll") for (int m = 0; m < 4; ++m) _Pragma("unroll") for (int k = 0; k < 2; ++k) dst[m][k] = *(const LAS bf16x8*)(lds + PG8_SA(b, h) + aoff + m * 2048 + k * 1024); } while (0)
#define PG8_LDB(dst, b, h) do { _Pragma("unroll") for (int n = 0; n < 2; ++n) _Pragma("unroll") for (int k = 0; k < 2; ++k) dst[n][k] = *(const LAS bf16x8*)(lds + PG8_SB(b, h) + boff + n * 2048 + k * 1024); } while (0)
#define PG8_MMA(ai, bj, At, Bt) do { __builtin_amdgcn_s_setprio(1); _Pragma("unroll") for (int m = 0; m < 4; ++m) _Pragma("unroll") for (int n = 0; n < 2; ++n) _Pragma("unroll") for (int k = 0; k < 2; ++k) \
    acc[ai][bj][m][n] = __builtin_amdgcn_mfma_f32_16x16x32_bf16(Bt[n][k], At[m][k], acc[ai][bj][m][n], 0, 0, 0); __builtin_amdgcn_s_setprio(0); } while (0)
#define PG8_WAIT_V(n) asm volatile("s_waitcnt vmcnt(" #n ")" ::: "memory")
#define PG8_WAIT_L(n) asm volatile("s_waitcnt lgkmcnt(" #n ")" ::: "memory")
#define PG8_BAR __builtin_amdgcn_s_barrier()
#define PG8_SCHED __builtin_amdgcn_sched_barrier(0)
  Unit cur, nxt; int ui = 0;
  if (!S.next(0, cur)) return;
  f32x4 acc[2][2][4][2];
#pragma unroll
  for (int a = 0; a < 2; ++a)
#pragma unroll
    for (int b = 0; b < 2; ++b)
#pragma unroll
      for (int m = 0; m < 4; ++m)
#pragma unroll
        for (int n = 0; n < 2; ++n) acc[a][b][m][n] = (f32x4){0.f, 0.f, 0.f, 0.f};
  bf16x8 At[4][2], B0[2][2], B1[2][2];
  const char* cA = (const char*)g.A + (size_t)cur.pm * 2 * hstepA; const char* cB = (const char*)g.Bt + (size_t)cur.pn * 2 * hstepB;
  PG8_STAGE(PG8_SB(0, 0), cB, voffB); PG8_STAGE(PG8_SA(0, 0), cA, voffA); PG8_STAGE(PG8_SB(0, 1), cB + hstepB, voffB); PG8_STAGE(PG8_SA(0, 1), cA + hstepA, voffA);
  if (wr == 1) PG8_BAR;
  PG8_WAIT_V(4); PG8_BAR;
  PG8_STAGE(PG8_SB(1, 0), cB + kstep, voffB); PG8_STAGE(PG8_SA(1, 0), cA + kstep, voffA); PG8_STAGE(PG8_SB(1, 1), cB + hstepB + kstep, voffB);
  PG8_WAIT_V(6); PG8_BAR;
  for (;;) {
    const bool has_next = S.next(ui + 1, nxt);
    const char* nA = has_next ? (const char*)g.A + (size_t)nxt.pm * 2 * hstepA : cA; const char* nB = has_next ? (const char*)g.Bt + (size_t)nxt.pn * 2 * hstepB : cB;
#pragma nounroll
    for (int t = 0; t < nt; t += 2) {
      const bool last = (t == nt - 2);
      const char* a1 = cA + (size_t)(t + 1) * kstep;
      const char* a2 = last ? nA : cA + (size_t)(t + 2) * kstep; const char* b2 = last ? nB : cB + (size_t)(t + 2) * kstep;
      const char* a3 = a2 + kstep; const char* b3 = b2 + kstep;
      PG8_LDB(B0, 0, 0); PG8_SCHED; PG8_LDA(At, 0, 0); PG8_STAGE(PG8_SA(1, 1), a1 + hstepA, voffA);
      PG8_WAIT_L(8); PG8_BAR; PG8_WAIT_L(0); PG8_MMA(0, 0, At, B0); PG8_BAR; PG8_SCHED;
      PG8_LDB(B1, 0, 1); PG8_STAGE(PG8_SB(0, 0), b2, voffB);
      PG8_BAR; PG8_WAIT_L(0); PG8_MMA(0, 1, At, B1); PG8_BAR;
      PG8_LDA(At, 0, 1); PG8_STAGE(PG8_SA(0, 0), a2, voffA);
      PG8_BAR; PG8_WAIT_L(0); PG8_MMA(1, 0, At, B0); PG8_BAR; PG8_SCHED;
      PG8_STAGE(PG8_SB(0, 1), b2 + hstepB, voffB);
      PG8_WAIT_V(6); PG8_BAR; PG8_MMA(1, 1, At, B1); PG8_BAR;
      PG8_LDB(B0, 1, 0); PG8_SCHED; PG8_LDA(At, 1, 0); PG8_STAGE(PG8_SA(0, 1), a2 + hstepA, voffA);
      PG8_WAIT_L(8); PG8_BAR; PG8_WAIT_L(0); PG8_MMA(0, 0, At, B0); PG8_BAR; PG8_SCHED;
      PG8_LDB(B1, 1, 1); PG8_STAGE(PG8_SB(1, 0), b3, voffB);
      PG8_BAR; PG8_WAIT_L(0); PG8_MMA(0, 1, At, B1); PG8_BAR;
      PG8_LDA(At, 1, 1); PG8_STAGE(PG8_SA(1, 0), a3, voffA);
      PG8_BAR; PG8_WAIT_L(0); PG8_MMA(1, 0, At, B0); PG8_BAR; PG8_SCHED;
      PG8_STAGE(PG8_SB(1, 1), b3 + hstepB, voffB);
      PG8_WAIT_V(6); PG8_BAR; PG8_MMA(1, 1, At, B1); PG8_BAR;
    }
    E(acc, cur, wr, wc, fr, fq);
    if (!has_next) break;
#pragma unroll
    for (int a = 0; a < 2; ++a)
#pragma unroll
      for (int b = 0; b < 2; ++b)
#pragma unroll
        for (int m = 0; m < 4; ++m)
#pragma unroll
          for (int n = 0; n < 2; ++n) acc[a][b][m][n] = (f32x4){0.f, 0.f, 0.f, 0.f};
    cur = nxt; cA = nA; cB = nB; ++ui;
  }
  PG8_WAIT_V(0);
  if (wr == 0) PG8_BAR;
  PG8_BAR;
#undef PG8_SA
#undef PG8_SB
#undef PG8_STAGE
#undef PG8_LDA
#undef PG8_LDB
#undef PG8_MMA
#undef PG8_WAIT_V
#undef PG8_WAIT_L
#undef PG8_BAR
#undef PG8_SCHED
}
typedef const f32x4 (&AccRef)[2][2][4][2];
DEVI unsigned cvtpk_e(float lo, float hi) { unsigned r; asm volatile("v_cvt_pk_bf16_f32 %0, %1, %2" : "=v"(r) : "v"(lo), "v"(hi)); return r; }
#define EPI_ROWS(...) _Pragma("unroll") for (int ai = 0; ai < (THIN ? 1 : 2); ++ai) _Pragma("unroll") for (int m = 0; m < (THIN ? 1 : 4); ++m) { const int row = u.pm * 256 + ai * 128 + wr * 64 + m * 16 + fr; __VA_ARGS__ }

template <int MAPT> DEVI int cmap(int n) {
  if (MAPT == 1) {
    if (n < 4096 + 1792) return n;
    int rc = n - 4096;
    if (rc < 2720) return 5896 + (rc - 1792);
    if (rc < 2728) return 5888 + (rc - 2720);
    return -1;
  } else if (MAPT == 2) {
    int nt = n >> 8, r = n & 255;
    return r < 128 ? nt * 128 + r : 256 + nt * 128 + (r - 128);
  }
  return n;
}
template <int MAPT> DEVI void prep_matrix(float* tile, const float* src, int K, int Nsrc, int Ndst, const float* g, u16* dst) { const int TX = opaque_tid();
  const int tk = K / 64, tn = Ndst / 64, tid = TX, ntile = tk * tn;
  float v[8];
  auto ld = [&](int t) { const int k0 = (t % tk) * 64, n0 = (t / tk) * 64;
    for (int i = 0; i < 8; ++i) { int idx = tid + i * 512, kk = idx >> 6, nn = idx & 63; int sc = cmap<MAPT>(n0 + nn);
      float x = sc >= 0 ? src[(size_t)(k0 + kk) * Nsrc + sc] : 0.f; if (g) x *= g[k0 + kk]; v[i] = x; } };
  int t = blockIdx.x;
  if (t < ntile) ld(t);
  for (; t < ntile; t += gridDim.x) {
    const int k0 = (t % tk) * 64, n0 = (t / tk) * 64;
    __syncthreads();
    for (int i = 0; i < 8; ++i) { int idx = tid + i * 512, kk = idx >> 6, nn = idx & 63; tile[kk * 65 + nn] = v[i]; }
    __syncthreads();
    if (t + (int)gridDim.x < ntile) ld(t + gridDim.x);
    { int nn = tid >> 3, k8 = (tid & 7) * 8; u32x4 o;
      for (int j = 0; j < 4; ++j) o[j] = pack2(tile[(k8 + 2 * j) * 65 + nn], tile[(k8 + 2 * j + 1) * 65 + nn]);
      *(u32x4*)(dst + (size_t)(n0 + nn) * K + k0 + k8) = o; }
  }
}
DEVI void prep_layer(PRef p, int l, float* tile) { unsigned char* const wsb = opq(p.ws);
  u16* W = (u16*)(wsb + WS_W);
  const float* ng = p.in[I_NG] + (size_t)l * 4 * DM;
  prep_matrix<1>(tile, p.in[I_WIN] + (size_t)l * DM * INW, 1024, INW, NIN, ng, W + W_IN / 2);
  prep_matrix<0>(tile, p.in[I_W1] + (size_t)l * DM * 4096, 1024, 4096, 4096, ng + 2 * DM, W + W_1 / 2);
  prep_matrix<0>(tile, p.in[I_W2] + (size_t)l * DM * 4096, 4096, 1024, 1024, nullptr, W + W_2 / 2);
  prep_matrix<0>(tile, p.in[I_WBR] + (size_t)l * 1280 * DM, 1280, 1024, 1024, nullptr, W + W_BR / 2);
  prep_matrix<0>(tile, p.in[I_WOUT] + (size_t)l * DM * DM, 1024, 1024, 1024, nullptr, W + W_OUT / 2);
  prep_matrix<0>(tile, p.in[I_WUQ] + (size_t)l * 384 * 768, 384, 768, 768, p.in[I_QN] + l * 384, W + W_UQ / 2);
  prep_matrix<0>(tile, p.in[I_WUKV] + (size_t)l * 256 * 1024, 256, 1024, 1024, p.in[I_KVN] + l * 256, W + W_UKV / 2);
  prep_matrix<2>(tile, p.in[I_GLU] + (size_t)l * 256 * 512, 256, 512, 512, nullptr, W + W_GLU / 2);
}

DEVI void phase0_act(PRef p) { const int TX = opaque_tid(); unsigned char* const wsb = opq(p.ws);
  const int lane = TX & 63, gw = blockIdx.x * 8 + (TX >> 6), NW = gridDim.x * 8;
  u16* hb = (u16*)(wsb + WS_HB); float* rs = (float*)(wsb + WS_RS); float* hm = (float*)(wsb + WS_HM);
  for (int row = gw; row < NREAL + NMETA; row += NW) {
    const float* src = row < NREAL ? p.in[I_X] + (size_t)row * DM : (row < METAROW + NMETA ? p.in[I_META] + (size_t)(row - METAROW) * DM : nullptr);
    float ss = 0.f;
    for (int i = 0; i < 4; ++i) {
      f32x4 v = src ? *(const f32x4*)(src + i * 256 + lane * 4) : (f32x4){0.f, 0.f, 0.f, 0.f};
      ss += v[0] * v[0] + v[1] * v[1] + v[2] * v[2] + v[3] * v[3];
      u32x2 o; o[0] = pack2(v[0], v[1]); o[1] = pack2(v[2], v[3]);
      *(u32x2*)(hb + (size_t)row * DM + i * 256 + lane * 4) = o;
      if (row >= NREAL) *(f32x4*)(hm + (size_t)(row - METAROW) * DM + i * 256 + lane * 4) = v;
    }
    ss = wave_sum(ss);
    if (lane == 0) rs[row] = rsqrtf(ss * (1.f / DM) + EPS);
  }
  float* rope = (float*)(wsb + WS_ROPE);
  for (int i = blockIdx.x * 512 + TX; i < 4112 * 16; i += gridDim.x * 512) {
    int pos = i >> 4, f = i & 15;
    float inv = exp2f(-(float)(2 * f) * (13.287712379549449f / 32.f));
    float ang = (float)pos * inv;
    rope[2 * i] = cosf(ang); rope[2 * i + 1] = sinf(ang);
  }
}

DEVI void row_pass(PRef p, const u16* y, const float* hsrc_real, const float* g, bool fin) { const int TX = opaque_tid(); unsigned char* const wsb = opq(p.ws);
  const int lane = TX & 63, gw = blockIdx.x * 8 + (TX >> 6), NW = gridDim.x * 8;
  u16* hb = (u16*)(wsb + WS_HB); float* rs = (float*)(wsb + WS_RS); float* hm = (float*)(wsb + WS_HM);
  const int NR = NREAL + NMETA;
  u32x2 yr[4]; f32x4 hr[4];
  if (gw < NR) { const float* hs = gw < NREAL ? hsrc_real + (size_t)gw * DM : hm + (size_t)(gw - METAROW) * DM;
    for (int i = 0; i < 4; ++i) { yr[i] = *(const u32x2*)(y + (size_t)gw * DM + i * 256 + lane * 4); hr[i] = *(const f32x4*)(hs + i * 256 + lane * 4); } }
  f32x4 gg[4]; for (int i = 0; i < 4; ++i) gg[i] = *(const f32x4*)(g + i * 256 + lane * 4);
  for (int row = gw; row < NR; row += NW) {
    const int nx = row + NW; u32x2 yn[4]; f32x4 hn[4];
    if (nx < NR) { const float* hs = nx < NREAL ? hsrc_real + (size_t)nx * DM : hm + (size_t)(nx - METAROW) * DM;
      for (int i = 0; i < 4; ++i) { yn[i] = *(const u32x2*)(y + (size_t)nx * DM + i * 256 + lane * 4); hn[i] = *(const f32x4*)(hs + i * 256 + lane * 4); } }
    float* hd = row < NREAL ? p.out + (size_t)row * DM : hm + (size_t)(row - METAROW) * DM;
    float yv[16]; float ss = 0.f;
    for (int i = 0; i < 4; ++i) { yv[4 * i] = blo(yr[i][0]); yv[4 * i + 1] = bhi(yr[i][0]); yv[4 * i + 2] = blo(yr[i][1]); yv[4 * i + 3] = bhi(yr[i][1]);
      for (int j = 0; j < 4; ++j) ss += yv[4 * i + j] * yv[4 * i + j]; }
    ss = wave_sum(ss);
    const float r = rsqrtf(ss * (1.f / DM) + EPS);
    float s2 = 0.f;
    for (int i = 0; i < 4; ++i) {
      f32x4 h = hr[i];
      for (int j = 0; j < 4; ++j) { h[j] += yv[4 * i + j] * r * gg[i][j]; s2 += h[j] * h[j]; }
      *(f32x4*)(hd + i * 256 + lane * 4) = h;
      if (!fin) { u32x2 o; o[0] = pack2(h[0], h[1]); o[1] = pack2(h[2], h[3]);
        *(u32x2*)(hb + (size_t)row * DM + i * 256 + lane * 4) = o; }
    }
    if (!fin) { s2 = wave_sum(s2);
      if (lane == 0) rs[row] = rsqrtf(s2 * (1.f / DM) + EPS); }
    for (int i = 0; i < 4; ++i) { yr[i] = yn[i]; hr[i] = hn[i]; }
  }
}

DEVI int prev_row(int t, int d) {
  if (t < NREAL) { int s = t & (SEQ - 1); return s >= d ? t - d : METAROW + NMETA + s - d; }
  int pp = t - METAROW; return pp >= d ? t - d : -1;
}
DEVI void phase_conv(PRef p, int l) { const int TX = opaque_tid(); unsigned char* const wsb = opq(p.ws);
  const int lane = TX & 63, gw = blockIdx.x * 8 + (TX >> 6), NW = gridDim.x * 8;
  u16* rest = (u16*)(wsb + WS_REST); u16* kr = (u16*)(wsb + WS_KR); const float* rope = (const float*)(wsb + WS_ROPE);
  const float* cw = p.in[I_CONVW] + (size_t)l * 3 * 256;
  float w0[4], w1[4], w2[4];
  for (int j = 0; j < 4; ++j) { w0[j] = cw[lane * 4 + j]; w1[j] = cw[256 + lane * 4 + j]; w2[j] = cw[512 + lane * 4 + j]; }
  auto ld = [&](int row, u32x2 (&d)[7]) {
    const u16* rr = rest + (size_t)row * NREST; const int r1 = prev_row(row, 1), r2 = prev_row(row, 2);
    d[0] = *(const u32x2*)(rr + RC_CB + lane * 4); d[1] = *(const u32x2*)(rr + RC_CC + lane * 4); d[2] = *(const u32x2*)(rr + RC_CV + lane * 4);
    d[3] = (u32x2){0, 0}; d[4] = d[3]; d[5] = d[3]; d[6] = d[3];
    if (r1 >= 0) { d[3] = *(const u32x2*)(rest + (size_t)r1 * NREST + RC_CC + lane * 4); d[4] = *(const u32x2*)(rest + (size_t)r1 * NREST + RC_CV + lane * 4); }
    if (r2 >= 0) { d[5] = *(const u32x2*)(rest + (size_t)r2 * NREST + RC_CC + lane * 4); d[6] = *(const u32x2*)(rest + (size_t)r2 * NREST + RC_CV + lane * 4); } };
  const int NR = NREAL + NMETA;
  u32x2 cur[7]; unsigned kcur = 0;
  if (gw < NR) { ld(gw, cur); if (lane < 32) kcur = rest[(size_t)gw * NREST + RC_KR + lane]; }
  for (int row = gw; row < NR; row += NW) {
    const int nx = row + NW; u32x2 nxt[7]; unsigned knx = 0;
    if (nx < NR) { ld(nx, nxt); if (lane < 32) knx = rest[(size_t)nx * NREST + RC_KR + lane]; }
    u16* rr = rest + (size_t)row * NREST;
    float o[4];
    for (int j = 0; j < 4; ++j) {
      unsigned a0 = cur[1][j >> 1], b0 = cur[2][j >> 1], a1 = cur[3][j >> 1], b1 = cur[4][j >> 1], a2 = cur[5][j >> 1], b2 = cur[6][j >> 1], g = cur[0][j >> 1];
      float u0 = (j & 1) ? bhi(a0) * bhi(b0) : blo(a0) * blo(b0);
      float u1 = (j & 1) ? bhi(a1) * bhi(b1) : blo(a1) * blo(b1);
      float u2 = (j & 1) ? bhi(a2) * bhi(b2) : blo(a2) * blo(b2);
      float gg = (j & 1) ? bhi(g) : blo(g);
      o[j] = gg * (w0[j] * u2 + w1[j] * u1 + w2[j] * u0);
    }
    u32x2 ov; ov[0] = pack2(o[0], o[1]); ov[1] = pack2(o[2], o[3]);
    *(u32x2*)(rr + RC_CB + lane * 4) = ov;
    { const int pos = row_pos(row);
      const float xm = b2f((u16)kcur), xo = b2f((u16)__shfl_xor((int)kcur, 16));
      if (lane < 32) { const int f = lane & 15; const float c = rope[(pos * 16 + f) * 2], sn = rope[(pos * 16 + f) * 2 + 1];
        kr[(size_t)row * 32 + lane] = f2b(lane < 16 ? xm * c - xo * sn : xm * c + xo * sn); } }
    for (int i = 0; i < 7; ++i) cur[i] = nxt[i]; kcur = knx;
  }
}

DEVI void chunk_rows(int b, int c, int& row0, int& len) { if (c == 0) { row0 = METAROW; len = NMETA; } else { row0 = b * SEQ + (c - 1) * 64; len = 64; } }
struct S5Const { float lr, li; float bre[16], bim[16]; };
DEVI void s5_consts(PRef p, int l, int g, int pp, S5Const& k) {
  const float are = p.in[I_ARE][(l * 16 + g) * 64 + pp], aim = p.in[I_AIM][(l * 16 + g) * 64 + pp];
  const float dt = expf(p.in[I_LSTEP][l * 16 + g]);
  const float mag = expf(are * dt);
  k.lr = mag * cosf(aim * dt); k.li = mag * sinf(aim * dt);
  const float den = are * are + aim * aim, xr = k.lr - 1.f, xi = k.li;
  const float zr = (xr * are + xi * aim) / den, zi = (xi * are - xr * aim) / den;
  const float* br = p.in[I_BRE] + ((size_t)(l * 16 + g) * 64 + pp) * 16; const float* bi = p.in[I_BIM] + ((size_t)(l * 16 + g) * 64 + pp) * 16;
  for (int i = 0; i < 16; ++i) { float a = br[i], b = bi[i]; k.bre[i] = zr * a - zi * b; k.bim[i] = zr * b + zi * a; }
}
DEVI void s5_load_u(PRef p, float* ul, int row0, int len) { const int TX = opaque_tid(); unsigned char* const wsb = opq(p.ws);
  const u16* rest = (const u16*)(wsb + WS_REST);
  for (int i = TX; i < 64 * 32; i += 512) { int r = i >> 5, c8 = (i & 31) * 8;
    u32x4 v = {0, 0, 0, 0}; if (r < len) v = *(const u32x4*)(rest + (size_t)(row0 + r) * NREST + RC_SU + c8);
    *(f32x4*)(ul + r * 256 + c8) = (f32x4){blo(v[0]), bhi(v[0]), blo(v[1]), bhi(v[1])}; *(f32x4*)(ul + r * 256 + c8 + 4) = (f32x4){blo(v[2]), bhi(v[2]), blo(v[3]), bhi(v[3])}; }
}
DEVI void s5_bu(const float* urow, const S5Const& k, float& bur, float& bui) {
  bur = 0.f; bui = 0.f;
#pragma unroll
  for (int q = 0; q < 4; ++q) { const f32x4 x = *(const f32x4*)(urow + 4 * q);
#pragma unroll
    for (int i = 0; i < 4; ++i) { bur += k.bre[4 * q + i] * x[i]; bui += k.bim[4 * q + i] * x[i]; } }
}
DEVI void s5_passA(PRef p, int l, unsigned char* lds) { const int TX = opaque_tid(); unsigned char* const wsb = opq(p.ws);
  u16* ulb = (u16*)lds; float* buL = (float*)(lds + 32768); float* send = (float*)(wsb + WS_S5);
  const u16* rest = (const u16*)(wsb + WS_REST);
  const int wave = TX >> 6, lane = TX & 63, fr = lane & 15, fq = lane >> 4;
  float* bw = buL + wave * 16 * 132;
  for (int it = blockIdx.x; it < NB * 64 + 1; it += gridDim.x) {
    const int b = it < NB * 64 ? it >> 6 : 0, c = it < NB * 64 ? 1 + (it & 63) : 0; int row0, len; chunk_rows(b, c, row0, len);
    __syncthreads();
    for (int i = TX; i < 64 * 32; i += 512) { int r = i >> 5, c8 = (i & 31) * 8;
      u32x4 v = {0, 0, 0, 0}; if (r < len) v = *(const u32x4*)(rest + (size_t)(row0 + r) * NREST + RC_SU + c8);
      *(u32x4*)(ulb + r * 256 + c8) = v; }
    __syncthreads();
    for (int gi = 0; gi < 2; ++gi) { const int g = wave * 2 + gi;
      const float are = p.in[I_ARE][(l * 16 + g) * 64 + lane], aim = p.in[I_AIM][(l * 16 + g) * 64 + lane];
      const float dt = expf(p.in[I_LSTEP][l * 16 + g]); const float mag = expf(are * dt);
      const float lr = mag * cosf(aim * dt), li = mag * sinf(aim * dt);
      { const float den = are * are + aim * aim, xr = lr - 1.f, xi = li;
        __builtin_amdgcn_wave_barrier();
        bw[lane] = (xr * are + xi * aim) / den; bw[64 + lane] = (xi * are - xr * aim) / den;
        __builtin_amdgcn_wave_barrier(); }
      bf16x8 bfr[4], bfi[4];
#pragma unroll
      for (int nt = 0; nt < 4; ++nt) { const int ps = 16 * nt + fr; const float zr = bw[ps], zi = bw[64 + ps];
        u32x4 wr4 = {0, 0, 0, 0}, wi4 = {0, 0, 0, 0};
        if (fq < 2) { const float* br = p.in[I_BRE] + ((size_t)(l * 16 + g) * 64 + ps) * 16 + 8 * fq; const float* bi = p.in[I_BIM] + ((size_t)(l * 16 + g) * 64 + ps) * 16 + 8 * fq;
          const f32x4 r0 = *(const f32x4*)br, r1 = *(const f32x4*)(br + 4), i0 = *(const f32x4*)bi, i1 = *(const f32x4*)(bi + 4);
          wr4[0] = cvtpk(zr * r0[0] - zi * i0[0], zr * r0[1] - zi * i0[1]); wr4[1] = cvtpk(zr * r0[2] - zi * i0[2], zr * r0[3] - zi * i0[3]);
          wr4[2] = cvtpk(zr * r1[0] - zi * i1[0], zr * r1[1] - zi * i1[1]); wr4[3] = cvtpk(zr * r1[2] - zi * i1[2], zr * r1[3] - zi * i1[3]);
          wi4[0] = cvtpk(zr * i0[0] + zi * r0[0], zr * i0[1] + zi * r0[1]); wi4[1] = cvtpk(zr * i0[2] + zi * r0[2], zr * i0[3] + zi * r0[3]);
          wi4[2] = cvtpk(zr * i1[0] + zi * r1[0], zr * i1[1] + zi * r1[1]); wi4[3] = cvtpk(zr * i1[2] + zi * r1[2], zr * i1[3] + zi * r1[3]); }
        bfr[nt] = __builtin_bit_cast(bf16x8, wr4); bfi[nt] = __builtin_bit_cast(bf16x8, wi4); }
      float sr = 0.f, si = 0.f;
      for (int sb = 0; sb < len; sb += 16) {
        u32x4 au = {0, 0, 0, 0}; if (fq < 2) au = *(const u32x4*)(ulb + (sb + fr) * 256 + g * 16 + 8 * fq);
        const bf16x8 af = __builtin_bit_cast(bf16x8, au);
        __builtin_amdgcn_wave_barrier();
#pragma unroll
        for (int nt = 0; nt < 4; ++nt) { const f32x4 z4 = {0.f, 0.f, 0.f, 0.f};
          const f32x4 dr = __builtin_amdgcn_mfma_f32_16x16x32_bf16(af, bfr[nt], z4, 0, 0, 0), di = __builtin_amdgcn_mfma_f32_16x16x32_bf16(af, bfi[nt], z4, 0, 0, 0);
#pragma unroll
          for (int r = 0; r < 4; ++r) { bw[(4 * fq + r) * 132 + 16 * nt + fr] = dr[r]; bw[(4 * fq + r) * 132 + 64 + 16 * nt + fr] = di[r]; } }
        __builtin_amdgcn_wave_barrier();
        for (int tt = 0; tt < 16; ++tt) { const float bur = bw[tt * 132 + lane], bui = bw[tt * 132 + 64 + lane];
          float nr = lr * sr - li * si + bur, ni = lr * si + li * sr + bui; sr = nr; si = ni; }
      }
      float* o = send + ((size_t)(c == 0 ? NB * NCH : b * NCH + c) * 16 + g) * 128; o[lane] = sr; o[64 + lane] = si; }
  }
}
DEVI void s5_scan(PRef p, int l, int blk0) { const int TX = opaque_tid(); unsigned char* const wsb = opq(p.ws);
  float* send = (float*)(wsb + WS_S5);
  const int lane = TX & 63, gw = ((int)blockIdx.x - blk0) * 8 + (TX >> 6);
  if (gw < 0 || gw >= NB * 16) return;
  const int b = gw >> 4, g = gw & 15;
  const float are = p.in[I_ARE][(l * 16 + g) * 64 + lane], aim = p.in[I_AIM][(l * 16 + g) * 64 + lane];
  const float dt = expf(p.in[I_LSTEP][l * 16 + g]); const float mag = expf(are * dt);
  float l16r = mag * cosf(aim * dt), l16i = mag * sinf(aim * dt);
  for (int i = 0; i < 4; ++i) { float a = l16r * l16r - l16i * l16i, bb = l16r * l16i; l16r = a; l16i = bb + bb; }
  float l64r = l16r, l64i = l16i; for (int i = 0; i < 2; ++i) { float a = l64r * l64r - l64i * l64i, bb = l64r * l64i; l64r = a; l64i = bb + bb; }
  float sr = 0.f, si = 0.f;
  for (int c0 = 0; c0 < NCH; c0 += 5) {
    float er[5], ei[5];
    for (int i = 0; i < 5; ++i) { const float* e = send + ((size_t)((c0 + i) == 0 ? NB * NCH : b * NCH + c0 + i) * 16 + g) * 128; er[i] = e[lane]; ei[i] = e[64 + lane]; }
    for (int i = 0; i < 5; ++i) { float* e = send + ((size_t)(b * NCH + c0 + i) * 16 + g) * 128; e[lane] = sr; e[64 + lane] = si;
      const float pr = (c0 + i) == 0 ? l16r : l64r, pi = (c0 + i) == 0 ? l16i : l64i;
      const float nr = pr * sr - pi * si + er[i], ni = pr * si + pi * sr + ei[i]; sr = nr; si = ni; }
  }
}
DEVI void s5_passB_item(PRef p, int l, int b, int c, unsigned char* lds) { const int TX = opaque_tid(); unsigned char* const wsb = opq(p.ws);
  u16* ulb = (u16*)lds;
  unsigned* sst = (unsigned*)(lds + 32768);
  float* buL = (float*)(lds + 32768 + 34816);
  const float* send = (const float*)(wsb + WS_S5); u16* rest = (u16*)(wsb + WS_REST);
  const int wave = TX >> 6, lane = TX & 63, fr = lane & 15, fq = lane >> 4;
  int row0, len; chunk_rows(b, c, row0, len);
  __syncthreads();
  for (int i = TX; i < 64 * 32; i += 512) { int r = i >> 5, c8 = (i & 31) * 8;
    u32x4 v = {0, 0, 0, 0}; if (r < len) v = *(const u32x4*)(rest + (size_t)(row0 + r) * NREST + RC_SU + c8);
    *(u32x4*)(ulb + r * 256 + c8) = v; }
  __syncthreads();
  unsigned* sw = sst + wave * 16 * 68; float* bw = buL + wave * 16 * 132;
  for (int gi = 0; gi < 2; ++gi) { const int g = wave * 2 + gi;
    const float are = p.in[I_ARE][(l * 16 + g) * 64 + lane], aim = p.in[I_AIM][(l * 16 + g) * 64 + lane];
    const float dt = expf(p.in[I_LSTEP][l * 16 + g]); const float mag = expf(are * dt);
    const float lr = mag * cosf(aim * dt), li = mag * sinf(aim * dt);
    { const float den = are * are + aim * aim, xr = lr - 1.f, xi = li;
      __builtin_amdgcn_wave_barrier();
      bw[lane] = (xr * are + xi * aim) / den; bw[64 + lane] = (xi * are - xr * aim) / den;
      __builtin_amdgcn_wave_barrier(); }
    bf16x8 bfr[4], bfi[4];
#pragma unroll
    for (int nt = 0; nt < 4; ++nt) { const int ps = 16 * nt + fr; const float zr = bw[ps], zi = bw[64 + ps];
      u32x4 wr4 = {0, 0, 0, 0}, wi4 = {0, 0, 0, 0};
      if (fq < 2) { const float* br = p.in[I_BRE] + ((size_t)(l * 16 + g) * 64 + ps) * 16 + 8 * fq; const float* bi = p.in[I_BIM] + ((size_t)(l * 16 + g) * 64 + ps) * 16 + 8 * fq;
        const f32x4 r0 = *(const f32x4*)br, r1 = *(const f32x4*)(br + 4), i0 = *(const f32x4*)bi, i1 = *(const f32x4*)(bi + 4);
        wr4[0] = cvtpk(zr * r0[0] - zi * i0[0], zr * r0[1] - zi * i0[1]); wr4[1] = cvtpk(zr * r0[2] - zi * i0[2], zr * r0[3] - zi * i0[3]);
        wr4[2] = cvtpk(zr * r1[0] - zi * i1[0], zr * r1[1] - zi * i1[1]); wr4[3] = cvtpk(zr * r1[2] - zi * i1[2], zr * r1[3] - zi * i1[3]);
        wi4[0] = cvtpk(zr * i0[0] + zi * r0[0], zr * i0[1] + zi * r0[1]); wi4[1] = cvtpk(zr * i0[2] + zi * r0[2], zr * i0[3] + zi * r0[3]);
        wi4[2] = cvtpk(zr * i1[0] + zi * r1[0], zr * i1[1] + zi * r1[1]); wi4[3] = cvtpk(zr * i1[2] + zi * r1[2], zr * i1[3] + zi * r1[3]); }
      bfr[nt] = __builtin_bit_cast(bf16x8, wr4); bfi[nt] = __builtin_bit_cast(bf16x8, wi4); }
    const float* e0 = send + ((size_t)(b * NCH + c) * 16 + g) * 128; float sr = e0[lane], si = e0[64 + lane];
    bf16x8 cf[4];
    for (int ks = 0; ks < 4; ++ks) { const int p0 = (32 * ks + 8 * fq) >> 1;
      const f32x4 cr = *(const f32x4*)(p.in[I_CRE] + ((size_t)(l * 16 + g) * 16 + fr) * 64 + p0), ci = *(const f32x4*)(p.in[I_CIM] + ((size_t)(l * 16 + g) * 16 + fr) * 64 + p0);
      u32x4 t4; for (int j = 0; j < 4; ++j) t4[j] = cvtpk(cr[j], -ci[j]);
      cf[ks] = __builtin_bit_cast(bf16x8, t4); }
    const float dsk = p.in[I_SD][l * 256 + g * 16 + fr];
    for (int sb = 0; sb < len; sb += 16) {
      u32x4 au = {0, 0, 0, 0}; if (fq < 2) au = *(const u32x4*)(ulb + (sb + fr) * 256 + g * 16 + 8 * fq);
      const bf16x8 af = __builtin_bit_cast(bf16x8, au);
      __builtin_amdgcn_wave_barrier();
#pragma unroll
      for (int nt = 0; nt < 4; ++nt) { const f32x4 z4 = {0.f, 0.f, 0.f, 0.f};
        const f32x4 dr = __builtin_amdgcn_mfma_f32_16x16x32_bf16(af, bfr[nt], z4, 0, 0, 0), di = __builtin_amdgcn_mfma_f32_16x16x32_bf16(af, bfi[nt], z4, 0, 0, 0);
#pragma unroll
        for (int r = 0; r < 4; ++r) { bw[(4 * fq + r) * 132 + 16 * nt + fr] = dr[r]; bw[(4 * fq + r) * 132 + 64 + 16 * nt + fr] = di[r]; } }
      __builtin_amdgcn_wave_barrier();
      for (int tt = 0; tt < 16; ++tt) { const float bur = bw[tt * 132 + lane], bui = bw[tt * 132 + 64 + lane];
        float nr = lr * sr - li * si + bur, ni = lr * si + li * sr + bui; sr = nr; si = ni;
        sw[tt * 68 + lane] = cvtpk(sr, si); }
      __builtin_amdgcn_wave_barrier();
      f32x4 d = {0.f, 0.f, 0.f, 0.f};
      for (int ks = 0; ks < 4; ++ks) { bf16x8 a = *(const bf16x8*)(sw + fr * 68 + 16 * ks + 4 * fq); d = __builtin_amdgcn_mfma_f32_16x16x32_bf16(a, cf[ks], d, 0, 0, 0); }
      for (int r = 0; r < 4; ++r) { const int t = sb + 4 * fq + r; const float u = b2f(ulb[t * 256 + g * 16 + fr]);
        rest[(size_t)(row0 + t) * NREST + RC_CV + g * 16 + fr] = f2b(d[r] + dsk * u); }
    }
  }
}

constexpr int MP = 72;
DEVI void mlstm_item(PRef p, int l, int b, int h, unsigned char* lds) { const int TX = opaque_tid(); unsigned char* const wsb = opq(p.ws);
  u16* Qs = (u16*)lds; u16* Ks = Qs + 64 * MP; u16* KTs = Ks + 64 * MP; u16* VTs = KTs + 64 * MP; u16* Cs = VTs + 80 * MP; u16* Ps = Cs + 80 * MP; u16* Os = Ps + 64 * MP;
  float* Hs = (float*)(Os + 64 * MP);
  float* sa = Hs + 64 * 65; float* sM = sa + 64; float* swi = sM + 64; float* sem = swi + 64; float* sden = sem + 64; float* swr = sden + 64; float* sdec = swr + 64; u16* VTw = (u16*)(sdec + 64);
  u16* rest = (u16*)(wsb + WS_REST); const float* gp = (const float*)(wsb + WS_GP);
  const int tid = TX, wave = tid >> 6, lane = tid & 63, fr = lane & 15, fq = lane >> 4;
  const float gbi = p.in[I_GATEB][l * 8 + h], gbf = p.in[I_GATEB][l * 8 + 4 + h];
  const int mt = wave >> 1, nh = wave & 1;
  __syncthreads();
  for (int i = tid; i < 80 * MP; i += 512) { Cs[i] = 0; int r = i / MP; VTs[i] = (r == 64) ? (u16)0x3F80 : (u16)0; }
  __syncthreads();
  f32x4 cst[3]; for (int i = 0; i < 3; ++i) cst[i] = (f32x4){0.f, 0.f, 0.f, 0.f};
  float m_prev = 0.f;
  const int lr = tid >> 3, c8 = (tid & 7) * 8;
  u32x4 qn = {0, 0, 0, 0}, kn = qn, vn = qn, on = qn; float gin = 0.f, gfn = 0.f;
  { int row0, len; chunk_rows(b, 0, row0, len);
    if (lr < len) { const u16* rp = rest + (size_t)(row0 + lr) * NREST + h * 64 + c8;
      qn = *(const u32x4*)(rp + RC_MQ); kn = *(const u32x4*)(rp + RC_MK); vn = *(const u32x4*)(rp + RC_MV); on = *(const u32x4*)(rp + RC_MO); }
    if (wave == 0 && lane < len) { const float* g8 = gp + (size_t)(row0 + lane) * 8; gin = g8[h]; gfn = g8[4 + h]; } }
  for (int c = 0; c < NCH; ++c) {
    int row0, len; chunk_rows(b, c, row0, len);
    const float gic = gin, gfc = gfn;
    { u32x4 q = qn, k = kn, v = vn, o = on;
      if (c + 1 < NCH) { int r1, l1; chunk_rows(b, c + 1, r1, l1); qn = (u32x4){0, 0, 0, 0}; kn = qn; vn = qn; on = qn;
        if (lr < l1) { const u16* rp = rest + (size_t)(r1 + lr) * NREST + h * 64 + c8;
          qn = *(const u32x4*)(rp + RC_MQ); kn = *(const u32x4*)(rp + RC_MK); vn = *(const u32x4*)(rp + RC_MV); on = *(const u32x4*)(rp + RC_MO); }
        if (wave == 0 && lane < l1) { const float* g8 = gp + (size_t)(r1 + lane) * 8; gin = g8[h]; gfn = g8[4 + h]; } }
      for (int j = 0; j < 4; ++j) k[j] = pack2(blo(k[j]) * 0.125f, bhi(k[j]) * 0.125f);
      *(u32x4*)(Qs + lr * MP + c8) = q; *(u32x4*)(Ks + lr * MP + c8) = k; *(u32x4*)(Os + lr * MP + c8) = o;
      for (int j = 0; j < 4; ++j) { KTs[(c8 + 2 * j) * MP + lr] = (u16)(k[j] & 0xffff); KTs[(c8 + 2 * j + 1) * MP + lr] = (u16)(k[j] >> 16);
        VTs[(c8 + 2 * j) * MP + lr] = (u16)(v[j] & 0xffff); VTs[(c8 + 2 * j + 1) * MP + lr] = (u16)(v[j] >> 16); } }
    if (wave == 0) {
      float ig = -INFINITY, lf = 0.f;
      if (lane < len) { ig = gic + gbi; float x = gfc + gbf; lf = fminf(x, 0.f) - __logf(1.f + __expf(-fabsf(x))); }
      float bc = lf; for (int o = 1; o < 64; o <<= 1) { float t = __shfl_up(bc, o); if (lane >= o) bc += t; }
      float a = ig - bc;
      float pm = a; for (int o = 1; o < 64; o <<= 1) { float t = __shfl_up(pm, o); if (lane >= o) pm = fmaxf(pm, t); }
      float M = fmaxf(m_prev, pm);
      float Mlast = __shfl(M, 63), blast = __shfl(bc, 63);
      sa[lane] = a; sM[lane] = M; swi[lane] = __expf(m_prev - M); sem[lane] = __expf(-(bc + M)); swr[lane] = __expf(a - Mlast);
      if (lane == 0) sdec[0] = __expf(m_prev - Mlast);
      m_prev = blast + Mlast;
    }
    __syncthreads();
    {
      for (int i = tid; i < 80 * 8; i += 512) { const int v = i >> 3, r8 = (i & 7) * 8; u32x4 x = *(const u32x4*)(VTs + v * MP + r8); u32x4 o;
        for (int j = 0; j < 4; ++j) o[j] = cvtpk(blo(x[j]) * swr[r8 + 2 * j], bhi(x[j]) * swr[r8 + 2 * j + 1]);
        *(u32x4*)(VTw + v * MP + r8) = o; } }
    for (int ni = 0; ni < 2; ++ni) { const int nt = nh * 2 + ni; f32x4 s = {0.f, 0.f, 0.f, 0.f};
      for (int ks = 0; ks < 2; ++ks) { bf16x8 a = *(const bf16x8*)(Qs + (mt * 16 + fr) * MP + 32 * ks + 8 * fq); bf16x8 bb = *(const bf16x8*)(Ks + (nt * 16 + fr) * MP + 32 * ks + 8 * fq);
        s = __builtin_amdgcn_mfma_f32_16x16x32_bf16(a, bb, s, 0, 0, 0); }
      const int r = nt * 16 + fr; const float ar = sa[r];
      for (int j = 0; j < 4; ++j) { const int srow = mt * 16 + 4 * fq + j; float w = (r <= srow) ? __expf(ar - sM[srow]) : 0.f; Ps[srow * MP + r] = f2b(s[j] * w); } }
    __syncthreads();
    f32x4 a1[3], a2[3]; const int ntl[3] = {nh * 2, nh * 2 + 1, 4}; const int ncnt = nh == 0 ? 3 : 2;
    for (int i = 0; i < 3; ++i) { a1[i] = (f32x4){0.f, 0.f, 0.f, 0.f}; a2[i] = a1[i]; }
    for (int ks = 0; ks < 2; ++ks) { bf16x8 pa = *(const bf16x8*)(Ps + (mt * 16 + fr) * MP + 32 * ks + 8 * fq); bf16x8 qa = *(const bf16x8*)(Qs + (mt * 16 + fr) * MP + 32 * ks + 8 * fq);
      for (int i = 0; i < 3; ++i) if (i < ncnt) { bf16x8 vb = *(const bf16x8*)(VTs + (ntl[i] * 16 + fr) * MP + 32 * ks + 8 * fq); bf16x8 cb = *(const bf16x8*)(Cs + (ntl[i] * 16 + fr) * MP + 32 * ks + 8 * fq);
        a1[i] = __builtin_amdgcn_mfma_f32_16x16x32_bf16(pa, vb, a1[i], 0, 0, 0); a2[i] = __builtin_amdgcn_mfma_f32_16x16x32_bf16(qa, cb, a2[i], 0, 0, 0); } }
    if (nh == 0 && fr == 0) for (int j = 0; j < 4; ++j) { const int srow = mt * 16 + 4 * fq + j; sden[srow] = a1[2][j] + swi[srow] * a2[2][j]; }
    __syncthreads();
    for (int i = 0; i < 2; ++i) for (int j = 0; j < 4; ++j) { const int srow = mt * 16 + 4 * fq + j, v = ntl[i] * 16 + fr;
      float num = a1[i][j] + swi[srow] * a2[i][j]; float hv = num * __builtin_amdgcn_rcpf(fmaxf(fabsf(sden[srow]), sem[srow]));
      hv *= sigm(b2f(Os[srow * MP + v])); Hs[srow * 65 + v] = hv; }
    { const float dec = sdec[0];
      const int tm[3] = {mt, mt, 4}, tn[3] = {nh * 2, nh * 2 + 1, wave}; const int tc = wave < 4 ? 3 : 2;
      for (int i = 0; i < 3; ++i) if (i < tc) { f32x4 acc = cst[i] * dec;
        for (int ks = 0; ks < 2; ++ks) { bf16x8 va = *(const bf16x8*)(VTw + (tm[i] * 16 + fr) * MP + 32 * ks + 8 * fq);
          bf16x8 kb = *(const bf16x8*)(KTs + (tn[i] * 16 + fr) * MP + 32 * ks + 8 * fq);
          acc = __builtin_amdgcn_mfma_f32_16x16x32_bf16(va, kb, acc, 0, 0, 0); }
        cst[i] = acc; } }
    __syncthreads();
    { const int tm[3] = {mt, mt, 4}, tn[3] = {nh * 2, nh * 2 + 1, wave}; const int tc = wave < 4 ? 3 : 2;
      for (int i = 0; i < 3; ++i) if (i < tc) for (int j = 0; j < 4; ++j) Cs[(tm[i] * 16 + 4 * fq + j) * MP + tn[i] * 16 + fr] = f2b(cst[i][j]); }
    { float hv[8]; float ss = 0.f; for (int j = 0; j < 8; ++j) { hv[j] = Hs[lr * 65 + c8 + j]; ss += hv[j] * hv[j]; }
      ss += __shfl_xor(ss, 1); ss += __shfl_xor(ss, 2); ss += __shfl_xor(ss, 4);
      const float r = rsqrtf(ss * (1.f / 64.f) + EPS); const float* ng = p.in[I_MNORM] + l * 256 + h * 64 + c8;
      if (lr < len && (c > 0 || b == 0)) { u32x4 o; for (int j = 0; j < 4; ++j) o[j] = pack2(hv[2 * j] * r * ng[2 * j], hv[2 * j + 1] * r * ng[2 * j + 1]);
        *(u32x4*)(rest + (size_t)(row0 + lr) * NREST + RC_CC + h * 64 + c8) = o; } }
  }
}

constexpr int MREC = 4160;
DEVI void mlstm_gates(PRef p, int l, int h, int row0, int len, int lane, const float* gp, float& a, float& bc) {
  const float gbi = p.in[I_GATEB][l * 8 + h], gbf = p.in[I_GATEB][l * 8 + 4 + h];
  float ig = -INFINITY, lf = 0.f;
  if (lane < len) { const float* g8 = gp + (size_t)(row0 + lane) * 8; ig = g8[h] + gbi; float x = g8[4 + h] + gbf; lf = fminf(x, 0.f) - __logf(1.f + __expf(-fabsf(x))); }
  bc = lf; for (int o = 1; o < 64; o <<= 1) { float t = __shfl_up(bc, o); if (lane >= o) bc += t; }
  a = ig - bc;
}
DEVI void mlstm_stepA(PRef p, int l, int b, int h, int c, unsigned char* lds) { const int TX = opaque_tid(); unsigned char* const wsb = opq(p.ws);
  u16* KTs = (u16*)lds; u16* VTs = KTs + 64 * MP; float* swr = (float*)(VTs + 80 * MP);
  const u16* rest = (const u16*)(wsb + WS_REST); const float* gp = (const float*)(wsb + WS_GP);
  u16* rec = (u16*)(wsb + WS_MSUM) + (size_t)((b * 4 + h) * NCH + c) * MREC; float* msc = (float*)(wsb + WS_MSC) + (size_t)((b * 4 + h) * NCH + c) * 4;
  const int tid = TX, wave = tid >> 6, lane = tid & 63, fr = lane & 15, fq = lane >> 4, mt = wave >> 1, nh = wave & 1;
  int row0, len; chunk_rows(b, c, row0, len);
  const int lr = tid >> 3, c8 = (tid & 7) * 8;
  __syncthreads();
  for (int i = tid; i < 16 * MP; i += 512) VTs[64 * MP + i] = (i < MP) ? (u16)0x3F80 : (u16)0;
  { u32x4 k = {0, 0, 0, 0}, v = k;
    if (lr < len) { const u16* rp = rest + (size_t)(row0 + lr) * NREST + h * 64 + c8; k = *(const u32x4*)(rp + RC_MK); v = *(const u32x4*)(rp + RC_MV); }
    for (int j = 0; j < 4; ++j) { const unsigned kk = pack2(blo(k[j]) * 0.125f, bhi(k[j]) * 0.125f);
      KTs[(c8 + 2 * j) * MP + lr] = (u16)(kk & 0xffff); KTs[(c8 + 2 * j + 1) * MP + lr] = (u16)(kk >> 16);
      VTs[(c8 + 2 * j) * MP + lr] = (u16)(v[j] & 0xffff); VTs[(c8 + 2 * j + 1) * MP + lr] = (u16)(v[j] >> 16); } }
  if (wave == 0) { float a, bc; mlstm_gates(p, l, h, row0, len, lane, gp, a, bc);
    float mx = a; for (int o = 32; o > 0; o >>= 1) mx = fmaxf(mx, __shfl_xor(mx, o));
    swr[lane] = expf(a - mx);
    if (lane == 0) msc[1] = mx;
    if (lane == 63) msc[0] = bc; }
  __syncthreads();
  const int tm[3] = {mt, mt, 4}, tn[3] = {nh * 2, nh * 2 + 1, wave}; const int tc = wave < 4 ? 3 : 2;
  for (int i = 0; i < 3; ++i) if (i < tc) { f32x4 acc = {0.f, 0.f, 0.f, 0.f};
    for (int ks = 0; ks < 2; ++ks) { bf16x8 va = *(const bf16x8*)(VTs + (tm[i] * 16 + fr) * MP + 32 * ks + 8 * fq);
      for (int j = 0; j < 8; ++j) va[j] = (short)f2b(b2f((u16)va[j]) * swr[32 * ks + 8 * fq + j]);
      bf16x8 kb = *(const bf16x8*)(KTs + (tn[i] * 16 + fr) * MP + 32 * ks + 8 * fq);
      acc = __builtin_amdgcn_mfma_f32_16x16x32_bf16(va, kb, acc, 0, 0, 0); }
    for (int j = 0; j < 4; ++j) { const int v = tm[i] * 16 + 4 * fq + j; if (v <= 64) rec[v * 64 + tn[i] * 16 + fr] = f2b(acc[j]); } }
}
DEVI void mlstm_scan(PRef p) { const int TX = opaque_tid(); unsigned char* const wsb = opq(p.ws);
  if (TX >= 64) return;
  const int lane = TX;
  for (int it = blockIdx.x; it < 256; it += gridDim.x) {
    const int bh = it >> 3, vs = it & 7;
    u16* base = (u16*)(wsb + WS_MSUM) + (size_t)bh * NCH * MREC; float* msc = (float*)(wsb + WS_MSC) + (size_t)bh * NCH * 4;
    const bool hasn = (vs == 0) && lane < 8;
    float st[8], sn[8]; for (int j = 0; j < 8; ++j) { st[j] = 0.f; sn[j] = 0.f; }
    float m_prev = 0.f;
    for (int c0 = 0; c0 < NCH; c0 += 5) {
      u32x4 d[5], dn[5]; float bl[5], ml[5];
      for (int i = 0; i < 5; ++i) { u16* r = base + (size_t)(c0 + i) * MREC; d[i] = *(const u32x4*)(r + vs * 512 + lane * 8);
        dn[i] = hasn ? *(const u32x4*)(r + 4096 + lane * 8) : (u32x4){0, 0, 0, 0}; bl[i] = msc[(c0 + i) * 4]; ml[i] = msc[(c0 + i) * 4 + 1]; }
      for (int i = 0; i < 5; ++i) { u16* r = base + (size_t)(c0 + i) * MREC;
        u32x4 o; for (int j = 0; j < 4; ++j) o[j] = pack2(st[2 * j], st[2 * j + 1]); *(u32x4*)(r + vs * 512 + lane * 8) = o;
        if (hasn) { u32x4 on; for (int j = 0; j < 4; ++j) on[j] = pack2(sn[2 * j], sn[2 * j + 1]); *(u32x4*)(r + 4096 + lane * 8) = on; }
        if (vs == 0 && lane == 0) msc[(c0 + i) * 4 + 2] = m_prev;
        const float Mx = fmaxf(m_prev, ml[i]), f1 = expf(m_prev - Mx), f2 = expf(ml[i] - Mx);
        for (int j = 0; j < 4; ++j) { st[2 * j] = f1 * st[2 * j] + f2 * blo(d[i][j]); st[2 * j + 1] = f1 * st[2 * j + 1] + f2 * bhi(d[i][j]);
          sn[2 * j] = f1 * sn[2 * j] + f2 * blo(dn[i][j]); sn[2 * j + 1] = f1 * sn[2 * j + 1] + f2 * bhi(dn[i][j]); }
        m_prev = bl[i] + Mx; }
    }
  }
}
DEVI void mlstm_stepC(PRef p, int l, int b, int h, int c, unsigned char* lds) { const int TX = opaque_tid(); unsigned char* const wsb = opq(p.ws);
  u16* Qs = (u16*)lds; u16* Ks = Qs + 64 * MP; u16* VTs = Ks + 64 * MP; u16* Cs = VTs + 80 * MP; u16* Ps = Cs + 80 * MP; u16* Os = Ps + 64 * MP;
  float* Hs = (float*)(Os + 64 * MP);
  float* sa = Hs + 64 * 65; float* sM = sa + 64; float* swi = sM + 64; float* sem = swi + 64; float* sden = sem + 64;
  u16* rest = (u16*)(wsb + WS_REST); const float* gp = (const float*)(wsb + WS_GP);
  const u16* rec = (const u16*)(wsb + WS_MSUM) + (size_t)((b * 4 + h) * NCH + c) * MREC; const float* msc = (const float*)(wsb + WS_MSC) + (size_t)((b * 4 + h) * NCH + c) * 4;
  const int tid = TX, wave = tid >> 6, lane = tid & 63, fr = lane & 15, fq = lane >> 4;
  const int mt = wave >> 1, nh = wave & 1;
  int row0, len; chunk_rows(b, c, row0, len);
  const int lr = tid >> 3, c8 = (tid & 7) * 8;
  __syncthreads();
  for (int i = tid; i < 16 * MP; i += 512) { VTs[64 * MP + i] = (i < MP) ? (u16)0x3F80 : (u16)0; if (i >= MP) Cs[64 * MP + i] = 0; }
  { u32x4 q = {0, 0, 0, 0}, k = q, v = q, o = q;
    if (lr < len) { const u16* rp = rest + (size_t)(row0 + lr) * NREST + h * 64 + c8;
      q = *(const u32x4*)(rp + RC_MQ); k = *(const u32x4*)(rp + RC_MK); v = *(const u32x4*)(rp + RC_MV); o = *(const u32x4*)(rp + RC_MO); }
    const u32x4 cin = *(const u32x4*)(rec + lr * 64 + c8);
    for (int j = 0; j < 4; ++j) k[j] = pack2(blo(k[j]) * 0.125f, bhi(k[j]) * 0.125f);
    *(u32x4*)(Qs + lr * MP + c8) = q; *(u32x4*)(Ks + lr * MP + c8) = k; *(u32x4*)(Os + lr * MP + c8) = o; *(u32x4*)(Cs + lr * MP + c8) = cin;
    if (tid < 8) *(u32x4*)(Cs + 64 * MP + tid * 8) = *(const u32x4*)(rec + 4096 + tid * 8);
    for (int j = 0; j < 4; ++j) { VTs[(c8 + 2 * j) * MP + lr] = (u16)(v[j] & 0xffff); VTs[(c8 + 2 * j + 1) * MP + lr] = (u16)(v[j] >> 16); } }
  if (wave == 0) { float a, bc; mlstm_gates(p, l, h, row0, len, lane, gp, a, bc);
    const float m_prev = msc[2];
    float pm = a; for (int o = 1; o < 64; o <<= 1) { float t = __shfl_up(pm, o); if (lane >= o) pm = fmaxf(pm, t); }
    const float M = fmaxf(m_prev, pm);
    sa[lane] = a; sM[lane] = M; swi[lane] = expf(m_prev - M); sem[lane] = expf(-(bc + M)); }
  __syncthreads();
  for (int ni = 0; ni < 2; ++ni) { const int nt = nh * 2 + ni; f32x4 s = {0.f, 0.f, 0.f, 0.f};
    for (int ks = 0; ks < 2; ++ks) { bf16x8 a = *(const bf16x8*)(Qs + (mt * 16 + fr) * MP + 32 * ks + 8 * fq); bf16x8 bb = *(const bf16x8*)(Ks + (nt * 16 + fr) * MP + 32 * ks + 8 * fq);
      s = __builtin_amdgcn_mfma_f32_16x16x32_bf16(a, bb, s, 0, 0, 0); }
    const int r = nt * 16 + fr; const float ar = sa[r];
    for (int j = 0; j < 4; ++j) { const int srow = mt * 16 + 4 * fq + j; float w = (r <= srow) ? expf(ar - sM[srow]) : 0.f; Ps[srow * MP + r] = f2b(s[j] * w); } }
  __syncthreads();
  f32x4 a1[3], a2[3]; const int ntl[3] = {nh * 2, nh * 2 + 1, 4}; const int ncnt = nh == 0 ? 3 : 2;
  for (int i = 0; i < 3; ++i) { a1[i] = (f32x4){0.f, 0.f, 0.f, 0.f}; a2[i] = a1[i]; }
  for (int ks = 0; ks < 2; ++ks) { bf16x8 pa = *(const bf16x8*)(Ps + (mt * 16 + fr) * MP + 32 * ks + 8 * fq); bf16x8 qa = *(const bf16x8*)(Qs + (mt * 16 + fr) * MP + 32 * ks + 8 * fq);
    for (int i = 0; i < 3; ++i) if (i < ncnt) { bf16x8 vb = *(const bf16x8*)(VTs + (ntl[i] * 16 + fr) * MP + 32 * ks + 8 * fq); bf16x8 cb = *(const bf16x8*)(Cs + (ntl[i] * 16 + fr) * MP + 32 * ks + 8 * fq);
      a1[i] = __builtin_amdgcn_mfma_f32_16x16x32_bf16(pa, vb, a1[i], 0, 0, 0); a2[i] = __builtin_amdgcn_mfma_f32_16x16x32_bf16(qa, cb, a2[i], 0, 0, 0); } }
  if (nh == 0 && fr == 0) for (int j = 0; j < 4; ++j) { const int srow = mt * 16 + 4 * fq + j; sden[srow] = a1[2][j] + swi[srow] * a2[2][j]; }
  __syncthreads();
  for (int i = 0; i < 2; ++i) for (int j = 0; j < 4; ++j) { const int srow = mt * 16 + 4 * fq + j, v = ntl[i] * 16 + fr;
    float num = a1[i][j] + swi[srow] * a2[i][j]; float hv = num / fmaxf(fabsf(sden[srow]), sem[srow]);
    hv *= sigm(b2f(Os[srow * MP + v])); Hs[srow * 65 + v] = hv; }
  __syncthreads();
  { float hv[8]; float ss = 0.f; for (int j = 0; j < 8; ++j) { hv[j] = Hs[lr * 65 + c8 + j]; ss += hv[j] * hv[j]; }
    ss += __shfl_xor(ss, 1); ss += __shfl_xor(ss, 2); ss += __shfl_xor(ss, 4);
    const float r = rsqrtf(ss * (1.f / 64.f) + EPS); const float* ng = p.in[I_MNORM] + l * 256 + h * 64 + c8;
    if (lr < len) { u32x4 o; for (int j = 0; j < 4; ++j) o[j] = pack2(hv[2 * j] * r * ng[2 * j], hv[2 * j + 1] * r * ng[2 * j + 1]);
      *(u32x4*)(rest + (size_t)(row0 + lr) * NREST + RC_CC + h * 64 + c8) = o; } }
}

constexpr int KP = 104, VP = 72;
DEVI void attn_item(PRef p, int b, int hh, int qb, bool meta, unsigned char* lds) { const int TX = opaque_tid(); unsigned char* const wsb = opq(p.ws);
  u16* Kl = (u16*)lds;
  u16* Vl = Kl + 2 * 64 * KP;
  const u16* Q = (const u16*)(wsb + WS_Q); const u16* KN = (const u16*)(wsb + WS_KN); const u16* KR = (const u16*)(wsb + WS_KR); const u16* VT = (const u16*)(wsb + WS_VT);
  u16* rest = (u16*)(wsb + WS_REST);
  const int tid = TX, wave = tid >> 6, lane = tid & 63, r31 = lane & 31, h2 = lane >> 5;
  const int ntile = meta ? 1 : 4 * qb + 5;
  const int mychunk = meta ? (wave == 0 ? 0 : -1) : 4 * qb + 1 + (wave >> 1);
  const int qrow = meta ? METAROW + r31 : b * SEQ + qb * 256 + wave * 32 + r31;
  bf16x8 qf[6];
  for (int ks = 0; ks < 6; ++ks) qf[ks] = *(const bf16x8*)(Q + (size_t)qrow * 768 + hh * 96 + 16 * ks + 8 * h2);
  f32x16 o0, o1; for (int i = 0; i < 16; ++i) { o0[i] = 0.f; o1[i] = 0.f; }
  float mrun = 0.f, lsum = 0.f;
  u32x4 kreg0, kreg1, vreg;
  auto gload = [&](int j) {
    const int krow0 = j == 0 ? METAROW : b * SEQ + (j - 1) * 64;
    { int i = tid; int r = i / 12, c = i % 12; kreg0 = c < 8 ? *(const u32x4*)(KN + (size_t)(krow0 + r) * 512 + hh * 64 + c * 8) : *(const u32x4*)(KR + (size_t)(krow0 + r) * 32 + (c - 8) * 8); }
    if (tid < 256) { int i = tid + 512; int r = i / 12, c = i % 12; kreg1 = c < 8 ? *(const u32x4*)(KN + (size_t)(krow0 + r) * 512 + hh * 64 + c * 8) : *(const u32x4*)(KR + (size_t)(krow0 + r) * 32 + (c - 8) * 8); }
    { int v = tid >> 3, c = tid & 7; vreg = *(const u32x4*)(VT + (size_t)(hh * 64 + v) * MROWS + krow0 + c * 8); }
  };
  auto lstore = [&](int buf) {
    u16* kl = Kl + buf * 64 * KP; u16* vl = Vl + buf * 64 * VP;
    { int i = tid; int r = i / 12, c = i % 12; *(u32x4*)(kl + r * KP + c * 8) = kreg0; }
    if (tid < 256) { int i = tid + 512; int r = i / 12, c = i % 12; *(u32x4*)(kl + r * KP + c * 8) = kreg1; }
    { int v = tid >> 3, c = tid & 7; *(u32x4*)(vl + v * VP + c * 8) = vreg; }
  };
  __syncthreads();
  gload(0); lstore(0);
  for (int j = 0; j < ntile; ++j) {
    __syncthreads();
    if (j + 1 < ntile) gload(j + 1);
    if (j <= mychunk) {
      const u16* kl = Kl + (j & 1) * 64 * KP; const u16* vl = Vl + (j & 1) * 64 * VP;
      const float ninit = (j == 0) ? 0.f : -mrun;
      f32x16 s0, s1; for (int i = 0; i < 16; ++i) { s0[i] = ninit; s1[i] = ninit; }
      for (int ks = 0; ks < 6; ++ks) {
        bf16x8 k0 = *(const bf16x8*)(kl + r31 * KP + 16 * ks + 8 * h2); bf16x8 k1 = *(const bf16x8*)(kl + (32 + r31) * KP + 16 * ks + 8 * h2);
        s0 = __builtin_amdgcn_mfma_f32_32x32x16_bf16(k0, qf[ks], s0, 0, 0, 0); s1 = __builtin_amdgcn_mfma_f32_32x32x16_bf16(k1, qf[ks], s1, 0, 0, 0);
      }
      if (j == 0) { for (int i = 8; i < 16; ++i) s0[i] = -INFINITY; for (int i = 0; i < 16; ++i) s1[i] = -INFINITY; }
      float mx = s0[0]; for (int i = 1; i < 16; ++i) mx = fmaxf(mx, s0[i]); for (int i = 0; i < 16; ++i) mx = fmaxf(mx, s1[i]);
      mx = fmaxf(mx, __shfl_xor(mx, 32));
      const float d = (j == 0) ? mx : fmaxf(mx, 0.f);
      float ps = 0.f;
      if (j == 0 || __any(d > 8.f)) {
        const float alpha = (j == 0) ? 1.f : __builtin_amdgcn_exp2f(-d);
        for (int i = 0; i < 16; ++i) { s0[i] = __builtin_amdgcn_exp2f(s0[i] - d); ps += s0[i]; s1[i] = __builtin_amdgcn_exp2f(s1[i] - d); ps += s1[i]; }
        lsum = lsum * alpha + ps;
        for (int i = 0; i < 16; ++i) { o0[i] *= alpha; o1[i] *= alpha; }
        mrun = (j == 0) ? d : mrun + d;
      } else {
        for (int i = 0; i < 16; ++i) { s0[i] = __builtin_amdgcn_exp2f(s0[i]); ps += s0[i]; s1[i] = __builtin_amdgcn_exp2f(s1[i]); ps += s1[i]; }
        lsum += ps;
      }
      for (int kt = 0; kt < 2; ++kt) for (int s = 0; s < 2; ++s) {
        u32x4 pp; for (int jj = 0; jj < 4; ++jj) pp[jj] = kt == 0 ? cvtpk_v(s0[8 * s + 2 * jj], s0[8 * s + 2 * jj + 1]) : cvtpk_v(s1[8 * s + 2 * jj], s1[8 * s + 2 * jj + 1]);
        bf16x8 pb = __builtin_bit_cast(bf16x8, pp);
        const int key0 = 32 * kt + 16 * s + 8 * h2;
        const bf16x8 va = *(const bf16x8*)(vl + r31 * VP + key0), vc = *(const bf16x8*)(vl + (32 + r31) * VP + key0);
        o0 = __builtin_amdgcn_mfma_f32_32x32x16_bf16(va, pb, o0, 0, 0, 0);
        o1 = __builtin_amdgcn_mfma_f32_32x32x16_bf16(vc, pb, o1, 0, 0, 0);
      }
    }
    if (j + 1 < ntile) lstore((j + 1) & 1);
  }
  if (mychunk >= 0) {
    lsum += __shfl_xor(lsum, 32);
    const float inv = __builtin_amdgcn_rcpf(lsum);
    u16* orow = rest + (size_t)qrow * NREST + RC_CQ + hh * 64;
    for (int g = 0; g < 4; ++g) { const int v0 = 8 * g + 4 * h2;
      u32x2 w0; w0[0] = cvtpk_v(o0[4 * g] * inv, o0[4 * g + 1] * inv); w0[1] = cvtpk_v(o0[4 * g + 2] * inv, o0[4 * g + 3] * inv); *(u32x2*)(orow + v0) = w0;
      u32x2 w1; w1[0] = cvtpk_v(o1[4 * g] * inv, o1[4 * g + 1] * inv); w1[1] = cvtpk_v(o1[4 * g + 2] * inv, o1[4 * g + 3] * inv); *(u32x2*)(orow + 32 + v0) = w1; }
  }
}

template <class Epi>
DEVI void thin_gemm(unsigned char* lds, const Gemm g, int nN, const Epi& E, int wg0 = 0) { const int TX = opaque_tid();
  const int wid = __builtin_amdgcn_readfirstlane(TX >> 6), lane = TX & 63, fr = lane & 15, fq = lane >> 4;
  int K = g.K; asm volatile("" : "+s"(K));
  f32x4* P = (f32x4*)lds;
  for (int un = (int)((blockIdx.x + gridDim.x - wg0) % gridDim.x); un < nN * 4; un += gridDim.x) {
    const int pn = un >> 2, wc = un & 3;
    f32x4 pacc[4];
#pragma unroll
    for (int t = 0; t < 4; ++t) pacc[t] = (f32x4){0.f, 0.f, 0.f, 0.f};
    const u16* ap = g.A + (size_t)(METAROW + fr) * g.lda + fq * 8;
    const u16* bp = g.Bt + (size_t)(pn * 256 + wc * 32) * g.ldb + fq * 8;
    const unsigned o0 = (unsigned)(perm32(fr) * g.ldb), o1 = (unsigned)(perm32(16 + fr) * g.ldb);
#pragma unroll 4
    for (int k = wid * 32; k < K; k += 256) {
      const bf16x8 a = *(const bf16x8*)(ap + k);
      bf16x8 bv[4];
#pragma unroll
      for (int t = 0; t < 4; ++t) { const int bj = t >> 1, n = t & 1; bv[t] = *(const bf16x8*)(bp + (size_t)(bj * 128) * g.ldb + (n ? o1 : o0) + k); }
#pragma unroll
      for (int t = 0; t < 4; ++t) pacc[t] = __builtin_amdgcn_mfma_f32_16x16x32_bf16(bv[t], a, pacc[t], 0, 0, 0);
    }
    __syncthreads();
#pragma unroll
    for (int t = 0; t < 4; ++t) P[(wid * 4 + t) * 64 + lane] = pacc[t];
    __syncthreads();
    if (wid == 0) {
      f32x4 acc[2][2][4][2];
#pragma unroll
      for (int bj = 0; bj < 2; ++bj)
#pragma unroll
        for (int n = 0; n < 2; ++n) { f32x4 sum = {0.f, 0.f, 0.f, 0.f};
#pragma unroll
          for (int w = 0; w < 8; ++w) sum += P[(w * 4 + bj * 2 + n) * 64 + lane];
          acc[0][bj][0][n] = sum; }
      Unit u; u.pm = 128; u.pn = pn;
      E.template run<true>(acc, u, 0, wc, fr, fq);
    }
    __syncthreads();
  }
}
#define LDS3 ((LAS unsigned char*)lds)
constexpr size_t WS_SSQ = WS_GP + (size_t)MROWS * 8 * 4;
struct EpiIn {
  const float* rs; u8* gates; u16* rest; float* gp; float* ssq;
  DEVI void operator()(AccRef acc, const Unit& u, int wr, int wc, int fr, int fq) const { run<false>(acc, u, wr, wc, fr, fq); }
  template <bool THIN> DEVI void run(AccRef acc, const Unit& u, int wr, int wc, int fr, int fq) const {
    const int pn = u.pn;
    float rsv[2][4];
    EPI_ROWS({ rsv[ai][m] = rs[row]; })
    EPI_ROWS({ const float r = rsv[ai][m];
      _Pragma("unroll") for (int bj = 0; bj < 2; ++bj) { const int col0 = pn * 256 + bj * 128 + wc * 32 + 8 * fq;
        float x[8]; _Pragma("unroll") for (int e = 0; e < 4; ++e) { x[e] = acc[ai][bj][m][0][e] * r; x[4 + e] = acc[ai][bj][m][1][e] * r; }
        if (pn < 16) { unsigned b[8]; _Pragma("unroll") for (int e = 0; e < 8; ++e) b[e] = (unsigned)(sigm(x[e]) * 255.f + 0.5f);
          u32x2 o; o[0] = b[0] | (b[1] << 8) | (b[2] << 16) | (b[3] << 24); o[1] = b[4] | (b[5] << 8) | (b[6] << 16) | (b[7] << 24);
          *(u32x2*)(gates + (size_t)row * 4096 + col0) = o; }
        else { const int rc = col0 - 4096; u32x4 o; _Pragma("unroll") for (int e = 0; e < 4; ++e) o[e] = cvtpk_e(x[2 * e], x[2 * e + 1]);
          *(u32x4*)(rest + (size_t)row * NREST + rc) = o;
          if (rc == RC_MI) { *(f32x4*)(gp + (size_t)row * 8) = (f32x4){x[0], x[1], x[2], x[3]}; *(f32x4*)(gp + (size_t)row * 8 + 4) = (f32x4){x[4], x[5], x[6], x[7]}; }
          const int slot = pn == 24 ? bj : (pn == 25 ? (bj == 0 ? 2 : 3) : (pn == 26 && bj == 0 ? 4 : -1));
          if (slot >= 0) { float ss = 0.f; _Pragma("unroll") for (int e = 0; e < 8; ++e) ss += x[e] * x[e];
            ss += __shfl_xor(ss, 16); ss += __shfl_xor(ss, 32);
            if (fq == 0) ssq[(size_t)row * 20 + slot * 4 + wc] = ss; } } } })
  }
};
struct EpiQ {
  const float* ssq; const float* rope; u16* Q;
  DEVI void operator()(AccRef acc, const Unit& u, int wr, int wc, int fr, int fq) const { run<false>(acc, u, wr, wc, fr, fq); }
  template <bool THIN> DEVI void run(AccRef acc, const Unit& u, int wr, int wc, int fr, int fq) const {
    const float QS = 0.10206207261596577f * 1.4426950408889634f;
    constexpr int NA = THIN ? 1 : 2, NMM = THIN ? 1 : 4;
#pragma unroll
    for (int ai = 0; ai < NA; ++ai) {
      float ssv[NMM];
#pragma unroll
      for (int m = 0; m < NMM; ++m) { const int row = u.pm * 256 + ai * 128 + wr * 64 + m * 16 + fr; const float* sp = ssq + (size_t)row * 20;
        const f32x4 s0 = *(const f32x4*)sp, s1 = *(const f32x4*)(sp + 4), s2 = *(const f32x4*)(sp + 8);
        ssv[m] = (s0[0] + s0[1] + s0[2] + s0[3]) + (s1[0] + s1[1] + s1[2] + s1[3]) + (s2[0] + s2[1] + s2[2] + s2[3]); }
#pragma unroll
      for (int m = 0; m < NMM; ++m) { const int row = u.pm * 256 + ai * 128 + wr * 64 + m * 16 + fr;
        const float sc = rsqrtf(ssv[m] * (1.f / 384.f) + EPS) * QS; const int pos = row_pos(row);
#pragma unroll
        for (int bj = 0; bj < 2; ++bj) { const int cb = u.pn * 256 + bj * 128 + wc * 32, col0 = cb + 8 * fq;
          float x[8];
#pragma unroll
          for (int e = 0; e < 4; ++e) { x[e] = acc[ai][bj][m][0][e] * sc; x[4 + e] = acc[ai][bj][m][1][e] * sc; }
          if ((cb % 96) == 64) {
#pragma unroll
            for (int e = 0; e < 8; ++e) { const float other = __shfl_xor(x[e], 32); const int i = 8 * (fq & 1) + e;
              const float c = rope[(pos * 16 + i) * 2], s = rope[(pos * 16 + i) * 2 + 1];
              x[e] = fq < 2 ? x[e] * c - other * s : x[e] * c + other * s; } }
          u32x4 o;
#pragma unroll
          for (int e = 0; e < 4; ++e) o[e] = cvtpk_e(x[2 * e], x[2 * e + 1]);
          *(u32x4*)(Q + (size_t)row * 768 + col0) = o; }
        __builtin_amdgcn_sched_barrier(0); }
    }
  }
};
struct EpiKV {
  const float* ssq; u16* KN; u16* VT;
  DEVI void operator()(AccRef acc, const Unit& u, int wr, int wc, int fr, int fq) const { run<false>(acc, u, wr, wc, fr, fq); }
  template <bool THIN> DEVI void run(AccRef acc, const Unit& u, int wr, int wc, int fr, int fq) const {
    constexpr int NA = THIN ? 1 : 2, NMM = THIN ? 1 : 4;
#pragma unroll
    for (int ai = 0; ai < NA; ++ai) {
      float ssv[NMM];
#pragma unroll
      for (int m = 0; m < NMM; ++m) { const int row = u.pm * 256 + ai * 128 + wr * 64 + m * 16 + fr; const float* sp = ssq + (size_t)row * 20 + 12;
        const f32x4 s0 = *(const f32x4*)sp, s1 = *(const f32x4*)(sp + 4);
        ssv[m] = (s0[0] + s0[1] + s0[2] + s0[3]) + (s1[0] + s1[1] + s1[2] + s1[3]); }
#pragma unroll
      for (int m = 0; m < NMM; ++m) { const int row = u.pm * 256 + ai * 128 + wr * 64 + m * 16 + fr;
        const float sc = rsqrtf(ssv[m] * (1.f / 256.f) + EPS);
#pragma unroll
        for (int bj = 0; bj < 2; ++bj) { const int col0 = u.pn * 256 + bj * 128 + wc * 32 + 8 * fq, hd = col0 >> 7, d0 = col0 & 127;
          float x[8];
#pragma unroll
          for (int e = 0; e < 4; ++e) { x[e] = acc[ai][bj][m][0][e] * sc; x[4 + e] = acc[ai][bj][m][1][e] * sc; }
          if (d0 < 64) { u32x4 o;
#pragma unroll
            for (int e = 0; e < 4; ++e) o[e] = cvtpk_e(x[2 * e], x[2 * e + 1]);
            *(u32x4*)(KN + (size_t)row * 512 + hd * 64 + d0) = o; }
          else {
#pragma unroll
            for (int e = 0; e < 8; ++e) VT[(size_t)(hd * 64 + d0 - 64 + e) * MROWS + ((row & ~12) | ((row & 4) << 1) | ((row & 8) >> 1))] = (u16)cvtpk_e(x[e], x[e]); } }
        __builtin_amdgcn_sched_barrier(0); }
    }
  }
};
struct EpiGlu {
  u16* rest;
  DEVI void operator()(AccRef acc, const Unit& u, int wr, int wc, int fr, int fq) const { run<false>(acc, u, wr, wc, fr, fq); }
  template <bool THIN> DEVI void run(AccRef acc, const Unit& u, int wr, int wc, int fr, int fq) const {
    EPI_ROWS({ float x[8]; _Pragma("unroll") for (int e = 0; e < 4; ++e) { x[e] = acc[ai][0][m][0][e] * sigm(acc[ai][1][m][0][e]); x[4 + e] = acc[ai][0][m][1][e] * sigm(acc[ai][1][m][1][e]); }
      u32x4 o; _Pragma("unroll") for (int e = 0; e < 4; ++e) o[e] = cvtpk_e(x[2 * e], x[2 * e + 1]);
      *(u32x4*)(rest + (size_t)row * NREST + RC_SU + u.pn * 128 + wc * 32 + 8 * fq) = o; })
  }
};
struct EpiMerge {
  const u8* gates; u16* mg; int bi;
  DEVI void operator()(AccRef acc, const Unit& u, int wr, int wc, int fr, int fq) const { run<false>(acc, u, wr, wc, fr, fq); }
  template <bool THIN> DEVI void run(AccRef acc, const Unit& u, int wr, int wc, int fr, int fq) const {
    constexpr int NA = THIN ? 1 : 2, NMM = THIN ? 1 : 4;
    u32x2 gb[NA][NMM][2];
#pragma unroll
    for (int ai = 0; ai < NA; ++ai)
#pragma unroll
      for (int m = 0; m < NMM; ++m)
#pragma unroll
        for (int bj = 0; bj < 2; ++bj) { const int row = u.pm * 256 + ai * 128 + wr * 64 + m * 16 + fr, col0 = u.pn * 256 + bj * 128 + wc * 32 + 8 * fq;
          gb[ai][m][bj] = *(const u32x2*)(gates + (size_t)row * 4096 + bi * 1024 + col0); }
#pragma unroll
    for (int ai = 0; ai < NA; ++ai) {
      u32x4 old[NMM][2];
#pragma unroll
      for (int m = 0; m < NMM; ++m)
#pragma unroll
        for (int bj = 0; bj < 2; ++bj) { const int row = u.pm * 256 + ai * 128 + wr * 64 + m * 16 + fr, col0 = u.pn * 256 + bj * 128 + wc * 32 + 8 * fq;
          old[m][bj] = bi ? *(const u32x4*)(mg + (size_t)row * 1024 + col0) : (u32x4){0, 0, 0, 0}; }
#pragma unroll
      for (int m = 0; m < NMM; ++m)
#pragma unroll
        for (int bj = 0; bj < 2; ++bj) { const int row = u.pm * 256 + ai * 128 + wr * 64 + m * 16 + fr, col0 = u.pn * 256 + bj * 128 + wc * 32 + 8 * fq;
          float x[8];
#pragma unroll
          for (int e = 0; e < 8; ++e) { const float g = (float)((gb[ai][m][bj][e >> 2] >> (8 * (e & 3))) & 255u) * (1.f / 255.f); x[e] = g * (e < 4 ? acc[ai][bj][m][0][e] : acc[ai][bj][m][1][e - 4]); }
#pragma unroll
          for (int e = 0; e < 4; ++e) { x[2 * e] += blo(old[m][bj][e]); x[2 * e + 1] += bhi(old[m][bj][e]); }
          u32x4 o;
#pragma unroll
          for (int e = 0; e < 4; ++e) o[e] = cvtpk_e(x[2 * e], x[2 * e + 1]);
          *(u32x4*)(mg + (size_t)row * 1024 + col0) = o; }
    }
  }
};
template <int MODE> struct EpiPlain {
  const float* rs; u16* out; int ldo;
  DEVI void operator()(AccRef acc, const Unit& u, int wr, int wc, int fr, int fq) const { run<false>(acc, u, wr, wc, fr, fq); }
  template <bool THIN> DEVI void run(AccRef acc, const Unit& u, int wr, int wc, int fr, int fq) const {
    float rsv[2][4];
    EPI_ROWS({ rsv[ai][m] = MODE == 1 ? rs[row] : 1.f; })
    EPI_ROWS({ const float r = rsv[ai][m];
      _Pragma("unroll") for (int bj = 0; bj < 2; ++bj) { const int col0 = u.pn * 256 + bj * 128 + wc * 32 + 8 * fq;
        float x[8]; _Pragma("unroll") for (int e = 0; e < 4; ++e) { x[e] = acc[ai][bj][m][0][e]; x[4 + e] = acc[ai][bj][m][1][e]; }
        if (MODE == 1) { _Pragma("unroll") for (int e = 0; e < 8; ++e) { float t = fmaxf(x[e] * r, 0.f); x[e] = t * t; } }
        u32x4 o; _Pragma("unroll") for (int e = 0; e < 4; ++e) o[e] = cvtpk_e(x[2 * e], x[2 * e + 1]);
        *(u32x4*)(out + (size_t)row * ldo + col0) = o; } })
  }
};
DEVI void phase_inproj(PRef p, unsigned char* lds) { unsigned char* const wsb = opq(p.ws);
  Gemm g{(const u16*)(wsb + WS_HB), (const u16*)(wsb + WS_W + W_IN), 1024, 1024, 1024};
  StaticOrder S; S.init(129, NIN / 256, gridDim.x, blockIdx.x);
  EpiIn E{(const float*)(wsb + WS_RS), wsb + WS_GATES, (u16*)(wsb + WS_REST), (float*)(wsb + WS_GP), (float*)(wsb + WS_SSQ)};
  gemm_phase(LDS3, g, S, E);
}
DEVI void phase_upq(PRef p, unsigned char* lds) { unsigned char* const wsb = opq(p.ws);
  Gemm g{(const u16*)(wsb + WS_REST) + RC_CQ, (const u16*)(wsb + WS_W + W_UQ), NREST, 384, 384};
  StaticOrder S; S.init(129, 3, gridDim.x, blockIdx.x);
  EpiQ E{(const float*)(wsb + WS_SSQ), (const float*)(wsb + WS_ROPE), (u16*)(wsb + WS_Q)};
  gemm_phase(LDS3, g, S, E);
}
DEVI void phase_upkv(PRef p, unsigned char* lds) { unsigned char* const wsb = opq(p.ws);
  Gemm g{(const u16*)(wsb + WS_REST) + RC_CKV, (const u16*)(wsb + WS_W + W_UKV), NREST, 256, 256};
  StaticOrder S; S.init(128, 4, gridDim.x, blockIdx.x);
  EpiKV E{(const float*)(wsb + WS_SSQ), (u16*)(wsb + WS_KN), (u16*)(wsb + WS_VT)};
  thin_gemm(lds, g, S.nN, E);
  gemm_phase(LDS3, g, S, E);
}
DEVI void phase_glu(PRef p, unsigned char* lds, bool meta) { unsigned char* const wsb = opq(p.ws);
  Gemm g{(const u16*)(wsb + WS_REST) + RC_CV, (const u16*)(wsb + WS_W + W_GLU), NREST, 256, 256};
  StaticOrder S; S.init(128, 2, gridDim.x, blockIdx.x);
  EpiGlu E{(u16*)(wsb + WS_REST)};
  if (meta) thin_gemm(lds, g, S.nN, E);
  gemm_phase(LDS3, g, S, E);
}
DEVI void phase_merge(PRef p, unsigned char* lds, bool meta) { unsigned char* const wsb = opq(p.ws);
  const u16* rest = (const u16*)(wsb + WS_REST); const u16* Bt = (const u16*)(wsb + WS_W + W_BR);
  const int aoff[4] = {RC_CB, RC_CC, RC_SU, RC_CQ}; const int koff[4] = {0, 256, 512, 768}; const int kk[4] = {256, 256, 256, 512};
  StaticOrder S; S.init(128, 4, gridDim.x, blockIdx.x);
  for (int bi = 0; bi < 4; ++bi) {
    Gemm g{rest + aoff[bi], Bt + koff[bi], NREST, 1280, kk[bi]};
    EpiMerge E{wsb + WS_GATES, (u16*)(wsb + WS_MERGED), bi};
    if (meta) thin_gemm(lds, g, S.nN, E);
  gemm_phase(LDS3, g, S, E);
  }
}
template <int MODE> DEVI void phase_gemm_plain(PRef p, unsigned char* lds, const u16* A, int lda, const u16* Bt, int K, int N, u16* out, int ldo, bool meta) { unsigned char* const wsb = opq(p.ws);
  Gemm g{A, Bt, lda, K, K};
  StaticOrder S; S.init(128, N / 256, gridDim.x, blockIdx.x);
  EpiPlain<MODE> E{(const float*)(wsb + WS_RS), out, ldo};
  if (meta) thin_gemm(lds, g, S.nN, E);
  gemm_phase(LDS3, g, S, E);
}

#define XB_TMO      128
#define XB_XCNT(j)  (256  + 64 * (j))
#define XB_XSUB(j)  (1280 + 64 * (j))
#define XB_XGEN(j)  (2304 + 64 * (j))
#define XB_TOP      3328
#define XB_TOPGEN   3392
#define XCD_BAR_WORDS 3456
#define XB_SPIN_CAP (1u << 18)
DEVI unsigned xb_ld(unsigned* p) { return __hip_atomic_load(p, __ATOMIC_RELAXED, __HIP_MEMORY_SCOPE_AGENT); }
DEVI unsigned xb_add(unsigned* p, unsigned v) { return __hip_atomic_fetch_add(p, v, __ATOMIC_RELAXED, __HIP_MEMORY_SCOPE_AGENT); }
DEVI unsigned xb_xcc_id() { return (unsigned)__builtin_amdgcn_s_getreg((3 << 11) | 20) & 0xFu; }
#define XB_SPIN(cond, bar) do { unsigned _sp = 0; while (cond) { __builtin_amdgcn_s_sleep(1); \
    if ((++_sp & 255u) == 0u) { if (xb_ld(&(bar)[XB_TMO])) break; if (_sp > XB_SPIN_CAP) { atomicAdd(&(bar)[XB_TMO], 1u); break; } } } } while (0)
struct XcdBarrier { unsigned* bar; unsigned x; volatile __attribute__((address_space(3))) unsigned* st; };
DEVI XcdBarrier xcd_barrier_post(unsigned* bar, volatile __attribute__((address_space(3))) unsigned* st) {
  XcdBarrier b; b.bar = bar; b.x = xb_xcc_id(); b.st = st;
  if (threadIdx.x == 0) (void)xb_add(&bar[XB_XCNT(b.x)], 1u);
  return b;
}
DEVI void xcd_barrier_complete(unsigned* bar, unsigned x, unsigned& nloc, unsigned& nx) {
  const unsigned G = gridDim.x * gridDim.y * gridDim.z;
  unsigned sum, cnt, mine, sp = 0u;
  for (;;) {
    sum = 0u; cnt = 0u; mine = 0u;
#pragma unroll
    for (unsigned j = 0; j < 16; ++j) { const unsigned c = xb_ld(&bar[XB_XCNT(j)]); sum += c; cnt += (c > 0u) ? 1u : 0u; mine = (j == x) ? c : mine; }
    if (sum == G) break;
    __builtin_amdgcn_s_sleep(1);
    if ((++sp & 255u) == 0u) { if (xb_ld(&bar[XB_TMO])) break; if (sp > XB_SPIN_CAP) { atomicAdd(&bar[XB_TMO], 1u); break; } }
  }
  nloc = mine > 0u ? mine : 1u; nx = cnt > 0u ? cnt : 1u;
}
__device__ __attribute__((noinline)) void xcd_barrier(const XcdBarrier b) {
  asm volatile("s_waitcnt vmcnt(0)" ::: "memory");
  __syncthreads();
  if (threadIdx.x == 0) {
    unsigned* bar = b.bar;
    __builtin_amdgcn_s_waitcnt(0);
    unsigned nloc = b.st[0], nx = b.st[1];
    if (nloc == 0u) { xcd_barrier_complete(bar, b.x, nloc, nx); b.st[0] = nloc; b.st[1] = nx; }
    const unsigned old = xb_add(&bar[XB_XSUB(b.x)], 1u);
    const unsigned gen = old / nloc;
    if (old + 1u == (gen + 1u) * nloc) {
      __builtin_amdgcn_fence(__ATOMIC_RELEASE, "agent");
      asm volatile("s_waitcnt vmcnt(0)" ::: "memory");
      const unsigned og = xb_add(&bar[XB_TOP], 1u);
      const unsigned tg = og / nx;
      if (og + 1u == (tg + 1u) * nx) xb_add(&bar[XB_TOPGEN], 1u);
      else XB_SPIN(xb_ld(&bar[XB_TOPGEN]) == tg, bar);
      __builtin_amdgcn_fence(__ATOMIC_ACQUIRE, "agent");
      xb_add(&bar[XB_XGEN(b.x)], 1u);
      asm volatile("s_waitcnt vmcnt(0)" ::: "memory");
    } else {
      XB_SPIN(xb_ld(&bar[XB_XGEN(b.x)]) == gen, bar);
      __builtin_amdgcn_fence(__ATOMIC_ACQUIRE, "agent");
      asm volatile("s_waitcnt vmcnt(0)" ::: "memory");
    }
  }
  __syncthreads();
}

#ifndef PHM
#define PHM 0xFFFF
#endif
__global__ void __launch_bounds__(512, 2) mega(Params p_unused) {
#define p (*kparams())
  extern __shared__ __attribute__((aligned(16))) unsigned char lds[];
  cg::grid_group grid = cg::this_grid();
  unsigned* ctl = (unsigned*)(p.ws + WS_CTL);
  __shared__ uint4 s_misc;
  if (threadIdx.x == 0) s_misc = make_uint4(0u, 0u, 0u, 0u);
  __syncthreads();
  XcdBarrier xbar = xcd_barrier_post(ctl, (volatile __attribute__((address_space(3))) unsigned*)&s_misc);
  u16* W = (u16*)(p.ws + WS_W);
  if (PHM & 1) { prep_layer(p, 0, (float*)lds);
  phase0_act(p); }
  if (p.ws == nullptr) grid.sync();
  xcd_barrier(xbar);
  for (int l = 0; l < 2; ++l) {
    if (PHM & 2) phase_inproj(p, lds);
    xcd_barrier(xbar);
    if (PHM & 4) { phase_upq(p, lds);
    phase_upkv(p, lds); }
    if (PHM & 8) phase_conv(p, l);
    if (PHM & 16) s5_passA(p, l, lds);
    xcd_barrier(xbar);
    if (blockIdx.x < 32) mlstm_item(p, l, blockIdx.x >> 2, blockIdx.x & 3, lds);
    else if (blockIdx.x < 48) {
      s5_scan(p, l, 32);
      __threadfence(); __syncthreads();
      if (threadIdx.x == 0) __hip_atomic_fetch_add(ctl + 24 + l, 1u, __ATOMIC_RELEASE, __HIP_MEMORY_SCOPE_AGENT);
    }
    for (;;) {
      __syncthreads();
      if (threadIdx.x == 0) s_misc.z = atomicAdd(ctl + 16 + l, 1u);
      __syncthreads();
      int it = (int)s_misc.z;
      if (it >= 1032 + 513) break;
      if (it < 1024) { const int qb = 15 - it / 64, bh = it % 64; attn_item(p, bh >> 3, bh & 7, qb, false, lds); }
      else if (it < 1032) attn_item(p, 0, it - 1024, 0, true, lds);
      else { const int k = it - 1032;
        if (threadIdx.x == 0) { unsigned spins = 0; while (__hip_atomic_load(ctl + 24 + l, __ATOMIC_RELAXED, __HIP_MEMORY_SCOPE_AGENT) < 16u && ++spins < (1u << 22)) __builtin_amdgcn_s_sleep(2); }
        __syncthreads(); __builtin_amdgcn_fence(__ATOMIC_ACQUIRE, "agent");
        if (k == 0) s5_passB_item(p, l, 0, 0, lds); else s5_passB_item(p, l, (k - 1) >> 6, 1 + ((k - 1) & 63), lds); }
    }
    xcd_barrier(xbar);
    const bool meta_live = (l == 0);
    if (PHM & 256) phase_glu(p, lds, meta_live);
    xcd_barrier(xbar);
    if (PHM & 512) phase_merge(p, lds, meta_live);
    xcd_barrier(xbar);
    if (PHM & 1024) phase_gemm_plain<0>(p, lds, (const u16*)(p.ws + WS_MERGED), 1024, W + W_OUT / 2, 1024, 1024, (u16*)(p.ws + WS_YOUT), 1024, meta_live);
    xcd_barrier(xbar);
    row_pass(p, (const u16*)(p.ws + WS_YOUT), l == 0 ? p.in[I_X] : p.out, p.in[I_NG] + (size_t)(l * 4 + 1) * DM, false);
    xcd_barrier(xbar);
    if (PHM & 4096) phase_gemm_plain<1>(p, lds, (const u16*)(p.ws + WS_HB), 1024, W + W_1 / 2, 1024, 4096, (u16*)(p.ws + WS_FF1), 4096, meta_live);
    xcd_barrier(xbar);
    if (PHM & 8192) phase_gemm_plain<0>(p, lds, (const u16*)(p.ws + WS_FF1), 4096, W + W_2 / 2, 4096, 1024, (u16*)(p.ws + WS_MERGED), 1024, meta_live);
    xcd_barrier(xbar);
    row_pass(p, (const u16*)(p.ws + WS_MERGED), p.out, p.in[I_NG] + (size_t)(l * 4 + 3) * DM, l == 1);
    if ((PHM & 1) && l == 0) prep_layer(p, 1, (float*)lds);
    xcd_barrier(xbar);
  }
}

#undef p
extern "C" void kernel_launch(void* const* d_in, const int* in_sizes, int n_in, void* d_out, int out_size, void* d_ws, size_t ws_size, hipStream_t stream) {
  static int grid = 0;
  if (grid == 0) {
    if (ws_size < WS_END) { fprintf(stderr, "workspace too small: %zu < %zu\n", ws_size, (size_t)WS_END); grid = -1; return; }
    int dev = 0, cus = 0, per_cu = 0;
    (void)hipGetDevice(&dev);
    (void)hipDeviceGetAttribute(&cus, hipDeviceAttributeMultiprocessorCount, dev);
    (void)hipFuncSetAttribute((const void*)mega, hipFuncAttributeMaxDynamicSharedMemorySize, LDS_BYTES);
    (void)hipOccupancyMaxActiveBlocksPerMultiprocessor(&per_cu, (const void*)mega, 512, LDS_BYTES);
    if (per_cu < 1) per_cu = 1;
    grid = cus * 1;
    (void)hipGetLastError();
  }
  if (grid < 0) return;
  (void)hipMemsetAsync((char*)d_ws + WS_CTL, 0, 32768, stream);
  Params p{};
  for (int i = 0; i < 24; ++i) p.in[i] = (const float*)d_in[i];
  p.out = (float*)d_out; p.ws = (unsigned char*)d_ws;
  void* args[] = {&p};
  hipError_t e = hipLaunchCooperativeKernel((const void*)mega, dim3(grid), dim3(512), args, LDS_BYTES, stream);
  if (e != hipSuccess) fprintf(stderr, "cooperative launch failed: %s (grid %d)\n", hipGetErrorString(e), grid);
}
```

```cpp
#include <hip/hip_runtime.h>
#include <hip/hip_cooperative_groups.h>
#include <cstdio>
namespace cg = cooperative_groups;

typedef unsigned short u16;
typedef unsigned char u8;
using bf16x8 = __attribute__((ext_vector_type(8))) short;
using s16x4 = __attribute__((ext_vector_type(4))) short;
using f32x4 = __attribute__((ext_vector_type(4))) float;
using f32x16 = __attribute__((ext_vector_type(16))) float;
using u32x4 = __attribute__((ext_vector_type(4))) unsigned;
using u32x2 = __attribute__((ext_vector_type(2))) unsigned;
#define DEVI __device__ __forceinline__

constexpr int DM = 1024, SEQ = 4096, NB = 8, NMETA = 16;
constexpr int MROWS = 33024, NREAL = 32768, METAROW = 32768;
constexpr int NIN = 6912, NREST = 2816, INW = 6824;
constexpr int RC_CB = 0, RC_CC = 256, RC_CV = 512, RC_MQ = 768, RC_MK = 1024, RC_MV = 1280, RC_MO = 1536, RC_SU = 1792,
              RC_CQ = 2048, RC_CKV = 2432, RC_KR = 2688, RC_MI = 2720;
constexpr float EPS = 1e-6f;
constexpr int NCH = 65;

constexpr size_t al256(size_t x) { return (x + 255) & ~(size_t)255; }
constexpr size_t WS_CTL = 0;
constexpr size_t WS_W = 32768;
constexpr size_t W_IN = 0, W_UQ = W_IN + (size_t)NIN * 1024 * 2, W_UKV = W_UQ + 768 * 384 * 2, W_GLU = W_UKV + 1024 * 256 * 2,
                 W_BR = W_GLU + 512 * 256 * 2, W_OUT = W_BR + 1024 * 1280 * 2, W_1 = W_OUT + 1024 * 1024 * 2, W_2 = W_1 + 4096 * 1024 * 2,
                 W_END = W_2 + 4096 * 1024 * 2;
constexpr size_t WS_GATES = al256(WS_W + W_END);
constexpr size_t WS_REST = al256(WS_GATES + (size_t)MROWS * 4096);
constexpr size_t WS_HB = al256(WS_REST + (size_t)MROWS * NREST * 2);
constexpr size_t WS_KN = al256(WS_HB + (size_t)MROWS * 1024 * 2);
constexpr size_t WS_KR = al256(WS_KN + (size_t)MROWS * 512 * 2);
constexpr size_t WS_VT = al256(WS_KR + (size_t)MROWS * 32 * 2);
constexpr size_t WS_RS = al256(WS_VT + (size_t)MROWS * 512 * 2);
constexpr size_t WS_HM = al256(WS_RS + (size_t)MROWS * 4);
constexpr size_t WS_S5 = al256(WS_HM + (size_t)256 * 1024 * 4);
constexpr size_t WS_ROPE = al256(WS_S5 + (size_t)(NB * NCH + 1) * 16 * 128 * 4);
constexpr size_t WS_GP = al256(WS_ROPE + (size_t)4112 * 16 * 8);
constexpr size_t WS_MSUM = al256(WS_GP + (size_t)MROWS * 8 * 4 + (size_t)MROWS * 20 * 4);
constexpr size_t WS_MSC = al256(WS_MSUM + (size_t)32 * NCH * 4160 * 2);
constexpr size_t WS_END = al256(WS_MSC + (size_t)32 * NCH * 4 * 4);
constexpr size_t WS_Q = WS_HB;
constexpr size_t WS_MERGED = WS_KN;
constexpr size_t WS_YOUT = WS_GATES;
constexpr size_t WS_FF1 = WS_GATES;
static_assert(WS_RS - WS_KN >= (size_t)MROWS * 1024 * 2, "merged alias");
static_assert(WS_HB - WS_GATES >= (size_t)MROWS * 4096 * 2, "ff1 alias");

constexpr int LDS_BYTES = 147456;
constexpr int LDS_MISC = 131072;

struct Params {
  const float* in[24];
  float* out;
  unsigned char* ws;
};
typedef const __attribute__((address_space(4))) Params& PRef;
DEVI const __attribute__((address_space(4))) Params* kparams() { auto k = __builtin_amdgcn_kernarg_segment_ptr(); asm volatile("" : "+s"(k)); return (const __attribute__((address_space(4))) Params*)k; }
enum { I_X = 0, I_META, I_NG, I_WIN, I_CONVW, I_GATEB, I_MNORM, I_ARE, I_AIM, I_LSTEP, I_BRE, I_BIM, I_CRE, I_CIM, I_SD, I_GLU,
       I_QN, I_KVN, I_WUQ, I_WUKV, I_WBR, I_WOUT, I_W1, I_W2 };

typedef __bf16 bf16x2_t __attribute__((ext_vector_type(2)));
DEVI unsigned cvtpk(float lo, float hi) { bf16x2_t v = {(__bf16)lo, (__bf16)hi}; return __builtin_bit_cast(unsigned, v); }
DEVI unsigned cvtpk_v(float lo, float hi) { unsigned r; asm volatile("v_cvt_pk_bf16_f32 %0, %1, %2\n\ts_nop 1" : "=v"(r) : "v"(lo), "v"(hi)); return r; }
DEVI u16 f2b(float f) { return (u16)(cvtpk(f, f) & 0xffffu); }
DEVI float b2f(u16 b) { return __uint_as_float(((unsigned)b) << 16); }
DEVI unsigned pack2(float a, float b) { return cvtpk(a, b); }
DEVI float blo(unsigned u) { return __uint_as_float(u << 16); }
DEVI float bhi(unsigned u) { return __uint_as_float(u & 0xffff0000u); }
DEVI float sigm(float x) { return __builtin_amdgcn_rcpf(1.f + __builtin_amdgcn_exp2f(-1.4426950408889634f * x)); }
DEVI float wave_sum(float v) { for (int o = 32; o > 0; o >>= 1) v += __shfl_xor(v, o); return v; }
DEVI int opaque_tid() { int t = threadIdx.x; asm volatile("" : "+v"(t)); return t; }
DEVI unsigned char* opq(unsigned char* p) { asm volatile("" : "+s"(p)); return p; }
DEVI int row_pos(int row) { return row < NREAL ? NMETA + (row & (SEQ - 1)) : row - METAROW; }

#define LAS __attribute__((address_space(3)))
constexpr int BM = 256, BK = 64, HALF = 128, HTB = HALF * BK * 2, NXCD = 8, WGM = 8;
DEVI int lds_byte(int r, int c) { const int st = (r >> 4) * 2 + (c >> 5), rr = r & 15, cc = c & 31, ob = rr * 64 + cc * 2; return st * 1024 + (ob ^ (((ob >> 9) & 1) << 5)); }
DEVI void stage_rc(int b, int& R, int& C) { const int st = b / 1024, sb = b % 1024, swz = sb ^ (((sb >> 9) & 1) << 5); R = (st >> 1) * 16 + swz / 64; C = (st & 1) * 32 + (swz % 64) / 2; }
DEVI int perm32(int rho) { const int n = rho >> 4, i = rho & 15; return 8 * (i >> 2) + 4 * n + (i & 3); }
struct Unit { int pm, pn; };
struct Gemm { const u16* A; const u16* Bt; int lda, ldb, K; };
struct StaticOrder {
  int nM, nN, nwg, G, c;
  DEVI void init(int nM_, int nN_, int G_, int c_) { nM = nM_; nN = nN_; nwg = nM * nN; G = G_; c = c_; }
  DEVI bool next(int i, Unit& u) const {
    const long L = (long)i * G + c; if (L >= nwg) return false;
    int wgid = (int)L; { const int q = nwg / NXCD, r = nwg % NXCD, xcd = wgid % NXCD, off = wgid / NXCD; wgid = (xcd < r ? xcd * (q + 1) : r * (q + 1) + (xcd - r) * q) + off; }
    const int nig = WGM * nN, gid = wgid / nig, fm = gid * WGM, gsz = (nM - fm) < WGM ? (nM - fm) : WGM;
    u.pm = fm + ((wgid % nig) % gsz); u.pn = (wgid % nig) / gsz; return true;
  }
};
template <class Epi>
DEVI void gemm_phase(LAS unsigned char* lds, const Gemm g, const StaticOrder& S, const Epi& E) { const int TX = opaque_tid();
  const int tid = TX, wid = __builtin_amdgcn_readfirstlane(tid >> 6), lane = tid & 63, wr = wid >> 2, wc = wid & 3, fr = lane & 15, fq = lane >> 4;
  int K = g.K; asm volatile("" : "+s"(K));
  const int nt = K / BK;
  unsigned voffA[2], voffB[2];
#pragma unroll
  for (int i = 0; i < 2; ++i) { int R, C; stage_rc(tid * 16 + i * 8192, R, C); const int Rb = (R & ~31) + perm32(R & 31);
    voffA[i] = (unsigned)(R * g.lda + C) * 2u; voffB[i] = (unsigned)(Rb * g.ldb + C) * 2u; }
  const size_t kstep = (size_t)(BK * 2);
  const size_t hstepA = (size_t)HALF * g.lda * 2, hstepB = (size_t)HALF * g.ldb * 2;
  const unsigned ldsw = (unsigned)wid * 1024u;
  const int aoff = lds_byte(wr * 64 + fr, fq * 8), boff = lds_byte(wc * 32 + fr, fq * 8);
#define PG8_SA(b, h) (((b) * 2 + (h)) * HTB)
#define PG8_SB(b, h) ((4 + (b) * 2 + (h)) * HTB)
#define PG8_STAGE(bufoff, gbase, voff) do { _Pragma("unroll") for (int _i = 0; _i < 2; ++_i) \
    __builtin_amdgcn_global_load_lds((const unsigned*)((const char*)(gbase) + (voff)[_i]), (LAS unsigned*)(lds + (bufoff) + ldsw + _i * 8192), 16, 0, 0); } while (0)
#define PG8_LDA(dst, b, h) do { _Pragma("unroll") for (int m = 0; m < 4; ++m) _Pragma("unroll") for (int k = 0; k < 2; ++k) dst[m][k] = *(const LAS bf16x8*)(lds + PG8_SA(b, h) + aoff + m * 2048 + k * 1024); } while (0)
#define PG8_LDB(dst, b, h) do { _Pragma("unroll") for (int n = 0; n < 2; ++n) _Pragma("unroll") for (int k = 0; k < 2; ++k) dst[n][k] = *(const LAS bf16x8*)(lds + PG8_SB(b, h) + boff + n * 2048 + k * 1024); } while (0)
#define PG8_MMA(ai, bj, At, Bt) do { __builtin_amdgcn_s_setprio(1); _Pragma("unroll") for (int m = 0; m < 4; ++m) _Pragma("unroll") for (int n = 0; n < 2; ++n) _Pragma("unroll") for (int k = 0; k < 2; ++k) \
    acc[ai][bj][m][n] = __builtin_amdgcn_mfma_f32_16x16x32_bf16(Bt[n][k], At[m][k], acc[ai][bj][m][n], 0, 0, 0); __builtin_amdgcn_s_setprio(0); } while (0)
#define PG8_WAIT_V(n) asm volatile("s_waitcnt vmcnt(" #n ")" ::: "memory")
#define PG8_WAIT_L(n) asm volatile("s_waitcnt lgkmcnt(" #n ")" ::: "memory")
#define PG8_BAR __builtin_amdgcn_s_barrier()
#define PG8_SCHED __builtin_amdgcn_sched_barrier(0)
  Unit cur, nxt; int ui = 0;
  if (!S.next(0, cur)) return;
  f32x4 acc[2][2][4][2];
#pragma unroll
  for (int a = 0; a < 2; ++a)
#pragma unroll
    for (int b = 0; b < 2; ++b)
#pragma unroll
      for (int m = 0; m < 4; ++m)
#pragma unroll
        for (int n = 0; n < 2; ++n) acc[a][b][m][n] = (f32x4){0.f, 0.f, 0.f, 0.f};
  bf16x8 At[4][2], B0[2][2], B1[2][2];
  const char* cA = (const char*)g.A + (size_t)cur.pm * 2 * hstepA; const char* cB = (const char*)g.Bt + (size_t)cur.pn * 2 * hstepB;
  PG8_STAGE(PG8_SB(0, 0), cB, voffB); PG8_STAGE(PG8_SA(0, 0), cA, voffA); PG8_STAGE(PG8_SB(0, 1), cB + hstepB, voffB); PG8_STAGE(PG8_SA(0, 1), cA + hstepA, voffA);
  if (wr == 1) PG8_BAR;
  PG8_WAIT_V(4); PG8_BAR;
  PG8_STAGE(PG8_SB(1, 0), cB + kstep, voffB); PG8_STAGE(PG8_SA(1, 0), cA + kstep, voffA); PG8_STAGE(PG8_SB(1, 1), cB + hstepB + kstep, voffB);
  PG8_WAIT_V(6); PG8_BAR;
  for (;;) {
    const bool has_next = S.next(ui + 1, nxt);
    const char* nA = has_next ? (const char*)g.A + (size_t)nxt.pm * 2 * hstepA : cA; const char* nB = has_next ? (const char*)g.Bt + (size_t)nxt.pn * 2 * hstepB : cB;
#pragma nounroll
    for (int t = 0; t < nt; t += 2) {
      const bool last = (t == nt - 2);
      const char* a1 = cA + (size_t)(t + 1) * kstep;
      const char* a2 = last ? nA : cA + (size_t)(t + 2) * kstep; const char* b2 = last ? nB : cB + (size_t)(t + 2) * kstep;
      const char* a3 = a2 + kstep; const char* b3 = b2 + kstep;
      PG8_LDB(B0, 0, 0); PG8_SCHED; PG8_LDA(At, 0, 0); PG8_STAGE(PG8_SA(1, 1), a1 + hstepA, voffA);
      PG8_WAIT_L(8); PG8_BAR; PG8_WAIT_L(0); PG8_MMA(0, 0, At, B0); PG8_BAR; PG8_SCHED;
      PG8_LDB(B1, 0, 1); PG8_STAGE(PG8_SB(0, 0), b2, voffB);
      PG8_BAR; PG8_WAIT_L(0); PG8_MMA(0, 1, At, B1); PG8_BAR;
      PG8_LDA(At, 0, 1); PG8_STAGE(PG8_SA(0, 0), a2, voffA);
      PG8_BAR; PG8_WAIT_L(0); PG8_MMA(1, 0, At, B0); PG8_BAR; PG8_SCHED;
      PG8_STAGE(PG8_SB(0, 1), b2 + hstepB, voffB);
      PG8_WAIT_V(6); PG8_BAR; PG8_MMA(1, 1, At, B1); PG8_BAR;
      PG8_LDB(B0, 1, 0); PG8_SCHED; PG8_LDA(At, 1, 0); PG8_STAGE(PG8_SA(0, 1), a2 + hstepA, voffA);
      PG8_WAIT_L(8); PG8_BAR; PG8_WAIT_L(0); PG8_MMA(0, 0, At, B0); PG8_BAR; PG8_SCHED;
      PG8_LDB(B1, 1, 1); PG8_STAGE(PG8_SB(1, 0), b3, voffB);
      PG8_BAR; PG8_WAIT_L(0); PG8_MMA(0, 1, At, B1); PG8_BAR;
      PG8_LDA(At, 1, 1); PG8_STAGE(PG8_SA(1, 0), a3, voffA);
      PG8_BAR; PG8_WAIT_L(0); PG8_MMA(1, 0, At, B0); PG8_BAR; PG8_SCHED;
      PG8_STAGE(PG8_SB(1, 1), b3 + hstepB, voffB);
      PG8_WAIT_V(6); PG8_BAR; PG8_MMA(1, 1, At, B1); PG8_BAR;
    }
    E(acc, cur, wr, wc, fr, fq);
    if (!has_next) break;
#pragma unroll
    for (int a = 0; a < 2; ++a)
#pragma unroll
      for (int b = 0; b < 2; ++b)
#pragma unroll
        for (int m = 0; m < 4; ++m)
#pragma unroll
          for (int n = 0; n < 2; ++n) acc[a][b][m][n] = (f32x4){0.f, 0.f, 0.f, 0.f};
    cur = nxt; cA = nA; cB = nB; ++ui;
  }
  PG8_WAIT_V(0);
  if (wr == 0) PG8_BAR;
  PG8_BAR;
#undef PG8_SA
#undef PG8_SB
#undef PG8_STAGE
#undef PG8_LDA
#undef PG8_LDB
#undef PG8_MMA
#undef PG8_WAIT_V
#undef PG8_WAIT_L
#undef PG8_BAR
#undef PG8_SCHED
}
typedef const f32x4 (&AccRef)[2][2][4][2];
DEVI unsigned cvtpk_e(float lo, float hi) { unsigned r; asm volatile("v_cvt_pk_bf16_f32 %0, %1, %2" : "=v"(r) : "v"(lo), "v"(hi)); return r; }
#define EPI_ROWS(...) _Pragma("unroll") for (int ai = 0; ai < (THIN ? 1 : 2); ++ai) _Pragma("unroll") for (int m = 0; m < (THIN ? 1 : 4); ++m) { const int row = u.pm * 256 + ai * 128 + wr * 64 + m * 16 + fr; __VA_ARGS__ }

template <int MAPT> DEVI int cmap(int n) {
  if (MAPT == 1) {
    if (n < 4096 + 1792) return n;
    int rc = n - 4096;
    if (rc < 2720) return 5896 + (rc - 1792);
    if (rc < 2728) return 5888 + (rc - 2720);
    return -1;
  } else if (MAPT == 2) {
    int nt = n >> 8, r = n & 255;
    return r < 128 ? nt * 128 + r : 256 + nt * 128 + (r - 128);
  }
  return n;
}
template <int MAPT> DEVI void prep_matrix(float* tile, const float* src, int K, int Nsrc, int Ndst, const float* g, u16* dst) { const int TX = opaque_tid();
  const int tk = K / 64, tn = Ndst / 64, tid = TX, ntile = tk * tn;
  float v[8];
  auto ld = [&](int t) { const int k0 = (t % tk) * 64, n0 = (t / tk) * 64;
    for (int i = 0; i < 8; ++i) { int idx = tid + i * 512, kk = idx >> 6, nn = idx & 63; int sc = cmap<MAPT>(n0 + nn);
      float x = sc >= 0 ? src[(size_t)(k0 + kk) * Nsrc + sc] : 0.f; if (g) x *= g[k0 + kk]; v[i] = x; } };
  int t = blockIdx.x;
  if (t < ntile) ld(t);
  for (; t < ntile; t += gridDim.x) {
    const int k0 = (t % tk) * 64, n0 = (t / tk) * 64;
    __syncthreads();
    for (int i = 0; i < 8; ++i) { int idx = tid + i * 512, kk = idx >> 6, nn = idx & 63; tile[kk * 65 + nn] = v[i]; }
    __syncthreads();
    if (t + (int)gridDim.x < ntile) ld(t + gridDim.x);
    { int nn = tid >> 3, k8 = (tid & 7) * 8; u32x4 o;
      for (int j = 0; j < 4; ++j) o[j] = pack2(tile[(k8 + 2 * j) * 65 + nn], tile[(k8 + 2 * j + 1) * 65 + nn]);
      *(u32x4*)(dst + (size_t)(n0 + nn) * K + k0 + k8) = o; }
  }
}
DEVI void prep_layer(PRef p, int l, float* tile) { unsigned char* const wsb = opq(p.ws);
  u16* W = (u16*)(wsb + WS_W);
  const float* ng = p.in[I_NG] + (size_t)l * 4 * DM;
  prep_matrix<1>(tile, p.in[I_WIN] + (size_t)l * DM * INW, 1024, INW, NIN, ng, W + W_IN / 2);
  prep_matrix<0>(tile, p.in[I_W1] + (size_t)l * DM * 4096, 1024, 4096, 4096, ng + 2 * DM, W + W_1 / 2);
  prep_matrix<0>(tile, p.in[I_W2] + (size_t)l * DM * 4096, 4096, 1024, 1024, nullptr, W + W_2 / 2);
  prep_matrix<0>(tile, p.in[I_WBR] + (size_t)l * 1280 * DM, 1280, 1024, 1024, nullptr, W + W_BR / 2);
  prep_matrix<0>(tile, p.in[I_WOUT] + (size_t)l * DM * DM, 1024, 1024, 1024, nullptr, W + W_OUT / 2);
  prep_matrix<0>(tile, p.in[I_WUQ] + (size_t)l * 384 * 768, 384, 768, 768, p.in[I_QN] + l * 384, W + W_UQ / 2);
  prep_matrix<0>(tile, p.in[I_WUKV] + (size_t)l * 256 * 1024, 256, 1024, 1024, p.in[I_KVN] + l * 256, W + W_UKV / 2);
  prep_matrix<2>(tile, p.in[I_GLU] + (size_t)l * 256 * 512, 256, 512, 512, nullptr, W + W_GLU / 2);
}

DEVI void phase0_act(PRef p) { const int TX = opaque_tid(); unsigned char* const wsb = opq(p.ws);
  const int lane = TX & 63, gw = blockIdx.x * 8 + (TX >> 6), NW = gridDim.x * 8;
  u16* hb = (u16*)(wsb + WS_HB); float* rs = (float*)(wsb + WS_RS); float* hm = (float*)(wsb + WS_HM);
  for (int row = gw; row < NREAL + NMETA; row += NW) {
    const float* src = row < NREAL ? p.in[I_X] + (size_t)row * DM : (row < METAROW + NMETA ? p.in[I_META] + (size_t)(row - METAROW) * DM : nullptr);
    float ss = 0.f;
    for (int i = 0; i < 4; ++i) {
      f32x4 v = src ? *(const f32x4*)(src + i * 256 + lane * 4) : (f32x4){0.f, 0.f, 0.f, 0.f};
      ss += v[0] * v[0] + v[1] * v[1] + v[2] * v[2] + v[3] * v[3];
      u32x2 o; o[0] = pack2(v[0], v[1]); o[1] = pack2(v[2], v[3]);
      *(u32x2*)(hb + (size_t)row * DM + i * 256 + lane * 4) = o;
      if (row >= NREAL) *(f32x4*)(hm + (size_t)(row - METAROW) * DM + i * 256 + lane * 4) = v;
    }
    ss = wave_sum(ss);
    if (lane == 0) rs[row] = rsqrtf(ss * (1.f / DM) + EPS);
  }
  float* rope = (float*)(wsb + WS_ROPE);
  for (int i = blockIdx.x * 512 + TX; i < 4112 * 16; i += gridDim.x * 512) {
    int pos = i >> 4, f = i & 15;
    float inv = exp2f(-(float)(2 * f) * (13.287712379549449f / 32.f));
    float ang = (float)pos * inv;
    rope[2 * i] = cosf(ang); rope[2 * i + 1] = sinf(ang);
  }
}

DEVI void row_pass(PRef p, const u16* y, const float* hsrc_real, const float* g, bool fin) { const int TX = opaque_tid(); unsigned char* const wsb = opq(p.ws);
  const int lane = TX & 63, gw = blockIdx.x * 8 + (TX >> 6), NW = gridDim.x * 8;
  u16* hb = (u16*)(wsb + WS_HB); float* rs = (float*)(wsb + WS_RS); float* hm = (float*)(wsb + WS_HM);
  const int NR = NREAL + NMETA;
  u32x2 yr[4]; f32x4 hr[4];
  if (gw < NR) { const float* hs = gw < NREAL ? hsrc_real + (size_t)gw * DM : hm + (size_t)(gw - METAROW) * DM;
    for (int i = 0; i < 4; ++i) { yr[i] = *(const u32x2*)(y + (size_t)gw * DM + i * 256 + lane * 4); hr[i] = *(const f32x4*)(hs + i * 256 + lane * 4); } }
  f32x4 gg[4]; for (int i = 0; i < 4; ++i) gg[i] = *(const f32x4*)(g + i * 256 + lane * 4);
  for (int row = gw; row < NR; row += NW) {
    const int nx = row + NW; u32x2 yn[4]; f32x4 hn[4];
    if (nx < NR) { const float* hs = nx < NREAL ? hsrc_real + (size_t)nx * DM : hm + (size_t)(nx - METAROW) * DM;
      for (int i = 0; i < 4; ++i) { yn[i] = *(const u32x2*)(y + (size_t)nx * DM + i * 256 + lane * 4); hn[i] = *(const f32x4*)(hs + i * 256 + lane * 4); } }
    float* hd = row < NREAL ? p.out + (size_t)row * DM : hm + (size_t)(row - METAROW) * DM;
    float yv[16]; float ss = 0.f;
    for (int i = 0; i < 4; ++i) { yv[4 * i] = blo(yr[i][0]); yv[4 * i + 1] = bhi(yr[i][0]); yv[4 * i + 2] = blo(yr[i][1]); yv[4 * i + 3] = bhi(yr[i][1]);
      for (int j = 0; j < 4; ++j) ss += yv[4 * i + j] * yv[4 * i + j]; }
    ss = wave_sum(ss);
    const float r = rsqrtf(ss * (1.f / DM) + EPS);
    float s2 = 0.f;
    for (int i = 0; i < 4; ++i) {
      f32x4 h = hr[i];
      for (int j = 0; j < 4; ++j) { h[j] += yv[4 * i + j] * r * gg[i][j]; s2 += h[j] * h[j]; }
      *(f32x4*)(hd + i * 256 + lane * 4) = h;
      if (!fin) { u32x2 o; o[0] = pack2(h[0], h[1]); o[1] = pack2(h[2], h[3]);
        *(u32x2*)(hb + (size_t)row * DM + i * 256 + lane * 4) = o; }
    }
    if (!fin) { s2 = wave_sum(s2);
      if (lane == 0) rs[row] = rsqrtf(s2 * (1.f / DM) + EPS); }
    for (int i = 0; i < 4; ++i) { yr[i] = yn[i]; hr[i] = hn[i]; }
  }
}

DEVI int prev_row(int t, int d) {
  if (t < NREAL) { int s = t & (SEQ - 1); return s >= d ? t - d : METAROW + NMETA + s - d; }
  int pp = t - METAROW; return pp >= d ? t - d : -1;
}
DEVI void phase_conv(PRef p, int l) { const int TX = opaque_tid(); unsigned char* const wsb = opq(p.ws);
  const int lane = TX & 63, gw = blockIdx.x * 8 + (TX >> 6), NW = gridDim.x * 8;
  u16* rest = (u16*)(wsb + WS_REST); u16* kr = (u16*)(wsb + WS_KR); const float* rope = (const float*)(wsb + WS_ROPE);
  const float* cw = p.in[I_CONVW] + (size_t)l * 3 * 256;
  float w0[4], w1[4], w2[4];
  for (int j = 0; j < 4; ++j) { w0[j] = cw[lane * 4 + j]; w1[j] = cw[256 + lane * 4 + j]; w2[j] = cw[512 + lane * 4 + j]; }
  auto ld = [&](int row, u32x2 (&d)[7]) {
    const u16* rr = rest + (size_t)row * NREST; const int r1 = prev_row(row, 1), r2 = prev_row(row, 2);
    d[0] = *(const u32x2*)(rr + RC_CB + lane * 4); d[1] = *(const u32x2*)(rr + RC_CC + lane * 4); d[2] = *(const u32x2*)(rr + RC_CV + lane * 4);
    d[3] = (u32x2){0, 0}; d[4] = d[3]; d[5] = d[3]; d[6] = d[3];
    if (r1 >= 0) { d[3] = *(const u32x2*)(rest + (size_t)r1 * NREST + RC_CC + lane * 4); d[4] = *(const u32x2*)(rest + (size_t)r1 * NREST + RC_CV + lane * 4); }
    if (r2 >= 0) { d[5] = *(const u32x2*)(rest + (size_t)r2 * NREST + RC_CC + lane * 4); d[6] = *(const u32x2*)(rest + (size_t)r2 * NREST + RC_CV + lane * 4); } };
  const int NR = NREAL + NMETA;
  u32x2 cur[7]; unsigned kcur = 0;
  if (gw < NR) { ld(gw, cur); if (lane < 32) kcur = rest[(size_t)gw * NREST + RC_KR + lane]; }
  for (int row = gw; row < NR; row += NW) {
    const int nx = row + NW; u32x2 nxt[7]; unsigned knx = 0;
    if (nx < NR) { ld(nx, nxt); if (lane < 32) knx = rest[(size_t)nx * NREST + RC_KR + lane]; }
    u16* rr = rest + (size_t)row * NREST;
    float o[4];
    for (int j = 0; j < 4; ++j) {
      unsigned a0 = cur[1][j >> 1], b0 = cur[2][j >> 1], a1 = cur[3][j >> 1], b1 = cur[4][j >> 1], a2 = cur[5][j >> 1], b2 = cur[6][j >> 1], g = cur[0][j >> 1];
      float u0 = (j & 1) ? bhi(a0) * bhi(b0) : blo(a0) * blo(b0);
      float u1 = (j & 1) ? bhi(a1) * bhi(b1) : blo(a1) * blo(b1);
      float u2 = (j & 1) ? bhi(a2) * bhi(b2) : blo(a2) * blo(b2);
      float gg = (j & 1) ? bhi(g) : blo(g);
      o[j] = gg * (w0[j] * u2 + w1[j] * u1 + w2[j] * u0);
    }
    u32x2 ov; ov[0] = pack2(o[0], o[1]); ov[1] = pack2(o[2], o[3]);
    *(u32x2*)(rr + RC_CB + lane * 4) = ov;
    { const int pos = row_pos(row);
      const float xm = b2f((u16)kcur), xo = b2f((u16)__shfl_xor((int)kcur, 16));
      if (lane < 32) { const int f = lane & 15; const float c = rope[(pos * 16 + f) * 2], sn = rope[(pos * 16 + f) * 2 + 1];
        kr[(size_t)row * 32 + lane] = f2b(lane < 16 ? xm * c - xo * sn : xm * c + xo * sn); } }
    for (int i = 0; i < 7; ++i) cur[i] = nxt[i]; kcur = knx;
  }
}

DEVI void chunk_rows(int b, int c, int& row0, int& len) { if (c == 0) { row0 = METAROW; len = NMETA; } else { row0 = b * SEQ + (c - 1) * 64; len = 64; } }
struct S5Const { float lr, li; float bre[16], bim[16]; };
DEVI void s5_consts(PRef p, int l, int g, int pp, S5Const& k) {
  const float are = p.in[I_ARE][(l * 16 + g) * 64 + pp], aim = p.in[I_AIM][(l * 16 + g) * 64 + pp];
  const float dt = expf(p.in[I_LSTEP][l * 16 + g]);
  const float mag = expf(are * dt);
  k.lr = mag * cosf(aim * dt); k.li = mag * sinf(aim * dt);
  const float den = are * are + aim * aim, xr = k.lr - 1.f, xi = k.li;
  const float zr = (xr * are + xi * aim) / den, zi = (xi * are - xr * aim) / den;
  const float* br = p.in[I_BRE] + ((size_t)(l * 16 + g) * 64 + pp) * 16; const float* bi = p.in[I_BIM] + ((size_t)(l * 16 + g) * 64 + pp) * 16;
  for (int i = 0; i < 16; ++i) { float a = br[i], b = bi[i]; k.bre[i] = zr * a - zi * b; k.bim[i] = zr * b + zi * a; }
}
DEVI void s5_load_u(PRef p, float* ul, int row0, int len) { const int TX = opaque_tid(); unsigned char* const wsb = opq(p.ws);
  const u16* rest = (const u16*)(wsb + WS_REST);
  for (int i = TX; i < 64 * 32; i += 512) { int r = i >> 5, c8 = (i & 31) * 8;
    u32x4 v = {0, 0, 0, 0}; if (r < len) v = *(const u32x4*)(rest + (size_t)(row0 + r) * NREST + RC_SU + c8);
    *(f32x4*)(ul + r * 256 + c8) = (f32x4){blo(v[0]), bhi(v[0]), blo(v[1]), bhi(v[1])}; *(f32x4*)(ul + r * 256 + c8 + 4) = (f32x4){blo(v[2]), bhi(v[2]), blo(v[3]), bhi(v[3])}; }
}
DEVI void s5_bu(const float* urow, const S5Const& k, float& bur, float& bui) {
  bur = 0.f; bui = 0.f;
#pragma unroll
  for (int q = 0; q < 4; ++q) { const f32x4 x = *(const f32x4*)(urow + 4 * q);
#pragma unroll
    for (int i = 0; i < 4; ++i) { bur += k.bre[4 * q + i] * x[i]; bui += k.bim[4 * q + i] * x[i]; } }
}
DEVI void s5_passA(PRef p, int l, unsigned char* lds) { const int TX = opaque_tid(); unsigned char* const wsb = opq(p.ws);
  u16* ulb = (u16*)lds; float* buL = (float*)(lds + 32768); float* send = (float*)(wsb + WS_S5);
  const u16* rest = (const u16*)(wsb + WS_REST);
  const int wave = TX >> 6, lane = TX & 63, fr = lane & 15, fq = lane >> 4;
  float* bw = buL + wave * 16 * 132;
  for (int it = blockIdx.x; it < NB * 64 + 1; it += gridDim.x) {
    const int b = it < NB * 64 ? it >> 6 : 0, c = it < NB * 64 ? 1 + (it & 63) : 0; int row0, len; chunk_rows(b, c, row0, len);
    __syncthreads();
    for (int i = TX; i < 64 * 32; i += 512) { int r = i >> 5, c8 = (i & 31) * 8;
      u32x4 v = {0, 0, 0, 0}; if (r < len) v = *(const u32x4*)(rest + (size_t)(row0 + r) * NREST + RC_SU + c8);
      *(u32x4*)(ulb + r * 256 + c8) = v; }
    __syncthreads();
    for (int gi = 0; gi < 2; ++gi) { const int g = wave * 2 + gi;
      const float are = p.in[I_ARE][(l * 16 + g) * 64 + lane], aim = p.in[I_AIM][(l * 16 + g) * 64 + lane];
      const float dt = expf(p.in[I_LSTEP][l * 16 + g]); const float mag = expf(are * dt);
      const float lr = mag * cosf(aim * dt), li = mag * sinf(aim * dt);
      { const float den = are * are + aim * aim, xr = lr - 1.f, xi = li;
        __builtin_amdgcn_wave_barrier();
        bw[lane] = (xr * are + xi * aim) / den; bw[64 + lane] = (xi * are - xr * aim) / den;
        __builtin_amdgcn_wave_barrier(); }
      bf16x8 bfr[4], bfi[4];
#pragma unroll
      for (int nt = 0; nt < 4; ++nt) { const int ps = 16 * nt + fr; const float zr = bw[ps], zi = bw[64 + ps];
        u32x4 wr4 = {0, 0, 0, 0}, wi4 = {0, 0, 0, 0};
        if (fq < 2) { const float* br = p.in[I_BRE] + ((size_t)(l * 16 + g) * 64 + ps) * 16 + 8 * fq; const float* bi = p.in[I_BIM] + ((size_t)(l * 16 + g) * 64 + ps) * 16 + 8 * fq;
          const f32x4 r0 = *(const f32x4*)br, r1 = *(const f32x4*)(br + 4), i0 = *(const f32x4*)bi, i1 = *(const f32x4*)(bi + 4);
          wr4[0] = cvtpk(zr * r0[0] - zi * i0[0], zr * r0[1] - zi * i0[1]); wr4[1] = cvtpk(zr * r0[2] - zi * i0[2], zr * r0[3] - zi * i0[3]);
          wr4[2] = cvtpk(zr * r1[0] - zi * i1[0], zr * r1[1] - zi * i1[1]); wr4[3] = cvtpk(zr * r1[2] - zi * i1[2], zr * r1[3] - zi * i1[3]);
          wi4[0] = cvtpk(zr * i0[0] + zi * r0[0], zr * i0[1] + zi * r0[1]); wi4[1] = cvtpk(zr * i0[2] + zi * r0[2], zr * i0[3] + zi * r0[3]);
          wi4[2] = cvtpk(zr * i1[0] + zi * r1[0], zr * i1[1] + zi * r1[1]); wi4[3] = cvtpk(zr * i1[2] + zi * r1[2], zr * i1[3] + zi * r1[3]); }
        bfr[nt] = __builtin_bit_cast(bf16x8, wr4); bfi[nt] = __builtin_bit_cast(bf16x8, wi4); }
      float sr = 0.f, si = 0.f;
      for (int sb = 0; sb < len; sb += 16) {
        u32x4 au = {0, 0, 0, 0}; if (fq < 2) au = *(const u32x4*)(ulb + (sb + fr) * 256 + g * 16 + 8 * fq);
        const bf16x8 af = __builtin_bit_cast(bf16x8, au);
        __builtin_amdgcn_wave_barrier();
#pragma unroll
        for (int nt = 0; nt < 4; ++nt) { const f32x4 z4 = {0.f, 0.f, 0.f, 0.f};
          const f32x4 dr = __builtin_amdgcn_mfma_f32_16x16x32_bf16(af, bfr[nt], z4, 0, 0, 0), di = __builtin_amdgcn_mfma_f32_16x16x32_bf16(af, bfi[nt], z4, 0, 0, 0);
#pragma unroll
          for (int r = 0; r < 4; ++r) { bw[(4 * fq + r) * 132 + 16 * nt + fr] = dr[r]; bw[(4 * fq + r) * 132 + 64 + 16 * nt + fr] = di[r]; } }
        __builtin_amdgcn_wave_barrier();
        for (int tt = 0; tt < 16; ++tt) { const float bur = bw[tt * 132 + lane], bui = bw[tt * 132 + 64 + lane];
          float nr = lr * sr - li * si + bur, ni = lr * si + li * sr + bui; sr = nr; si = ni; }
      }
      float* o = send + ((size_t)(c == 0 ? NB * NCH : b * NCH + c) * 16 + g) * 128; o[lane] = sr; o[64 + lane] = si; }
  }
}
DEVI void s5_scan(PRef p, int l, int blk0) { const int TX = opaque_tid(); unsigned char* const wsb = opq(p.ws);
  float* send = (float*)(wsb + WS_S5);
  const int lane = TX & 63, gw = ((int)blockIdx.x - blk0) * 8 + (TX >> 6);
  if (gw < 0 || gw >= NB * 16) return;
  const int b = gw >> 4, g = gw & 15;
  const float are = p.in[I_ARE][(l * 16 + g) * 64 + lane], aim = p.in[I_AIM][(l * 16 + g) * 64 + lane];
  const float dt = expf(p.in[I_LSTEP][l * 16 + g]); const float mag = expf(are * dt);
  float l16r = mag * cosf(aim * dt), l16i = mag * sinf(aim * dt);
  for (int i = 0; i < 4; ++i) { float a = l16r * l16r - l16i * l16i, bb = l16r * l16i; l16r = a; l16i = bb + bb; }
  float l64r = l16r, l64i = l16i; for (int i = 0; i < 2; ++i) { float a = l64r * l64r - l64i * l64i, bb = l64r * l64i; l64r = a; l64i = bb + bb; }
  float sr = 0.f, si = 0.f;
  for (int c0 = 0; c0 < NCH; c0 += 5) {
    float er[5], ei[5];
    for (int i = 0; i < 5; ++i) { const float* e = send + ((size_t)((c0 + i) == 0 ? NB * NCH : b * NCH + c0 + i) * 16 + g) * 128; er[i] = e[lane]; ei[i] = e[64 + lane]; }
    for (int i = 0; i < 5; ++i) { float* e = send + ((size_t)(b * NCH + c0 + i) * 16 + g) * 128; e[lane] = sr; e[64 + lane] = si;
      const float pr = (c0 + i) == 0 ? l16r : l64r, pi = (c0 + i) == 0 ? l16i : l64i;
      const float nr = pr * sr - pi * si + er[i], ni = pr * si + pi * sr + ei[i]; sr = nr; si = ni; }
  }
}
DEVI void s5_passB_item(PRef p, int l, int b, int c, unsigned char* lds) { const int TX = opaque_tid(); unsigned char* const wsb = opq(p.ws);
  u16* ulb = (u16*)lds;
  unsigned* sst = (unsigned*)(lds + 32768);
  float* buL = (float*)(lds + 32768 + 34816);
  const float* send = (const float*)(wsb + WS_S5); u16* rest = (u16*)(wsb + WS_REST);
  const int wave = TX >> 6, lane = TX & 63, fr = lane & 15, fq = lane >> 4;
  int row0, len; chunk_rows(b, c, row0, len);
  __syncthreads();
  for (int i = TX; i < 64 * 32; i += 512) { int r = i >> 5, c8 = (i & 31) * 8;
    u32x4 v = {0, 0, 0, 0}; if (r < len) v = *(const u32x4*)(rest + (size_t)(row0 + r) * NREST + RC_SU + c8);
    *(u32x4*)(ulb + r * 256 + c8) = v; }
  __syncthreads();
  unsigned* sw = sst + wave * 16 * 68; float* bw = buL + wave * 16 * 132;
  for (int gi = 0; gi < 2; ++gi) { const int g = wave * 2 + gi;
    const float are = p.in[I_ARE][(l * 16 + g) * 64 + lane], aim = p.in[I_AIM][(l * 16 + g) * 64 + lane];
    const float dt = expf(p.in[I_LSTEP][l * 16 + g]); const float mag = expf(are * dt);
    const float lr = mag * cosf(aim * dt), li = mag * sinf(aim * dt);
    { const float den = are * are + aim * aim, xr = lr - 1.f, xi = li;
      __builtin_amdgcn_wave_barrier();
      bw[lane] = (xr * are + xi * aim) / den; bw[64 + lane] = (xi * are - xr * aim) / den;
      __builtin_amdgcn_wave_barrier(); }
    bf16x8 bfr[4], bfi[4];
#pragma unroll
    for (int nt = 0; nt < 4; ++nt) { const int ps = 16 * nt + fr; const float zr = bw[ps], zi = bw[64 + ps];
      u32x4 wr4 = {0, 0, 0, 0}, wi4 = {0, 0, 0, 0};
      if (fq < 2) { const float* br = p.in[I_BRE] + ((size_t)(l * 16 + g) * 64 + ps) * 16 + 8 * fq; const float* bi = p.in[I_BIM] + ((size_t)(l * 16 + g) * 64 + ps) * 16 + 8 * fq;
        const f32x4 r0 = *(const f32x4*)br, r1 = *(const f32x4*)(br + 4), i0 = *(const f32x4*)bi, i1 = *(const f32x4*)(bi + 4);
        wr4[0] = cvtpk(zr * r0[0] - zi * i0[0], zr * r0[1] - zi * i0[1]); wr4[1] = cvtpk(zr * r0[2] - zi * i0[2], zr * r0[3] - zi * i0[3]);
        wr4[2] = cvtpk(zr * r1[0] - zi * i1[0], zr * r1[1] - zi * i1[1]); wr4[3] = cvtpk(zr * r1[2] - zi * i1[2], zr * r1[3] - zi * i1[3]);
        wi4[0] = cvtpk(zr * i0[0] + zi * r0[0], zr * i0[1] + zi * r0[1]); wi4[1] = cvtpk(zr * i0[2] + zi * r0[2], zr * i0[3] + zi * r0[3]);
        wi4[2] = cvtpk(zr * i1[0] + zi * r1[0], zr * i1[1] + zi * r1[1]); wi4[3] = cvtpk(zr * i1[2] + zi * r1[2], zr * i1[3] + zi * r1[3]); }
      bfr[nt] = __builtin_bit_cast(bf16x8, wr4); bfi[nt] = __builtin_bit_cast(bf16x8, wi4); }
    const float* e0 = send + ((size_t)(b * NCH + c) * 16 + g) * 128; float sr = e0[lane], si = e0[64 + lane];
    bf16x8 cf[4];
    for (int ks = 0; ks < 4; ++ks) { const int p0 = (32 * ks + 8 * fq) >> 1;
      const f32x4 cr = *(const f32x4*)(p.in[I_CRE] + ((size_t)(l * 16 + g) * 16 + fr) * 64 + p0), ci = *(const f32x4*)(p.in[I_CIM] + ((size_t)(l * 16 + g) * 16 + fr) * 64 + p0);
      u32x4 t4; for (int j = 0; j < 4; ++j) t4[j] = cvtpk(cr[j], -ci[j]);
      cf[ks] = __builtin_bit_cast(bf16x8, t4); }
    const float dsk = p.in[I_SD][l * 256 + g * 16 + fr];
    for (int sb = 0; sb < len; sb += 16) {
      u32x4 au = {0, 0, 0, 0}; if (fq < 2) au = *(const u32x4*)(ulb + (sb + fr) * 256 + g * 16 + 8 * fq);
      const bf16x8 af = __builtin_bit_cast(bf16x8, au);
      __builtin_amdgcn_wave_barrier();
#pragma unroll
      for (int nt = 0; nt < 4; ++nt) { const f32x4 z4 = {0.f, 0.f, 0.f, 0.f};
        const f32x4 dr = __builtin_amdgcn_mfma_f32_16x16x32_bf16(af, bfr[nt], z4, 0, 0, 0), di = __builtin_amdgcn_mfma_f32_16x16x32_bf16(af, bfi[nt], z4, 0, 0, 0);
#pragma unroll
        for (int r = 0; r < 4; ++r) { bw[(4 * fq + r) * 132 + 16 * nt + fr] = dr[r]; bw[(4 * fq + r) * 132 + 64 + 16 * nt + fr] = di[r]; } }
      __builtin_amdgcn_wave_barrier();
      for (int tt = 0; tt < 16; ++tt) { const float bur = bw[tt * 132 + lane], bui = bw[tt * 132 + 64 + lane];
        float nr = lr * sr - li * si + bur, ni = lr * si + li * sr + bui; sr = nr; si = ni;
        sw[tt * 68 + lane] = cvtpk(sr, si); }
      __builtin_amdgcn_wave_barrier();
      f32x4 d = {0.f, 0.f, 0.f, 0.f};
      for (int ks = 0; ks < 4; ++ks) { bf16x8 a = *(const bf16x8*)(sw + fr * 68 + 16 * ks + 4 * fq); d = __builtin_amdgcn_mfma_f32_16x16x32_bf16(a, cf[ks], d, 0, 0, 0); }
      for (int r = 0; r < 4; ++r) { const int t = sb + 4 * fq + r; const float u = b2f(ulb[t * 256 + g * 16 + fr]);
        rest[(size_t)(row0 + t) * NREST + RC_CV + g * 16 + fr] = f2b(d[r] + dsk * u); }
    }
  }
}

constexpr int MP = 72;
DEVI void mlstm_item(PRef p, int l, int b, int h, unsigned char* lds) { const int TX = opaque_tid(); unsigned char* const wsb = opq(p.ws);
  u16* Qs = (u16*)lds; u16* Ks = Qs + 64 * MP; u16* KTs = Ks + 64 * MP; u16* VTs = KTs + 64 * MP; u16* Cs = VTs + 80 * MP; u16* Ps = Cs + 80 * MP; u16* Os = Ps + 64 * MP;
  float* Hs = (float*)(Os + 64 * MP);
  float* sa = Hs + 64 * 65; float* sM = sa + 64; float* swi = sM + 64; float* sem = swi + 64; float* sden = sem + 64; float* swr = sden + 64; float* sdec = swr + 64; u16* VTw = (u16*)(sdec + 64);
  u16* rest = (u16*)(wsb + WS_REST); const float* gp = (const float*)(wsb + WS_GP);
  const int tid = TX, wave = tid >> 6, lane = tid & 63, fr = lane & 15, fq = lane >> 4;
  const float gbi = p.in[I_GATEB][l * 8 + h], gbf = p.in[I_GATEB][l * 8 + 4 + h];
  const int mt = wave >> 1, nh = wave & 1;
  __syncthreads();
  for (int i = tid; i < 80 * MP; i += 512) { Cs[i] = 0; int r = i / MP; VTs[i] = (r == 64) ? (u16)0x3F80 : (u16)0; }
  __syncthreads();
  f32x4 cst[3]; for (int i = 0; i < 3; ++i) cst[i] = (f32x4){0.f, 0.f, 0.f, 0.f};
  float m_prev = 0.f;
  const int lr = tid >> 3, c8 = (tid & 7) * 8;
  u32x4 qn = {0, 0, 0, 0}, kn = qn, vn = qn, on = qn; float gin = 0.f, gfn = 0.f;
  { int row0, len; chunk_rows(b, 0, row0, len);
    if (lr < len) { const u16* rp = rest + (size_t)(row0 + lr) * NREST + h * 64 + c8;
      qn = *(const u32x4*)(rp + RC_MQ); kn = *(const u32x4*)(rp + RC_MK); vn = *(const u32x4*)(rp + RC_MV); on = *(const u32x4*)(rp + RC_MO); }
    if (wave == 0 && lane < len) { const float* g8 = gp + (size_t)(row0 + lane) * 8; gin = g8[h]; gfn = g8[4 + h]; } }
  for (int c = 0; c < NCH; ++c) {
    int row0, len; chunk_rows(b, c, row0, len);
    const float gic = gin, gfc = gfn;
    { u32x4 q = qn, k = kn, v = vn, o = on;
      if (c + 1 < NCH) { int r1, l1; chunk_rows(b, c + 1, r1, l1); qn = (u32x4){0, 0, 0, 0}; kn = qn; vn = qn; on = qn;
        if (lr < l1) { const u16* rp = rest + (size_t)(r1 + lr) * NREST + h * 64 + c8;
          qn = *(const u32x4*)(rp + RC_MQ); kn = *(const u32x4*)(rp + RC_MK); vn = *(const u32x4*)(rp + RC_MV); on = *(const u32x4*)(rp + RC_MO); }
        if (wave == 0 && lane < l1) { const float* g8 = gp + (size_t)(r1 + lane) * 8; gin = g8[h]; gfn = g8[4 + h]; } }
      for (int j = 0; j < 4; ++j) k[j] = pack2(blo(k[j]) * 0.125f, bhi(k[j]) * 0.125f);
      *(u32x4*)(Qs + lr * MP + c8) = q; *(u32x4*)(Ks + lr * MP + c8) = k; *(u32x4*)(Os + lr * MP + c8) = o;
      for (int j = 0; j < 4; ++j) { KTs[(c8 + 2 * j) * MP + lr] = (u16)(k[j] & 0xffff); KTs[(c8 + 2 * j + 1) * MP + lr] = (u16)(k[j] >> 16);
        VTs[(c8 + 2 * j) * MP + lr] = (u16)(v[j] & 0xffff); VTs[(c8 + 2 * j + 1) * MP + lr] = (u16)(v[j] >> 16); } }
    if (wave == 0) {
      float ig = -INFINITY, lf = 0.f;
      if (lane < len) { ig = gic + gbi; float x = gfc + gbf; lf = fminf(x, 0.f) - __logf(1.f + __expf(-fabsf(x))); }
      float bc = lf; for (int o = 1; o < 64; o <<= 1) { float t = __shfl_up(bc, o); if (lane >= o) bc += t; }
      float a = ig - bc;
      float pm = a; for (int o = 1; o < 64; o <<= 1) { float t = __shfl_up(pm, o); if (lane >= o) pm = fmaxf(pm, t); }
      float M = fmaxf(m_prev, pm);
      float Mlast = __shfl(M, 63), blast = __shfl(bc, 63);
      sa[lane] = a; sM[lane] = M; swi[lane] = __expf(m_prev - M); sem[lane] = __expf(-(bc + M)); swr[lane] = __expf(a - Mlast);
      if (lane == 0) sdec[0] = __expf(m_prev - Mlast);
      m_prev = blast + Mlast;
    }
    __syncthreads();
    {
      for (int i = tid; i < 80 * 8; i += 512) { const int v = i >> 3, r8 = (i & 7) * 8; u32x4 x = *(const u32x4*)(VTs + v * MP + r8); u32x4 o;
        for (int j = 0; j < 4; ++j) o[j] = cvtpk(blo(x[j]) * swr[r8 + 2 * j], bhi(x[j]) * swr[r8 + 2 * j + 1]);
        *(u32x4*)(VTw + v * MP + r8) = o; } }
    for (int ni = 0; ni < 2; ++ni) { const int nt = nh * 2 + ni; f32x4 s = {0.f, 0.f, 0.f, 0.f};
      for (int ks = 0; ks < 2; ++ks) { bf16x8 a = *(const bf16x8*)(Qs + (mt * 16 + fr) * MP + 32 * ks + 8 * fq); bf16x8 bb = *(const bf16x8*)(Ks + (nt * 16 + fr) * MP + 32 * ks + 8 * fq);
        s = __builtin_amdgcn_mfma_f32_16x16x32_bf16(a, bb, s, 0, 0, 0); }
      const int r = nt * 16 + fr; const float ar = sa[r];
      for (int j = 0; j < 4; ++j) { const int srow = mt * 16 + 4 * fq + j; float w = (r <= srow) ? __expf(ar - sM[srow]) : 0.f; Ps[srow * MP + r] = f2b(s[j] * w); } }
    __syncthreads();
    f32x4 a1[3], a2[3]; const int ntl[3] = {nh * 2, nh * 2 + 1, 4}; const int ncnt = nh == 0 ? 3 : 2;
    for (int i = 0; i < 3; ++i) { a1[i] = (f32x4){0.f, 0.f, 0.f, 0.f}; a2[i] = a1[i]; }
    for (int ks = 0; ks < 2; ++ks) { bf16x8 pa = *(const bf16x8*)(Ps + (mt * 16 + fr) * MP + 32 * ks + 8 * fq); bf16x8 qa = *(const bf16x8*)(Qs + (mt * 16 + fr) * MP + 32 * ks + 8 * fq);
      for (int i = 0; i < 3; ++i) if (i < ncnt) { bf16x8 vb = *(const bf16x8*)(VTs + (ntl[i] * 16 + fr) * MP + 32 * ks + 8 * fq); bf16x8 cb = *(const bf16x8*)(Cs + (ntl[i] * 16 + fr) * MP + 32 * ks + 8 * fq);
        a1[i] = __builtin_amdgcn_mfma_f32_16x16x32_bf16(pa, vb, a1[i], 0, 0, 0); a2[i] = __builtin_amdgcn_mfma_f32_16x16x32_bf16(qa, cb, a2[i], 0, 0, 0); } }
    if (nh == 0 && fr == 0) for (int j = 0; j < 4; ++j) { const int srow = mt * 16 + 4 * fq + j; sden[srow] = a1[2][j] + swi[srow] * a2[2][j]; }
    __syncthreads();
    for (int i = 0; i < 2; ++i) for (int j = 0; j < 4; ++j) { const int srow = mt * 16 + 4 * fq + j, v = ntl[i] * 16 + fr;
      float num = a1[i][j] + swi[srow] * a2[i][j]; float hv = num * __builtin_amdgcn_rcpf(fmaxf(fabsf(sden[srow]), sem[srow]));
      hv *= sigm(b2f(Os[srow * MP + v])); Hs[srow * 65 + v] = hv; }
    { const float dec = sdec[0];
      const int tm[3] = {mt, mt, 4}, tn[3] = {nh * 2, nh * 2 + 1, wave}; const int tc = wave < 4 ? 3 : 2;
      for (int i = 0; i < 3; ++i) if (i < tc) { f32x4 acc = cst[i] * dec;
        for (int ks = 0; ks < 2; ++ks) { bf16x8 va = *(const bf16x8*)(VTw + (tm[i] * 16 + fr) * MP + 32 * ks + 8 * fq);
          bf16x8 kb = *(const bf16x8*)(KTs + (tn[i] * 16 + fr) * MP + 32 * ks + 8 * fq);
          acc = __builtin_amdgcn_mfma_f32_16x16x32_bf16(va, kb, acc, 0, 0, 0); }
        cst[i] = acc; } }
    __syncthreads();
    { const int tm[3] = {mt, mt, 4}, tn[3] = {nh * 2, nh * 2 + 1, wave}; const int tc = wave < 4 ? 3 : 2;
      for (int i = 0; i < 3; ++i) if (i < tc) for (int j = 0; j < 4; ++j) Cs[(tm[i] * 16 + 4 * fq + j) * MP + tn[i] * 16 + fr] = f2b(cst[i][j]); }
    { float hv[8]; float ss = 0.f; for (int j = 0; j < 8; ++j) { hv[j] = Hs[lr * 65 + c8 + j]; ss += hv[j] * hv[j]; }
      ss += __shfl_xor(ss, 1); ss += __shfl_xor(ss, 2); ss += __shfl_xor(ss, 4);
      const float r = rsqrtf(ss * (1.f / 64.f) + EPS); const float* ng = p.in[I_MNORM] + l * 256 + h * 64 + c8;
      if (lr < len && (c > 0 || b == 0)) { u32x4 o; for (int j = 0; j < 4; ++j) o[j] = pack2(hv[2 * j] * r * ng[2 * j], hv[2 * j + 1] * r * ng[2 * j + 1]);
        *(u32x4*)(rest + (size_t)(row0 + lr) * NREST + RC_CC + h * 64 + c8) = o; } }
  }
}

constexpr int MREC = 4160;
DEVI void mlstm_gates(PRef p, int l, int h, int row0, int len, int lane, const float* gp, float& a, float& bc) {
  const float gbi = p.in[I_GATEB][l * 8 + h], gbf = p.in[I_GATEB][l * 8 + 4 + h];
  float ig = -INFINITY, lf = 0.f;
  if (lane < len) { const float* g8 = gp + (size_t)(row0 + lane) * 8; ig = g8[h] + gbi; float x = g8[4 + h] + gbf; lf = fminf(x, 0.f) - __logf(1.f + __expf(-fabsf(x))); }
  bc = lf; for (int o = 1; o < 64; o <<= 1) { float t = __shfl_up(bc, o); if (lane >= o) bc += t; }
  a = ig - bc;
}
DEVI void mlstm_stepA(PRef p, int l, int b, int h, int c, unsigned char* lds) { const int TX = opaque_tid(); unsigned char* const wsb = opq(p.ws);
  u16* KTs = (u16*)lds; u16* VTs = KTs + 64 * MP; float* swr = (float*)(VTs + 80 * MP);
  const u16* rest = (const u16*)(wsb + WS_REST); const float* gp = (const float*)(wsb + WS_GP);
  u16* rec = (u16*)(wsb + WS_MSUM) + (size_t)((b * 4 + h) * NCH + c) * MREC; float* msc = (float*)(wsb + WS_MSC) + (size_t)((b * 4 + h) * NCH + c) * 4;
  const int tid = TX, wave = tid >> 6, lane = tid & 63, fr = lane & 15, fq = lane >> 4, mt = wave >> 1, nh = wave & 1;
  int row0, len; chunk_rows(b, c, row0, len);
  const int lr = tid >> 3, c8 = (tid & 7) * 8;
  __syncthreads();
  for (int i = tid; i < 16 * MP; i += 512) VTs[64 * MP + i] = (i < MP) ? (u16)0x3F80 : (u16)0;
  { u32x4 k = {0, 0, 0, 0}, v = k;
    if (lr < len) { const u16* rp = rest + (size_t)(row0 + lr) * NREST + h * 64 + c8; k = *(const u32x4*)(rp + RC_MK); v = *(const u32x4*)(rp + RC_MV); }
    for (int j = 0; j < 4; ++j) { const unsigned kk = pack2(blo(k[j]) * 0.125f, bhi(k[j]) * 0.125f);
      KTs[(c8 + 2 * j) * MP + lr] = (u16)(kk & 0xffff); KTs[(c8 + 2 * j + 1) * MP + lr] = (u16)(kk >> 16);
      VTs[(c8 + 2 * j) * MP + lr] = (u16)(v[j] & 0xffff); VTs[(c8 + 2 * j + 1) * MP + lr] = (u16)(v[j] >> 16); } }
  if (wave == 0) { float a, bc; mlstm_gates(p, l, h, row0, len, lane, gp, a, bc);
    float mx = a; for (int o = 32; o > 0; o >>= 1) mx = fmaxf(mx, __shfl_xor(mx, o));
    swr[lane] = expf(a - mx);
    if (lane == 0) msc[1] = mx;
    if (lane == 63) msc[0] = bc; }
  __syncthreads();
  const int tm[3] = {mt, mt, 4}, tn[3] = {nh * 2, nh * 2 + 1, wave}; const int tc = wave < 4 ? 3 : 2;
  for (int i = 0; i < 3; ++i) if (i < tc) { f32x4 acc = {0.f, 0.f, 0.f, 0.f};
    for (int ks = 0; ks < 2; ++ks) { bf16x8 va = *(const bf16x8*)(VTs + (tm[i] * 16 + fr) * MP + 32 * ks + 8 * fq);
      for (int j = 0; j < 8; ++j) va[j] = (short)f2b(b2f((u16)va[j]) * swr[32 * ks + 8 * fq + j]);
      bf16x8 kb = *(const bf16x8*)(KTs + (tn[i] * 16 + fr) * MP + 32 * ks + 8 * fq);
      acc = __builtin_amdgcn_mfma_f32_16x16x32_bf16(va, kb, acc, 0, 0, 0); }
    for (int j = 0; j < 4; ++j) { const int v = tm[i] * 16 + 4 * fq + j; if (v <= 64) rec[v * 64 + tn[i] * 16 + fr] = f2b(acc[j]); } }
}
DEVI void mlstm_scan(PRef p) { const int TX = opaque_tid(); unsigned char* const wsb = opq(p.ws);
  if (TX >= 64) return;
  const int lane = TX;
  for (int it = blockIdx.x; it < 256; it += gridDim.x) {
    const int bh = it >> 3, vs = it & 7;
    u16* base = (u16*)(wsb + WS_MSUM) + (size_t)bh * NCH * MREC; float* msc = (float*)(wsb + WS_MSC) + (size_t)bh * NCH * 4;
    const bool hasn = (vs == 0) && lane < 8;
    float st[8], sn[8]; for (int j = 0; j < 8; ++j) { st[j] = 0.f; sn[j] = 0.f; }
    float m_prev = 0.f;
    for (int c0 = 0; c0 < NCH; c0 += 5) {
      u32x4 d[5], dn[5]; float bl[5], ml[5];
      for (int i = 0; i < 5; ++i) { u16* r = base + (size_t)(c0 + i) * MREC; d[i] = *(const u32x4*)(r + vs * 512 + lane * 8);
        dn[i] = hasn ? *(const u32x4*)(r + 4096 + lane * 8) : (u32x4){0, 0, 0, 0}; bl[i] = msc[(c0 + i) * 4]; ml[i] = msc[(c0 + i) * 4 + 1]; }
      for (int i = 0; i < 5; ++i) { u16* r = base + (size_t)(c0 + i) * MREC;
        u32x4 o; for (int j = 0; j < 4; ++j) o[j] = pack2(st[2 * j], st[2 * j + 1]); *(u32x4*)(r + vs * 512 + lane * 8) = o;
        if (hasn) { u32x4 on; for (int j = 0; j < 4; ++j) on[j] = pack2(sn[2 * j], sn[2 * j + 1]); *(u32x4*)(r + 4096 + lane * 8) = on; }
        if (vs == 0 && lane == 0) msc[(c0 + i) * 4 + 2] = m_prev;
        const float Mx = fmaxf(m_prev, ml[i]), f1 = expf(m_prev - Mx), f2 = expf(ml[i] - Mx);
        for (int j = 0; j < 4; ++j) { st[2 * j] = f1 * st[2 * j] + f2 * blo(d[i][j]); st[2 * j + 1] = f1 * st[2 * j + 1] + f2 * bhi(d[i][j]);
          sn[2 * j] = f1 * sn[2 * j] + f2 * blo(dn[i][j]); sn[2 * j + 1] = f1 * sn[2 * j + 1] + f2 * bhi(dn[i][j]); }
        m_prev = bl[i] + Mx; }
    }
  }
}
DEVI void mlstm_stepC(PRef p, int l, int b, int h, int c, unsigned char* lds) { const int TX = opaque_tid(); unsigned char* const wsb = opq(p.ws);
  u16* Qs = (u16*)lds; u16* Ks = Qs + 64 * MP; u16* VTs = Ks + 64 * MP; u16* Cs = VTs + 80 * MP; u16* Ps = Cs + 80 * MP; u16* Os = Ps + 64 * MP;
  float* Hs = (float*)(Os + 64 * MP);
  float* sa = Hs + 64 * 65; float* sM = sa + 64; float* swi = sM + 64; float* sem = swi + 64; float* sden = sem + 64;
  u16* rest = (u16*)(wsb + WS_REST); const float* gp = (const float*)(wsb + WS_GP);
  const u16* rec = (const u16*)(wsb + WS_MSUM) + (size_t)((b * 4 + h) * NCH + c) * MREC; const float* msc = (const float*)(wsb + WS_MSC) + (size_t)((b * 4 + h) * NCH + c) * 4;
  const int tid = TX, wave = tid >> 6, lane = tid & 63, fr = lane & 15, fq = lane >> 4;
  const int mt = wave >> 1, nh = wave & 1;
  int row0, len; chunk_rows(b, c, row0, len);
  const int lr = tid >> 3, c8 = (tid & 7) * 8;
  __syncthreads();
  for (int i = tid; i < 16 * MP; i += 512) { VTs[64 * MP + i] = (i < MP) ? (u16)0x3F80 : (u16)0; if (i >= MP) Cs[64 * MP + i] = 0; }
  { u32x4 q = {0, 0, 0, 0}, k = q, v = q, o = q;
    if (lr < len) { const u16* rp = rest + (size_t)(row0 + lr) * NREST + h * 64 + c8;
      q = *(const u32x4*)(rp + RC_MQ); k = *(const u32x4*)(rp + RC_MK); v = *(const u32x4*)(rp + RC_MV); o = *(const u32x4*)(rp + RC_MO); }
    const u32x4 cin = *(const u32x4*)(rec + lr * 64 + c8);
    for (int j = 0; j < 4; ++j) k[j] = pack2(blo(k[j]) * 0.125f, bhi(k[j]) * 0.125f);
    *(u32x4*)(Qs + lr * MP + c8) = q; *(u32x4*)(Ks + lr * MP + c8) = k; *(u32x4*)(Os + lr * MP + c8) = o; *(u32x4*)(Cs + lr * MP + c8) = cin;
    if (tid < 8) *(u32x4*)(Cs + 64 * MP + tid * 8) = *(const u32x4*)(rec + 4096 + tid * 8);
    for (int j = 0; j < 4; ++j) { VTs[(c8 + 2 * j) * MP + lr] = (u16)(v[j] & 0xffff); VTs[(c8 + 2 * j + 1) * MP + lr] = (u16)(v[j] >> 16); } }
  if (wave == 0) { float a, bc; mlstm_gates(p, l, h, row0, len, lane, gp, a, bc);
    const float m_prev = msc[2];
    float pm = a; for (int o = 1; o < 64; o <<= 1) { float t = __shfl_up(pm, o); if (lane >= o) pm = fmaxf(pm, t); }
    const float M = fmaxf(m_prev, pm);
    sa[lane] = a; sM[lane] = M; swi[lane] = expf(m_prev - M); sem[lane] = expf(-(bc + M)); }
  __syncthreads();
  for (int ni = 0; ni < 2; ++ni) { const int nt = nh * 2 + ni; f32x4 s = {0.f, 0.f, 0.f, 0.f};
    for (int ks = 0; ks < 2; ++ks) { bf16x8 a = *(const bf16x8*)(Qs + (mt * 16 + fr) * MP + 32 * ks + 8 * fq); bf16x8 bb = *(const bf16x8*)(Ks + (nt * 16 + fr) * MP + 32 * ks + 8 * fq);
      s = __builtin_amdgcn_mfma_f32_16x16x32_bf16(a, bb, s, 0, 0, 0); }
    const int r = nt * 16 + fr; const float ar = sa[r];
    for (int j = 0; j < 4; ++j) { const int srow = mt * 16 + 4 * fq + j; float w = (r <= srow) ? expf(ar - sM[srow]) : 0.f; Ps[srow * MP + r] = f2b(s[j] * w); } }
  __syncthreads();
  f32x4 a1[3], a2[3]; const int ntl[3] = {nh * 2, nh * 2 + 1, 4}; const int ncnt = nh == 0 ? 3 : 2;
  for (int i = 0; i < 3; ++i) { a1[i] = (f32x4){0.f, 0.f, 0.f, 0.f}; a2[i] = a1[i]; }
  for (int ks = 0; ks < 2; ++ks) { bf16x8 pa = *(const bf16x8*)(Ps + (mt * 16 + fr) * MP + 32 * ks + 8 * fq); bf16x8 qa = *(const bf16x8*)(Qs + (mt * 16 + fr) * MP + 32 * ks + 8 * fq);
    for (int i = 0; i < 3; ++i) if (i < ncnt) { bf16x8 vb = *(const bf16x8*)(VTs + (ntl[i] * 16 + fr) * MP + 32 * ks + 8 * fq); bf16x8 cb = *(const bf16x8*)(Cs + (ntl[i] * 16 + fr) * MP + 32 * ks + 8 * fq);
      a1[i] = __builtin_amdgcn_mfma_f32_16x16x32_bf16(pa, vb, a1[i], 0, 0, 0); a2[i] = __builtin_amdgcn_mfma_f32_16x16x32_bf16(qa, cb, a2[i], 0, 0, 0); } }
  if (nh == 0 && fr == 0) for (int j = 0; j < 4; ++j) { const int srow = mt * 16 + 4 * fq + j; sden[srow] = a1[2][j] + swi[srow] * a2[2][j]; }
  __syncthreads();
  for (int i = 0; i < 2; ++i) for (int j = 0; j < 4; ++j) { const int srow = mt * 16 + 4 * fq + j, v = ntl[i] * 16 + fr;
    float num = a1[i][j] + swi[srow] * a2[i][j]; float hv = num / fmaxf(fabsf(sden[srow]), sem[srow]);
    hv *= sigm(b2f(Os[srow * MP + v])); Hs[srow * 65 + v] = hv; }
  __syncthreads();
  { float hv[8]; float ss = 0.f; for (int j = 0; j < 8; ++j) { hv[j] = Hs[lr * 65 + c8 + j]; ss += hv[j] * hv[j]; }
    ss += __shfl_xor(ss, 1); ss += __shfl_xor(ss, 2); ss += __shfl_xor(ss, 4);
    const float r = rsqrtf(ss * (1.f / 64.f) + EPS); const float* ng = p.in[I_MNORM] + l * 256 + h * 64 + c8;
    if (lr < len) { u32x4 o; for (int j = 0; j < 4; ++j) o[j] = pack2(hv[2 * j] * r * ng[2 * j], hv[2 * j + 1] * r * ng[2 * j + 1]);
      *(u32x4*)(rest + (size_t)(row0 + lr) * NREST + RC_CC + h * 64 + c8) = o; } }
}

constexpr int KP = 104, VP = 72;
DEVI void attn_item(PRef p, int b, int hh, int qb, bool meta, unsigned char* lds) { const int TX = opaque_tid(); unsigned char* const wsb = opq(p.ws);
  u16* Kl = (u16*)lds;
  u16* Vl = Kl + 2 * 64 * KP;
  const u16* Q = (const u16*)(wsb + WS_Q); const u16* KN = (const u16*)(wsb + WS_KN); const u16* KR = (const u16*)(wsb + WS_KR); const u16* VT = (const u16*)(wsb + WS_VT);
  u16* rest = (u16*)(wsb + WS_REST);
  const int tid = TX, wave = tid >> 6, lane = tid & 63, r31 = lane & 31, h2 = lane >> 5;
  const int ntile = meta ? 1 : 4 * qb + 5;
  const int mychunk = meta ? (wave == 0 ? 0 : -1) : 4 * qb + 1 + (wave >> 1);
  const int qrow = meta ? METAROW + r31 : b * SEQ + qb * 256 + wave * 32 + r31;
  bf16x8 qf[6];
  for (int ks = 0; ks < 6; ++ks) qf[ks] = *(const bf16x8*)(Q + (size_t)qrow * 768 + hh * 96 + 16 * ks + 8 * h2);
  f32x16 o0, o1; for (int i = 0; i < 16; ++i) { o0[i] = 0.f; o1[i] = 0.f; }
  float mrun = 0.f, lsum = 0.f;
  f32x16 cinit; for (int i = 0; i < 16; ++i) cinit[i] = 0.f;
  u32x4 kreg0, kreg1, vreg;
  auto gload = [&](int j) {
    const int krow0 = j == 0 ? METAROW : b * SEQ + (j - 1) * 64;
    { int i = tid; int r = i / 12, c = i % 12; kreg0 = c < 8 ? *(const u32x4*)(KN + (size_t)(krow0 + r) * 512 + hh * 64 + c * 8) : *(const u32x4*)(KR + (size_t)(krow0 + r) * 32 + (c - 8) * 8); }
    if (tid < 256) { int i = tid + 512; int r = i / 12, c = i % 12; kreg1 = c < 8 ? *(const u32x4*)(KN + (size_t)(krow0 + r) * 512 + hh * 64 + c * 8) : *(const u32x4*)(KR + (size_t)(krow0 + r) * 32 + (c - 8) * 8); }
    { int v = tid >> 3, c = tid & 7; vreg = *(const u32x4*)(VT + (size_t)(hh * 64 + v) * MROWS + krow0 + c * 8); }
  };
  auto lstore = [&](int buf) {
    u16* kl = Kl + buf * 64 * KP; u16* vl = Vl + buf * 64 * VP;
    { int i = tid; int r = i / 12, c = i % 12; *(u32x4*)(kl + r * KP + c * 8) = kreg0; }
    if (tid < 256) { int i = tid + 512; int r = i / 12, c = i % 12; *(u32x4*)(kl + r * KP + c * 8) = kreg1; }
    { int v = tid >> 3, c = tid & 7; *(u32x4*)(vl + v * VP + c * 8) = vreg; }
  };
  __syncthreads();
  gload(0); lstore(0);
  for (int j = 0; j < ntile; ++j) {
    __syncthreads();
    if (j + 1 < ntile) gload(j + 1);
    if (j <= mychunk) {
      const u16* kl = Kl + (j & 1) * 64 * KP; const u16* vl = Vl + (j & 1) * 64 * VP;
      f32x16 s0, s1;
#pragma unroll
      for (int ks = 0; ks < 6; ++ks) {
        bf16x8 k0 = *(const bf16x8*)(kl + r31 * KP + 16 * ks + 8 * h2); bf16x8 k1 = *(const bf16x8*)(kl + (32 + r31) * KP + 16 * ks + 8 * h2);
        s0 = __builtin_amdgcn_mfma_f32_32x32x16_bf16(k0, qf[ks], ks == 0 ? cinit : s0, 0, 0, 0); s1 = __builtin_amdgcn_mfma_f32_32x32x16_bf16(k1, qf[ks], ks == 0 ? cinit : s1, 0, 0, 0);
      }
      if (j == 0) { for (int i = 8; i < 16; ++i) s0[i] = -INFINITY; for (int i = 0; i < 16; ++i) s1[i] = -INFINITY; }
      float mx = s0[0]; for (int i = 1; i < 16; ++i) mx = fmaxf(mx, s0[i]); for (int i = 0; i < 16; ++i) mx = fmaxf(mx, s1[i]);
      mx = fmaxf(mx, __shfl_xor(mx, 32));
      const float d = (j == 0) ? mx : fmaxf(mx, 0.f);
      float ps = 0.f;
      if (j == 0 || __any(d > 8.f)) {
        const float alpha = (j == 0) ? 1.f : __builtin_amdgcn_exp2f(-d);
        for (int i = 0; i < 16; ++i) { s0[i] = __builtin_amdgcn_exp2f(s0[i] - d); ps += s0[i]; s1[i] = __builtin_amdgcn_exp2f(s1[i] - d); ps += s1[i]; }
        lsum = lsum * alpha + ps;
        for (int i = 0; i < 16; ++i) { o0[i] *= alpha; o1[i] *= alpha; }
        mrun = (j == 0) ? d : mrun + d;
        for (int i = 0; i < 16; ++i) cinit[i] = -mrun;
      } else {
        for (int i = 0; i < 16; ++i) { s0[i] = __builtin_amdgcn_exp2f(s0[i]); ps += s0[i]; s1[i] = __builtin_amdgcn_exp2f(s1[i]); ps += s1[i]; }
        lsum += ps;
      }
      for (int kt = 0; kt < 2; ++kt) for (int s = 0; s < 2; ++s) {
        u32x4 pp; for (int jj = 0; jj < 4; ++jj) pp[jj] = kt == 0 ? cvtpk_v(s0[8 * s + 2 * jj], s0[8 * s + 2 * jj + 1]) : cvtpk_v(s1[8 * s + 2 * jj], s1[8 * s + 2 * jj + 1]);
        bf16x8 pb = __builtin_bit_cast(bf16x8, pp);
        const int key0 = 32 * kt + 16 * s + 8 * h2;
        const bf16x8 va = *(const bf16x8*)(vl + r31 * VP + key0), vc = *(const bf16x8*)(vl + (32 + r31) * VP + key0);
        o0 = __builtin_amdgcn_mfma_f32_32x32x16_bf16(va, pb, o0, 0, 0, 0);
        o1 = __builtin_amdgcn_mfma_f32_32x32x16_bf16(vc, pb, o1, 0, 0, 0);
      }
    }
    if (j + 1 < ntile) lstore((j + 1) & 1);
  }
  if (mychunk >= 0) {
    lsum += __shfl_xor(lsum, 32);
    const float inv = __builtin_amdgcn_rcpf(lsum);
    u16* orow = rest + (size_t)qrow * NREST + RC_CQ + hh * 64;
    for (int g = 0; g < 4; ++g) { const int v0 = 8 * g + 4 * h2;
      u32x2 w0; w0[0] = cvtpk_v(o0[4 * g] * inv, o0[4 * g + 1] * inv); w0[1] = cvtpk_v(o0[4 * g + 2] * inv, o0[4 * g + 3] * inv); *(u32x2*)(orow + v0) = w0;
      u32x2 w1; w1[0] = cvtpk_v(o1[4 * g] * inv, o1[4 * g + 1] * inv); w1[1] = cvtpk_v(o1[4 * g + 2] * inv, o1[4 * g + 3] * inv); *(u32x2*)(orow + 32 + v0) = w1; }
  }
}

template <class Epi>
DEVI void thin_gemm(unsigned char* lds, const Gemm g, int nN, const Epi& E, int wg0 = 0) { const int TX = opaque_tid();
  const int wid = __builtin_amdgcn_readfirstlane(TX >> 6), lane = TX & 63, fr = lane & 15, fq = lane >> 4;
  int K = g.K; asm volatile("" : "+s"(K));
  f32x4* P = (f32x4*)lds;
  for (int un = (int)((blockIdx.x + gridDim.x - wg0) % gridDim.x); un < nN * 4; un += gridDim.x) {
    const int pn = un >> 2, wc = un & 3;
    f32x4 pacc[4];
#pragma unroll
    for (int t = 0; t < 4; ++t) pacc[t] = (f32x4){0.f, 0.f, 0.f, 0.f};
    const u16* ap = g.A + (size_t)(METAROW + fr) * g.lda + fq * 8;
    const u16* bp = g.Bt + (size_t)(pn * 256 + wc * 32) * g.ldb + fq * 8;
    const unsigned o0 = (unsigned)(perm32(fr) * g.ldb), o1 = (unsigned)(perm32(16 + fr) * g.ldb);
#pragma unroll 4
    for (int k = wid * 32; k < K; k += 256) {
      const bf16x8 a = *(const bf16x8*)(ap + k);
      bf16x8 bv[4];
#pragma unroll
      for (int t = 0; t < 4; ++t) { const int bj = t >> 1, n = t & 1; bv[t] = *(const bf16x8*)(bp + (size_t)(bj * 128) * g.ldb + (n ? o1 : o0) + k); }
#pragma unroll
      for (int t = 0; t < 4; ++t) pacc[t] = __builtin_amdgcn_mfma_f32_16x16x32_bf16(bv[t], a, pacc[t], 0, 0, 0);
    }
    __syncthreads();
#pragma unroll
    for (int t = 0; t < 4; ++t) P[(wid * 4 + t) * 64 + lane] = pacc[t];
    __syncthreads();
    if (wid == 0) {
      f32x4 acc[2][2][4][2];
#pragma unroll
      for (int bj = 0; bj < 2; ++bj)
#pragma unroll
        for (int n = 0; n < 2; ++n) { f32x4 sum = {0.f, 0.f, 0.f, 0.f};
#pragma unroll
          for (int w = 0; w < 8; ++w) sum += P[(w * 4 + bj * 2 + n) * 64 + lane];
          acc[0][bj][0][n] = sum; }
      Unit u; u.pm = 128; u.pn = pn;
      E.template run<true>(acc, u, 0, wc, fr, fq);
    }
    __syncthreads();
  }
}
#define LDS3 ((LAS unsigned char*)lds)
constexpr size_t WS_SSQ = WS_GP + (size_t)MROWS * 8 * 4;
struct EpiIn {
  const float* rs; u8* gates; u16* rest; float* gp; float* ssq;
  DEVI void operator()(AccRef acc, const Unit& u, int wr, int wc, int fr, int fq) const { run<false>(acc, u, wr, wc, fr, fq); }
  template <bool THIN> DEVI void run(AccRef acc, const Unit& u, int wr, int wc, int fr, int fq) const {
    const int pn = u.pn;
    float rsv[2][4];
    EPI_ROWS({ rsv[ai][m] = rs[row]; })
    EPI_ROWS({ const float r = rsv[ai][m];
      _Pragma("unroll") for (int bj = 0; bj < 2; ++bj) { const int col0 = pn * 256 + bj * 128 + wc * 32 + 8 * fq;
        float x[8]; _Pragma("unroll") for (int e = 0; e < 4; ++e) { x[e] = acc[ai][bj][m][0][e] * r; x[4 + e] = acc[ai][bj][m][1][e] * r; }
        if (pn < 16) { unsigned b[8]; _Pragma("unroll") for (int e = 0; e < 8; ++e) b[e] = (unsigned)(sigm(x[e]) * 255.f + 0.5f);
          u32x2 o; o[0] = b[0] | (b[1] << 8) | (b[2] << 16) | (b[3] << 24); o[1] = b[4] | (b[5] << 8) | (b[6] << 16) | (b[7] << 24);
          *(u32x2*)(gates + (size_t)row * 4096 + col0) = o; }
        else { const int rc = col0 - 4096; u32x4 o; _Pragma("unroll") for (int e = 0; e < 4; ++e) o[e] = cvtpk_e(x[2 * e], x[2 * e + 1]);
          *(u32x4*)(rest + (size_t)row * NREST + rc) = o;
          if (rc == RC_MI) { *(f32x4*)(gp + (size_t)row * 8) = (f32x4){x[0], x[1], x[2], x[3]}; *(f32x4*)(gp + (size_t)row * 8 + 4) = (f32x4){x[4], x[5], x[6], x[7]}; }
          const int slot = pn == 24 ? bj : (pn == 25 ? (bj == 0 ? 2 : 3) : (pn == 26 && bj == 0 ? 4 : -1));
          if (slot >= 0) { float ss = 0.f; _Pragma("unroll") for (int e = 0; e < 8; ++e) ss += x[e] * x[e];
            ss += __shfl_xor(ss, 16); ss += __shfl_xor(ss, 32);
            if (fq == 0) ssq[(size_t)row * 20 + slot * 4 + wc] = ss; } } } })
  }
};
struct EpiQ {
  const float* ssq; const float* rope; u16* Q;
  DEVI void operator()(AccRef acc, const Unit& u, int wr, int wc, int fr, int fq) const { run<false>(acc, u, wr, wc, fr, fq); }
  template <bool THIN> DEVI void run(AccRef acc, const Unit& u, int wr, int wc, int fr, int fq) const {
    const float QS = 0.10206207261596577f * 1.4426950408889634f;
    constexpr int NA = THIN ? 1 : 2, NMM = THIN ? 1 : 4;
#pragma unroll
    for (int ai = 0; ai < NA; ++ai) {
      float ssv[NMM];
#pragma unroll
      for (int m = 0; m < NMM; ++m) { const int row = u.pm * 256 + ai * 128 + wr * 64 + m * 16 + fr; const float* sp = ssq + (size_t)row * 20;
        const f32x4 s0 = *(const f32x4*)sp, s1 = *(const f32x4*)(sp + 4), s2 = *(const f32x4*)(sp + 8);
        ssv[m] = (s0[0] + s0[1] + s0[2] + s0[3]) + (s1[0] + s1[1] + s1[2] + s1[3]) + (s2[0] + s2[1] + s2[2] + s2[3]); }
#pragma unroll
      for (int m = 0; m < NMM; ++m) { const int row = u.pm * 256 + ai * 128 + wr * 64 + m * 16 + fr;
        const float sc = rsqrtf(ssv[m] * (1.f / 384.f) + EPS) * QS; const int pos = row_pos(row);
#pragma unroll
        for (int bj = 0; bj < 2; ++bj) { const int cb = u.pn * 256 + bj * 128 + wc * 32, col0 = cb + 8 * fq;
          float x[8];
#pragma unroll
          for (int e = 0; e < 4; ++e) { x[e] = acc[ai][bj][m][0][e] * sc; x[4 + e] = acc[ai][bj][m][1][e] * sc; }
          if ((cb % 96) == 64) {
#pragma unroll
            for (int e = 0; e < 8; ++e) { const float other = __shfl_xor(x[e], 32); const int i = 8 * (fq & 1) + e;
              const float c = rope[(pos * 16 + i) * 2], s = rope[(pos * 16 + i) * 2 + 1];
              x[e] = fq < 2 ? x[e] * c - other * s : x[e] * c + other * s; } }
          u32x4 o;
#pragma unroll
          for (int e = 0; e < 4; ++e) o[e] = cvtpk_e(x[2 * e], x[2 * e + 1]);
          *(u32x4*)(Q + (size_t)row * 768 + col0) = o; }
        __builtin_amdgcn_sched_barrier(0); }
    }
  }
};
struct EpiKV {
  const float* ssq; u16* KN; u16* VT;
  DEVI void operator()(AccRef acc, const Unit& u, int wr, int wc, int fr, int fq) const { run<false>(acc, u, wr, wc, fr, fq); }
  template <bool THIN> DEVI void run(AccRef acc, const Unit& u, int wr, int wc, int fr, int fq) const {
    constexpr int NA = THIN ? 1 : 2, NMM = THIN ? 1 : 4;
#pragma unroll
    for (int ai = 0; ai < NA; ++ai) {
      float ssv[NMM];
#pragma unroll
      for (int m = 0; m < NMM; ++m) { const int row = u.pm * 256 + ai * 128 + wr * 64 + m * 16 + fr; const float* sp = ssq + (size_t)row * 20 + 12;
        const f32x4 s0 = *(const f32x4*)sp, s1 = *(const f32x4*)(sp + 4);
        ssv[m] = (s0[0] + s0[1] + s0[2] + s0[3]) + (s1[0] + s1[1] + s1[2] + s1[3]); }
#pragma unroll
      for (int m = 0; m < NMM; ++m) { const int row = u.pm * 256 + ai * 128 + wr * 64 + m * 16 + fr;
        const float sc = rsqrtf(ssv[m] * (1.f / 256.f) + EPS);
#pragma unroll
        for (int bj = 0; bj < 2; ++bj) { const int col0 = u.pn * 256 + bj * 128 + wc * 32 + 8 * fq, hd = col0 >> 7, d0 = col0 & 127;
          float x[8];
#pragma unroll
          for (int e = 0; e < 4; ++e) { x[e] = acc[ai][bj][m][0][e] * sc; x[4 + e] = acc[ai][bj][m][1][e] * sc; }
          if (d0 < 64) { u32x4 o;
#pragma unroll
            for (int e = 0; e < 4; ++e) o[e] = cvtpk_e(x[2 * e], x[2 * e + 1]);
            *(u32x4*)(KN + (size_t)row * 512 + hd * 64 + d0) = o; }
          else {
#pragma unroll
            for (int e = 0; e < 8; ++e) VT[(size_t)(hd * 64 + d0 - 64 + e) * MROWS + ((row & ~12) | ((row & 4) << 1) | ((row & 8) >> 1))] = (u16)cvtpk_e(x[e], x[e]); } }
        __builtin_amdgcn_sched_barrier(0); }
    }
  }
};
struct EpiGlu {
  u16* rest;
  DEVI void operator()(AccRef acc, const Unit& u, int wr, int wc, int fr, int fq) const { run<false>(acc, u, wr, wc, fr, fq); }
  template <bool THIN> DEVI void run(AccRef acc, const Unit& u, int wr, int wc, int fr, int fq) const {
    EPI_ROWS({ float x[8]; _Pragma("unroll") for (int e = 0; e < 4; ++e) { x[e] = acc[ai][0][m][0][e] * sigm(acc[ai][1][m][0][e]); x[4 + e] = acc[ai][0][m][1][e] * sigm(acc[ai][1][m][1][e]); }
      u32x4 o; _Pragma("unroll") for (int e = 0; e < 4; ++e) o[e] = cvtpk_e(x[2 * e], x[2 * e + 1]);
      *(u32x4*)(rest + (size_t)row * NREST + RC_SU + u.pn * 128 + wc * 32 + 8 * fq) = o; })
  }
};
struct EpiMerge {
  const u8* gates; u16* mg; int bi;
  DEVI void operator()(AccRef acc, const Unit& u, int wr, int wc, int fr, int fq) const { run<false>(acc, u, wr, wc, fr, fq); }
  template <bool THIN> DEVI void run(AccRef acc, const Unit& u, int wr, int wc, int fr, int fq) const {
    constexpr int NA = THIN ? 1 : 2, NMM = THIN ? 1 : 4;
    u32x2 gb[NA][NMM][2];
#pragma unroll
    for (int ai = 0; ai < NA; ++ai)
#pragma unroll
      for (int m = 0; m < NMM; ++m)
#pragma unroll
        for (int bj = 0; bj < 2; ++bj) { const int row = u.pm * 256 + ai * 128 + wr * 64 + m * 16 + fr, col0 = u.pn * 256 + bj * 128 + wc * 32 + 8 * fq;
          gb[ai][m][bj] = *(const u32x2*)(gates + (size_t)row * 4096 + bi * 1024 + col0); }
#pragma unroll
    for (int ai = 0; ai < NA; ++ai) {
      u32x4 old[NMM][2];
#pragma unroll
      for (int m = 0; m < NMM; ++m)
#pragma unroll
        for (int bj = 0; bj < 2; ++bj) { const int row = u.pm * 256 + ai * 128 + wr * 64 + m * 16 + fr, col0 = u.pn * 256 + bj * 128 + wc * 32 + 8 * fq;
          old[m][bj] = bi ? *(const u32x4*)(mg + (size_t)row * 1024 + col0) : (u32x4){0, 0, 0, 0}; }
#pragma unroll
      for (int m = 0; m < NMM; ++m)
#pragma unroll
        for (int bj = 0; bj < 2; ++bj) { const int row = u.pm * 256 + ai * 128 + wr * 64 + m * 16 + fr, col0 = u.pn * 256 + bj * 128 + wc * 32 + 8 * fq;
          float x[8];
#pragma unroll
          for (int e = 0; e < 8; ++e) { const float g = (float)((gb[ai][m][bj][e >> 2] >> (8 * (e & 3))) & 255u) * (1.f / 255.f); x[e] = g * (e < 4 ? acc[ai][bj][m][0][e] : acc[ai][bj][m][1][e - 4]); }
#pragma unroll
          for (int e = 0; e < 4; ++e) { x[2 * e] += blo(old[m][bj][e]); x[2 * e + 1] += bhi(old[m][bj][e]); }
          u32x4 o;
#pragma unroll
          for (int e = 0; e < 4; ++e) o[e] = cvtpk_e(x[2 * e], x[2 * e + 1]);
          *(u32x4*)(mg + (size_t)row * 1024 + col0) = o; }
    }
  }
};
template <int MODE> struct EpiPlain {
  const float* rs; u16* out; int ldo;
  DEVI void operator()(AccRef acc, const Unit& u, int wr, int wc, int fr, int fq) const { run<false>(acc, u, wr, wc, fr, fq); }
  template <bool THIN> DEVI void run(AccRef acc, const Unit& u, int wr, int wc, int fr, int fq) const {
    float rsv[2][4];
    EPI_ROWS({ rsv[ai][m] = MODE == 1 ? rs[row] : 1.f; })
    EPI_ROWS({ const float r = rsv[ai][m];
      _Pragma("unroll") for (int bj = 0; bj < 2; ++bj) { const int col0 = u.pn * 256 + bj * 128 + wc * 32 + 8 * fq;
        float x[8]; _Pragma("unroll") for (int e = 0; e < 4; ++e) { x[e] = acc[ai][bj][m][0][e]; x[4 + e] = acc[ai][bj][m][1][e]; }
        if (MODE == 1) { _Pragma("unroll") for (int e = 0; e < 8; ++e) { float t = fmaxf(x[e] * r, 0.f); x[e] = t * t; } }
        u32x4 o; _Pragma("unroll") for (int e = 0; e < 4; ++e) o[e] = cvtpk_e(x[2 * e], x[2 * e + 1]);
        *(u32x4*)(out + (size_t)row * ldo + col0) = o; } })
  }
};
DEVI void phase_inproj(PRef p, unsigned char* lds) { unsigned char* const wsb = opq(p.ws);
  Gemm g{(const u16*)(wsb + WS_HB), (const u16*)(wsb + WS_W + W_IN), 1024, 1024, 1024};
  StaticOrder S; S.init(129, NIN / 256, gridDim.x, blockIdx.x);
  EpiIn E{(const float*)(wsb + WS_RS), wsb + WS_GATES, (u16*)(wsb + WS_REST), (float*)(wsb + WS_GP), (float*)(wsb + WS_SSQ)};
  gemm_phase(LDS3, g, S, E);
}
DEVI void phase_upq(PRef p, unsigned char* lds) { unsigned char* const wsb = opq(p.ws);
  Gemm g{(const u16*)(wsb + WS_REST) + RC_CQ, (const u16*)(wsb + WS_W + W_UQ), NREST, 384, 384};
  StaticOrder S; S.init(129, 3, gridDim.x, blockIdx.x);
  EpiQ E{(const float*)(wsb + WS_SSQ), (const float*)(wsb + WS_ROPE), (u16*)(wsb + WS_Q)};
  gemm_phase(LDS3, g, S, E);
}
DEVI void phase_upkv(PRef p, unsigned char* lds) { unsigned char* const wsb = opq(p.ws);
  Gemm g{(const u16*)(wsb + WS_REST) + RC_CKV, (const u16*)(wsb + WS_W + W_UKV), NREST, 256, 256};
  StaticOrder S; S.init(128, 4, gridDim.x, blockIdx.x);
  EpiKV E{(const float*)(wsb + WS_SSQ), (u16*)(wsb + WS_KN), (u16*)(wsb + WS_VT)};
  thin_gemm(lds, g, S.nN, E);
  gemm_phase(LDS3, g, S, E);
}
DEVI void phase_glu(PRef p, unsigned char* lds, bool meta) { unsigned char* const wsb = opq(p.ws);
  Gemm g{(const u16*)(wsb + WS_REST) + RC_CV, (const u16*)(wsb + WS_W + W_GLU), NREST, 256, 256};
  StaticOrder S; S.init(128, 2, gridDim.x, blockIdx.x);
  EpiGlu E{(u16*)(wsb + WS_REST)};
  if (meta) thin_gemm(lds, g, S.nN, E);
  gemm_phase(LDS3, g, S, E);
}
DEVI void phase_merge(PRef p, unsigned char* lds, bool meta) { unsigned char* const wsb = opq(p.ws);
  const u16* rest = (const u16*)(wsb + WS_REST); const u16* Bt = (const u16*)(wsb + WS_W + W_BR);
  const int aoff[4] = {RC_CB, RC_CC, RC_SU, RC_CQ}; const int koff[4] = {0, 256, 512, 768}; const int kk[4] = {256, 256, 256, 512};
  StaticOrder S; S.init(128, 4, gridDim.x, blockIdx.x);
  for (int bi = 0; bi < 4; ++bi) {
    Gemm g{rest + aoff[bi], Bt + koff[bi], NREST, 1280, kk[bi]};
    EpiMerge E{wsb + WS_GATES, (u16*)(wsb + WS_MERGED), bi};
    if (meta) thin_gemm(lds, g, S.nN, E);
  gemm_phase(LDS3, g, S, E);
  }
}
template <int MODE> DEVI void phase_gemm_plain(PRef p, unsigned char* lds, const u16* A, int lda, const u16* Bt, int K, int N, u16* out, int ldo, bool meta) { unsigned char* const wsb = opq(p.ws);
  Gemm g{A, Bt, lda, K, K};
  StaticOrder S; S.init(128, N / 256, gridDim.x, blockIdx.x);
  EpiPlain<MODE> E{(const float*)(wsb + WS_RS), out, ldo};
  if (meta) thin_gemm(lds, g, S.nN, E);
  gemm_phase(LDS3, g, S, E);
}

#define XB_TMO      128
#define XB_XCNT(j)  (256  + 64 * (j))
#define XB_XSUB(j)  (1280 + 64 * (j))
#define XB_XGEN(j)  (2304 + 64 * (j))
#define XB_TOP      3328
#define XB_TOPGEN   3392
#define XCD_BAR_WORDS 3456
#define XB_SPIN_CAP (1u << 18)
DEVI unsigned xb_ld(unsigned* p) { return __hip_atomic_load(p, __ATOMIC_RELAXED, __HIP_MEMORY_SCOPE_AGENT); }
DEVI unsigned xb_add(unsigned* p, unsigned v) { return __hip_atomic_fetch_add(p, v, __ATOMIC_RELAXED, __HIP_MEMORY_SCOPE_AGENT); }
DEVI unsigned xb_xcc_id() { return (unsigned)__builtin_amdgcn_s_getreg((3 << 11) | 20) & 0xFu; }
#define XB_SPIN(cond, bar) do { unsigned _sp = 0; while (cond) { __builtin_amdgcn_s_sleep(1); \
    if ((++_sp & 255u) == 0u) { if (xb_ld(&(bar)[XB_TMO])) break; if (_sp > XB_SPIN_CAP) { atomicAdd(&(bar)[XB_TMO], 1u); break; } } } } while (0)
struct XcdBarrier { unsigned* bar; unsigned x; volatile __attribute__((address_space(3))) unsigned* st; };
DEVI XcdBarrier xcd_barrier_post(unsigned* bar, volatile __attribute__((address_space(3))) unsigned* st) {
  XcdBarrier b; b.bar = bar; b.x = xb_xcc_id(); b.st = st;
  if (threadIdx.x == 0) (void)xb_add(&bar[XB_XCNT(b.x)], 1u);
  return b;
}
DEVI void xcd_barrier_complete(unsigned* bar, unsigned x, unsigned& nloc, unsigned& nx) {
  const unsigned G = gridDim.x * gridDim.y * gridDim.z;
  unsigned sum, cnt, mine, sp = 0u;
  for (;;) {
    sum = 0u; cnt = 0u; mine = 0u;
#pragma unroll
    for (unsigned j = 0; j < 16; ++j) { const unsigned c = xb_ld(&bar[XB_XCNT(j)]); sum += c; cnt += (c > 0u) ? 1u : 0u; mine = (j == x) ? c : mine; }
    if (sum == G) break;
    __builtin_amdgcn_s_sleep(1);
    if ((++sp & 255u) == 0u) { if (xb_ld(&bar[XB_TMO])) break; if (sp > XB_SPIN_CAP) { atomicAdd(&bar[XB_TMO], 1u); break; } }
  }
  nloc = mine > 0u ? mine : 1u; nx = cnt > 0u ? cnt : 1u;
}
__device__ __attribute__((noinline)) void xcd_barrier(const XcdBarrier b) {
  asm volatile("s_waitcnt vmcnt(0)" ::: "memory");
  __syncthreads();
  if (threadIdx.x == 0) {
    unsigned* bar = b.bar;
    __builtin_amdgcn_s_waitcnt(0);
    unsigned nloc = b.st[0], nx = b.st[1];
    if (nloc == 0u) { xcd_barrier_complete(bar, b.x, nloc, nx); b.st[0] = nloc; b.st[1] = nx; }
    const unsigned old = xb_add(&bar[XB_XSUB(b.x)], 1u);
    const unsigned gen = old / nloc;
    if (old + 1u == (gen + 1u) * nloc) {
      __builtin_amdgcn_fence(__ATOMIC_RELEASE, "agent");
      asm volatile("s_waitcnt vmcnt(0)" ::: "memory");
      const unsigned og = xb_add(&bar[XB_TOP], 1u);
      const unsigned tg = og / nx;
      if (og + 1u == (tg + 1u) * nx) xb_add(&bar[XB_TOPGEN], 1u);
      else XB_SPIN(xb_ld(&bar[XB_TOPGEN]) == tg, bar);
      __builtin_amdgcn_fence(__ATOMIC_ACQUIRE, "agent");
      xb_add(&bar[XB_XGEN(b.x)], 1u);
      asm volatile("s_waitcnt vmcnt(0)" ::: "memory");
    } else {
      XB_SPIN(xb_ld(&bar[XB_XGEN(b.x)]) == gen, bar);
      __builtin_amdgcn_fence(__ATOMIC_ACQUIRE, "agent");
      asm volatile("s_waitcnt vmcnt(0)" ::: "memory");
    }
  }
  __syncthreads();
}

#ifndef PHM
#define PHM 0xFFFF
#endif
__global__ void __launch_bounds__(512, 2) mega(Params p_unused) {
#define p (*kparams())
  extern __shared__ __attribute__((aligned(16))) unsigned char lds[];
  cg::grid_group grid = cg::this_grid();
  unsigned* ctl = (unsigned*)(p.ws + WS_CTL);
  __shared__ uint4 s_misc;
  if (threadIdx.x == 0) s_misc = make_uint4(0u, 0u, 0u, 0u);
  __syncthreads();
  XcdBarrier xbar = xcd_barrier_post(ctl, (volatile __attribute__((address_space(3))) unsigned*)&s_misc);
  u16* W = (u16*)(p.ws + WS_W);
  if (PHM & 1) { prep_layer(p, 0, (float*)lds);
  phase0_act(p); }
  if (p.ws == nullptr) grid.sync();
  xcd_barrier(xbar);
  for (int l = 0; l < 2; ++l) {
    if (PHM & 2) phase_inproj(p, lds);
    xcd_barrier(xbar);
    if (PHM & 4) { phase_upq(p, lds);
    phase_upkv(p, lds); }
    if (PHM & 8) phase_conv(p, l);
    if (PHM & 16) s5_passA(p, l, lds);
    xcd_barrier(xbar);
    if (blockIdx.x < 32) mlstm_item(p, l, blockIdx.x >> 2, blockIdx.x & 3, lds);
    else if (blockIdx.x < 48) {
      s5_scan(p, l, 32);
      __threadfence(); __syncthreads();
      if (threadIdx.x == 0) __hip_atomic_fetch_add(ctl + 24 + l, 1u, __ATOMIC_RELEASE, __HIP_MEMORY_SCOPE_AGENT);
    }
    for (;;) {
      __syncthreads();
      if (threadIdx.x == 0) s_misc.z = atomicAdd(ctl + 16 + l, 1u);
      __syncthreads();
      int it = (int)s_misc.z;
      if (it >= 1032 + 513) break;
      if (it < 1024) { const int qb = 15 - it / 64, bh = it % 64; attn_item(p, bh >> 3, bh & 7, qb, false, lds); }
      else if (it < 1032) attn_item(p, 0, it - 1024, 0, true, lds);
      else { const int k = it - 1032;
        if (threadIdx.x == 0) { unsigned spins = 0; while (__hip_atomic_load(ctl + 24 + l, __ATOMIC_RELAXED, __HIP_MEMORY_SCOPE_AGENT) < 16u && ++spins < (1u << 22)) __builtin_amdgcn_s_sleep(2); }
        __syncthreads(); __builtin_amdgcn_fence(__ATOMIC_ACQUIRE, "agent");
        if (k == 0) s5_passB_item(p, l, 0, 0, lds); else s5_passB_item(p, l, (k - 1) >> 6, 1 + ((k - 1) & 63), lds); }
    }
    xcd_barrier(xbar);
    const bool meta_live = (l == 0);
    if (PHM & 256) phase_glu(p, lds, meta_live);
    xcd_barrier(xbar);
    if (PHM & 512) phase_merge(p, lds, meta_live);
    xcd_barrier(xbar);
    if (PHM & 1024) phase_gemm_plain<0>(p, lds, (const u16*)(p.ws + WS_MERGED), 1024, W + W_OUT / 2, 1024, 1024, (u16*)(p.ws + WS_YOUT), 1024, meta_live);
    xcd_barrier(xbar);
    row_pass(p, (const u16*)(p.ws + WS_YOUT), l == 0 ? p.in[I_X] : p.out, p.in[I_NG] + (size_t)(l * 4 + 1) * DM, false);
    xcd_barrier(xbar);
    if (PHM & 4096) phase_gemm_plain<1>(p, lds, (const u16*)(p.ws + WS_HB), 1024, W + W_1 / 2, 1024, 4096, (u16*)(p.ws + WS_FF1), 4096, meta_live);
    xcd_barrier(xbar);
    if (PHM & 8192) phase_gemm_plain<0>(p, lds, (const u16*)(p.ws + WS_FF1), 4096, W + W_2 / 2, 4096, 1024, (u16*)(p.ws + WS_MERGED), 1024, meta_live);
    xcd_barrier(xbar);
    row_pass(p, (const u16*)(p.ws + WS_MERGED), p.out, p.in[I_NG] + (size_t)(l * 4 + 3) * DM, l == 1);
    if ((PHM & 1) && l == 0) prep_layer(p, 1, (float*)lds);
    xcd_barrier(xbar);
  }
}

#undef p
extern "C" void kernel_launch(void* const* d_in, const int* in_sizes, int n_in, void* d_out, int out_size, void* d_ws, size_t ws_size, hipStream_t stream) {
  static int grid = 0;
  if (grid == 0) {
    if (ws_size < WS_END) { fprintf(stderr, "workspace too small: %zu < %zu\n", ws_size, (size_t)WS_END); grid = -1; return; }
    int dev = 0, cus = 0, per_cu = 0;
    (void)hipGetDevice(&dev);
    (void)hipDeviceGetAttribute(&cus, hipDeviceAttributeMultiprocessorCount, dev);
    (void)hipFuncSetAttribute((const void*)mega, hipFuncAttributeMaxDynamicSharedMemorySize, LDS_BYTES);
    (void)hipOccupancyMaxActiveBlocksPerMultiprocessor(&per_cu, (const void*)mega, 512, LDS_BYTES);
    if (per_cu < 1) per_cu = 1;
    grid = cus * 1;
    (void)hipGetLastError();
  }
  if (grid < 0) return;
  (void)hipMemsetAsync((char*)d_ws + WS_CTL, 0, 32768, stream);
  Params p{};
  for (int i = 0; i < 24; ++i) p.in[i] = (const float*)d_in[i];
  p.out = (float*)d_out; p.ws = (unsigned char*)d_ws;
  void* args[] = {&p};
  hipError_t e = hipLaunchCooperativeKernel((const void*)mega, dim3(grid), dim3(512), args, LDS_BYTES, stream);
  if (e != hipSuccess) fprintf(stderr, "cooperative launch failed: %s (grid %d)\n", hipGetErrorString(e), grid);
}
```

```cpp
#include <hip/hip_runtime.h>
#include <hip/hip_cooperative_groups.h>
#include <cstdio>
namespace cg = cooperative_groups;

typedef unsigned short u16;
typedef unsigned char u8;
using bf16x8 = __attribute__((ext_vector_type(8))) short;
using s16x4 = __attribute__((ext_vector_type(4))) short;
using f32x4 = __attribute__((ext_vector_type(4))) float;
using f32x16 = __attribute__((ext_vector_type(16))) float;
using u32x4 = __attribute__((ext_vector_type(4))) unsigned;
using u32x2 = __attribute__((ext_vector_type(2))) unsigned;
#define DEVI __device__ __forceinline__

constexpr int DM = 1024, SEQ = 4096, NB = 8, NMETA = 16;
constexpr int MROWS = 33024, NREAL = 32768, METAROW = 32768;
constexpr int NIN = 6912, NREST = 2816, INW = 6824;
constexpr int RC_CB = 0, RC_CC = 256, RC_CV = 512, RC_MQ = 768, RC_MK = 1024, RC_MV = 1280, RC_MO = 1536, RC_SU = 1792,
              RC_CQ = 2048, RC_CKV = 2432, RC_KR = 2688, RC_MI = 2720;
constexpr float EPS = 1e-6f;
constexpr int NCH = 65;

constexpr size_t al256(size_t x) { return (x + 255) & ~(size_t)255; }
constexpr size_t WS_CTL = 0;
constexpr size_t WS_W = 32768;
constexpr size_t W_IN = 0, W_UQ = W_IN + (size_t)NIN * 1024 * 2, W_UKV = W_UQ + 768 * 384 * 2, W_GLU = W_UKV + 1024 * 256 * 2,
                 W_BR = W_GLU + 512 * 256 * 2, W_OUT = W_BR + 1024 * 1280 * 2, W_1 = W_OUT + 1024 * 1024 * 2, W_2 = W_1 + 4096 * 1024 * 2,
                 W_END = W_2 + 4096 * 1024 * 2;
constexpr size_t WS_GATES = al256(WS_W + W_END);
constexpr size_t WS_REST = al256(WS_GATES + (size_t)MROWS * 4096);
constexpr size_t WS_HB = al256(WS_REST + (size_t)MROWS * NREST * 2);
constexpr size_t WS_KN = al256(WS_HB + (size_t)MROWS * 1024 * 2);
constexpr size_t WS_KR = al256(WS_KN + (size_t)MROWS * 512 * 2);
constexpr size_t WS_VT = al256(WS_KR + (size_t)MROWS * 32 * 2);
constexpr size_t WS_RS = al256(WS_VT + (size_t)MROWS * 512 * 2);
constexpr size_t WS_HM = al256(WS_RS + (size_t)MROWS * 4);
constexpr size_t WS_S5 = al256(WS_HM + (size_t)256 * 1024 * 4);
constexpr size_t WS_ROPE = al256(WS_S5 + (size_t)(NB * NCH + 1) * 16 * 128 * 4);
constexpr size_t WS_GP = al256(WS_ROPE + (size_t)4112 * 16 * 8);
constexpr size_t WS_MSUM = al256(WS_GP + (size_t)MROWS * 8 * 4 + (size_t)MROWS * 20 * 4);
constexpr size_t WS_MSC = al256(WS_MSUM + (size_t)32 * NCH * 4160 * 2);
constexpr size_t WS_END = al256(WS_MSC + (size_t)32 * NCH * 4 * 4);
constexpr size_t WS_Q = WS_HB;
constexpr size_t WS_MERGED = WS_KN;
constexpr size_t WS_YOUT = WS_GATES;
constexpr size_t WS_FF1 = WS_GATES;
static_assert(WS_RS - WS_KN >= (size_t)MROWS * 1024 * 2, "merged alias");
static_assert(WS_HB - WS_GATES >= (size_t)MROWS * 4096 * 2, "ff1 alias");

constexpr int LDS_BYTES = 147456;
constexpr int LDS_MISC = 131072;

struct Params {
  const float* in[24];
  float* out;
  unsigned char* ws;
};
typedef const __attribute__((address_space(4))) Params& PRef;
DEVI const __attribute__((address_space(4))) Params* kparams() { auto k = __builtin_amdgcn_kernarg_segment_ptr(); asm volatile("" : "+s"(k)); return (const __attribute__((address_space(4))) Params*)k; }
enum { I_X = 0, I_META, I_NG, I_WIN, I_CONVW, I_GATEB, I_MNORM, I_ARE, I_AIM, I_LSTEP, I_BRE, I_BIM, I_CRE, I_CIM, I_SD, I_GLU,
       I_QN, I_KVN, I_WUQ, I_WUKV, I_WBR, I_WOUT, I_W1, I_W2 };

typedef __bf16 bf16x2_t __attribute__((ext_vector_type(2)));
DEVI unsigned cvtpk(float lo, float hi) { bf16x2_t v = {(__bf16)lo, (__bf16)hi}; return __builtin_bit_cast(unsigned, v); }
DEVI unsigned cvtpk_v(float lo, float hi) { unsigned r; asm volatile("v_cvt_pk_bf16_f32 %0, %1, %2\n\ts_nop 1" : "=v"(r) : "v"(lo), "v"(hi)); return r; }
DEVI u16 f2b(float f) { return (u16)(cvtpk(f, f) & 0xffffu); }
DEVI float b2f(u16 b) { return __uint_as_float(((unsigned)b) << 16); }
DEVI unsigned pack2(float a, float b) { return cvtpk(a, b); }
DEVI float blo(unsigned u) { return __uint_as_float(u << 16); }
DEVI float bhi(unsigned u) { return __uint_as_float(u & 0xffff0000u); }
DEVI float sigm(float x) { return __builtin_amdgcn_rcpf(1.f + __builtin_amdgcn_exp2f(-1.4426950408889634f * x)); }
DEVI float wave_sum(float v) { for (int o = 32; o > 0; o >>= 1) v += __shfl_xor(v, o); return v; }
DEVI int opaque_tid() { int t = threadIdx.x; asm volatile("" : "+v"(t)); return t; }
DEVI unsigned char* opq(unsigned char* p) { asm volatile("" : "+s"(p)); return p; }
DEVI int row_pos(int row) { return row < NREAL ? NMETA + (row & (SEQ - 1)) : row - METAROW; }

#define LAS __attribute__((address_space(3)))
constexpr int BM = 256, BK = 64, HALF = 128, HTB = HALF * BK * 2, NXCD = 8, WGM = 8;
DEVI int lds_byte(int r, int c) { const int st = (r >> 4) * 2 + (c >> 5), rr = r & 15, cc = c & 31, ob = rr * 64 + cc * 2; return st * 1024 + (ob ^ (((ob >> 9) & 1) << 5)); }
DEVI void stage_rc(int b, int& R, int& C) { const int st = b / 1024, sb = b % 1024, swz = sb ^ (((sb >> 9) & 1) << 5); R = (st >> 1) * 16 + swz / 64; C = (st & 1) * 32 + (swz % 64) / 2; }
DEVI int perm32(int rho) { const int n = rho >> 4, i = rho & 15; return 8 * (i >> 2) + 4 * n + (i & 3); }
struct Unit { int pm, pn; };
struct Gemm { const u16* A; const u16* Bt; int lda, ldb, K; };
struct StaticOrder {
  int nM, nN, nwg, G, c;
  DEVI void init(int nM_, int nN_, int G_, int c_) { nM = nM_; nN = nN_; nwg = nM * nN; G = G_; c = c_; }
  DEVI bool next(int i, Unit& u) const {
    const long L = (long)i * G + c; if (L >= nwg) return false;
    int wgid = (int)L; { const int q = nwg / NXCD, r = nwg % NXCD, xcd = wgid % NXCD, off = wgid / NXCD; wgid = (xcd < r ? xcd * (q + 1) : r * (q + 1) + (xcd - r) * q) + off; }
    const int nig = WGM * nN, gid = wgid / nig, fm = gid * WGM, gsz = (nM - fm) < WGM ? (nM - fm) : WGM;
    u.pm = fm + ((wgid % nig) % gsz); u.pn = (wgid % nig) / gsz; return true;
  }
};
template <class Epi>
DEVI void gemm_phase(LAS unsigned char* lds, const Gemm g, const StaticOrder& S, const Epi& E) { const int TX = opaque_tid();
  const int tid = TX, wid = __builtin_amdgcn_readfirstlane(tid >> 6), lane = tid & 63, wr = wid >> 2, wc = wid & 3, fr = lane & 15, fq = lane >> 4;
  int K = g.K; asm volatile("" : "+s"(K));
  const int nt = K / BK;
  unsigned voffA[2], voffB[2];
#pragma unroll
  for (int i = 0; i < 2; ++i) { int R, C; stage_rc(tid * 16 + i * 8192, R, C); const int Rb = (R & ~31) + perm32(R & 31);
    voffA[i] = (unsigned)(R * g.lda + C) * 2u; voffB[i] = (unsigned)(Rb * g.ldb + C) * 2u; }
  const size_t kstep = (size_t)(BK * 2);
  const size_t hstepA = (size_t)HALF * g.lda * 2, hstepB = (size_t)HALF * g.ldb * 2;
  const unsigned ldsw = (unsigned)wid * 1024u;
  const int aoff = lds_byte(wr * 64 + fr, fq * 8), boff = lds_byte(wc * 32 + fr, fq * 8);
#define PG8_SA(b, h) (((b) * 2 + (h)) * HTB)
#define PG8_SB(b, h) ((4 + (b) * 2 + (h)) * HTB)
#define PG8_STAGE(bufoff, gbase, voff) do { _Pragma("unroll") for (int _i = 0; _i < 2; ++_i) \
    __builtin_amdgcn_global_load_lds((const unsigned*)((const char*)(gbase) + (voff)[_i]), (LAS unsigned*)(lds + (bufoff) + ldsw + _i * 8192), 16, 0, 0); } while (0)
#define PG8_LDA(dst, b, h) do { _Pragma("unroll") for (int m = 0; m < 4; ++m) _Pragma("unroll") for (int k = 0; k < 2; ++k) dst[m][k] = *(const LAS bf16x8*)(lds + PG8_SA(b, h) + aoff + m * 2048 + k * 1024); } while (0)
#define PG8_LDB(dst, b, h) do { _Pragma("unroll") for (int n = 0; n < 2; ++n) _Pragma("unroll") for (int k = 0; k < 2; ++k) dst[n][k] = *(const LAS bf16x8*)(lds + PG8_SB(b, h) + boff + n * 2048 + k * 1024); } while (0)
#define PG8_MMA(ai, bj, At, Bt) do { __builtin_amdgcn_s_setprio(1); _Pragma("unroll") for (int m = 0; m < 4; ++m) _Pragma("unroll") for (int n = 0; n < 2; ++n) _Pragma("unroll") for (int k = 0; k < 2; ++k) \
    acc[ai][bj][m][n] = __builtin_amdgcn_mfma_f32_16x16x32_bf16(Bt[n][k], At[m][k], acc[ai][bj][m][n], 0, 0, 0); __builtin_amdgcn_s_setprio(0); } while (0)
#define PG8_WAIT_V(n) asm volatile("s_waitcnt vmcnt(" #n ")" ::: "memory")
#define PG8_WAIT_L(n) asm volatile("s_waitcnt lgkmcnt(" #n ")" ::: "memory")
#define PG8_BAR __builtin_amdgcn_s_barrier()
#define PG8_SCHED __builtin_amdgcn_sched_barrier(0)
  Unit cur, nxt; int ui = 0;
  if (!S.next(0, cur)) return;
  f32x4 acc[2][2][4][2];
#pragma unroll
  for (int a = 0; a < 2; ++a)
#pragma unroll
    for (int b = 0; b < 2; ++b)
#pragma unroll
      for (int m = 0; m < 4; ++m)
#pragma unroll
        for (int n = 0; n < 2; ++n) acc[a][b][m][n] = (f32x4){0.f, 0.f, 0.f, 0.f};
  bf16x8 At[4][2], B0[2][2], B1[2][2];
  const char* cA = (const char*)g.A + (size_t)cur.pm * 2 * hstepA; const char* cB = (const char*)g.Bt + (size_t)cur.pn * 2 * hstepB;
  PG8_STAGE(PG8_SB(0, 0), cB, voffB); PG8_STAGE(PG8_SA(0, 0), cA, voffA); PG8_STAGE(PG8_SB(0, 1), cB + hstepB, voffB); PG8_STAGE(PG8_SA(0, 1), cA + hstepA, voffA);
  if (wr == 1) PG8_BAR;
  PG8_WAIT_V(4); PG8_BAR;
  PG8_STAGE(PG8_SB(1, 0), cB + kstep, voffB); PG8_STAGE(PG8_SA(1, 0), cA + kstep, voffA); PG8_STAGE(PG8_SB(1, 1), cB + hstepB + kstep, voffB);
  PG8_WAIT_V(6); PG8_BAR;
  for (;;) {
    const bool has_next = S.next(ui + 1, nxt);
    const char* nA = has_next ? (const char*)g.A + (size_t)nxt.pm * 2 * hstepA : cA; const char* nB = has_next ? (const char*)g.Bt + (size_t)nxt.pn * 2 * hstepB : cB;
#pragma nounroll
    for (int t = 0; t < nt; t += 2) {
      const bool last = (t == nt - 2);
      const char* a1 = cA + (size_t)(t + 1) * kstep;
      const char* a2 = last ? nA : cA + (size_t)(t + 2) * kstep; const char* b2 = last ? nB : cB + (size_t)(t + 2) * kstep;
      const char* a3 = a2 + kstep; const char* b3 = b2 + kstep;
      PG8_LDB(B0, 0, 0); PG8_SCHED; PG8_LDA(At, 0, 0); PG8_STAGE(PG8_SA(1, 1), a1 + hstepA, voffA);
      PG8_WAIT_L(8); PG8_BAR; PG8_WAIT_L(0); PG8_MMA(0, 0, At, B0); PG8_BAR; PG8_SCHED;
      PG8_LDB(B1, 0, 1); PG8_STAGE(PG8_SB(0, 0), b2, voffB);
      PG8_BAR; PG8_WAIT_L(0); PG8_MMA(0, 1, At, B1); PG8_BAR;
      PG8_LDA(At, 0, 1); PG8_STAGE(PG8_SA(0, 0), a2, voffA);
      PG8_BAR; PG8_WAIT_L(0); PG8_MMA(1, 0, At, B0); PG8_BAR; PG8_SCHED;
      PG8_STAGE(PG8_SB(0, 1), b2 + hstepB, voffB);
      PG8_WAIT_V(6); PG8_BAR; PG8_MMA(1, 1, At, B1); PG8_BAR;
      PG8_LDB(B0, 1, 0); PG8_SCHED; PG8_LDA(At, 1, 0); PG8_STAGE(PG8_SA(0, 1), a2 + hstepA, voffA);
      PG8_WAIT_L(8); PG8_BAR; PG8_WAIT_L(0); PG8_MMA(0, 0, At, B0); PG8_BAR; PG8_SCHED;
      PG8_LDB(B1, 1, 1); PG8_STAGE(PG8_SB(1, 0), b3, voffB);
      PG8_BAR; PG8_WAIT_L(0); PG8_MMA(0, 1, At, B1); PG8_BAR;
      PG8_LDA(At, 1, 1); PG8_STAGE(PG8_SA(1, 0), a3, voffA);
      PG8_BAR; PG8_WAIT_L(0); PG8_MMA(1, 0, At, B0); PG8_BAR; PG8_SCHED;
      PG8_STAGE(PG8_SB(1, 1), b3 + hstepB, voffB);
      PG8_WAIT_V(6); PG8_BAR; PG8_MMA(1, 1, At, B1); PG8_BAR;
    }
    E(acc, cur, wr, wc, fr, fq);
    if (!has_next) break;
#pragma unroll
    for (int a = 0; a < 2; ++a)
#pragma unroll
      for (int b = 0; b < 2; ++b)
#pragma unroll
        for (int m = 0; m < 4; ++m)
#pragma unroll
          for (int n = 0; n < 2; ++n) acc[a][b][m][n] = (f32x4){0.f, 0.f, 0.f, 0.f};
    cur = nxt; cA = nA; cB = nB; ++ui;
  }
  PG8_WAIT_V(0);
  if (wr == 0) PG8_BAR;
  PG8_BAR;
#undef PG8_SA
#undef PG8_SB
#undef PG8_STAGE
#undef PG8_LDA
#undef PG8_LDB
#undef PG8_MMA
#undef PG8_WAIT_V
#undef PG8_WAIT_L
#undef PG8_BAR
#undef PG8_SCHED
}
typedef const f32x4 (&AccRef)[2][2][4][2];
DEVI unsigned cvtpk_e(float lo, float hi) { unsigned r; asm volatile("v_cvt_pk_bf16_f32 %0, %1, %2" : "=v"(r) : "v"(lo), "v"(hi)); return r; }
#define EPI_ROWS(...) _Pragma("unroll") for (int ai = 0; ai < (THIN ? 1 : 2); ++ai) _Pragma("unroll") for (int m = 0; m < (THIN ? 1 : 4); ++m) { const int row = u.pm * 256 + ai * 128 + wr * 64 + m * 16 + fr; __VA_ARGS__ }

template <int MAPT> DEVI int cmap(int n) {
  if (MAPT == 1) {
    if (n < 4096 + 1792) return n;
    int rc = n - 4096;
    if (rc < 2720) return 5896 + (rc - 1792);
    if (rc < 2728) return 5888 + (rc - 2720);
    return -1;
  } else if (MAPT == 2) {
    int nt = n >> 8, r = n & 255;
    return r < 128 ? nt * 128 + r : 256 + nt * 128 + (r - 128);
  }
  return n;
}
template <int MAPT> DEVI void prep_matrix(float* tile, const float* src, int K, int Nsrc, int Ndst, const float* g, u16* dst) { const int TX = opaque_tid();
  const int tk = K / 64, tn = Ndst / 64, tid = TX, ntile = tk * tn;
  float v[8];
  auto ld = [&](int t) { const int k0 = (t % tk) * 64, n0 = (t / tk) * 64;
    for (int i = 0; i < 8; ++i) { int idx = tid + i * 512, kk = idx >> 6, nn = idx & 63; int sc = cmap<MAPT>(n0 + nn);
      float x = sc >= 0 ? src[(size_t)(k0 + kk) * Nsrc + sc] : 0.f; if (g) x *= g[k0 + kk]; v[i] = x; } };
  int t = blockIdx.x;
  if (t < ntile) ld(t);
  for (; t < ntile; t += gridDim.x) {
    const int k0 = (t % tk) * 64, n0 = (t / tk) * 64;
    __syncthreads();
    for (int i = 0; i < 8; ++i) { int idx = tid + i * 512, kk = idx >> 6, nn = idx & 63; tile[kk * 65 + nn] = v[i]; }
    __syncthreads();
    if (t + (int)gridDim.x < ntile) ld(t + gridDim.x);
    { int nn = tid >> 3, k8 = (tid & 7) * 8; u32x4 o;
      for (int j = 0; j < 4; ++j) o[j] = pack2(tile[(k8 + 2 * j) * 65 + nn], tile[(k8 + 2 * j + 1) * 65 + nn]);
      *(u32x4*)(dst + (size_t)(n0 + nn) * K + k0 + k8) = o; }
  }
}
DEVI void prep_layer(PRef p, int l, float* tile) { unsigned char* const wsb = opq(p.ws);
  u16* W = (u16*)(wsb + WS_W);
  const float* ng = p.in[I_NG] + (size_t)l * 4 * DM;
  prep_matrix<1>(tile, p.in[I_WIN] + (size_t)l * DM * INW, 1024, INW, NIN, ng, W + W_IN / 2);
  prep_matrix<0>(tile, p.in[I_W1] + (size_t)l * DM * 4096, 1024, 4096, 4096, ng + 2 * DM, W + W_1 / 2);
  prep_matrix<0>(tile, p.in[I_W2] + (size_t)l * DM * 4096, 4096, 1024, 1024, nullptr, W + W_2 / 2);
  prep_matrix<0>(tile, p.in[I_WBR] + (size_t)l * 1280 * DM, 1280, 1024, 1024, nullptr, W + W_BR / 2);
  prep_matrix<0>(tile, p.in[I_WOUT] + (size_t)l * DM * DM, 1024, 1024, 1024, nullptr, W + W_OUT / 2);
  prep_matrix<0>(tile, p.in[I_WUQ] + (size_t)l * 384 * 768, 384, 768, 768, p.in[I_QN] + l * 384, W + W_UQ / 2);
  prep_matrix<0>(tile, p.in[I_WUKV] + (size_t)l * 256 * 1024, 256, 1024, 1024, p.in[I_KVN] + l * 256, W + W_UKV / 2);
  prep_matrix<2>(tile, p.in[I_GLU] + (size_t)l * 256 * 512, 256, 512, 512, nullptr, W + W_GLU / 2);
}

DEVI void phase0_act(PRef p) { const int TX = opaque_tid(); unsigned char* const wsb = opq(p.ws);
  const int lane = TX & 63, gw = blockIdx.x * 8 + (TX >> 6), NW = gridDim.x * 8;
  u16* hb = (u16*)(wsb + WS_HB); float* rs = (float*)(wsb + WS_RS); float* hm = (float*)(wsb + WS_HM);
  for (int row = gw; row < NREAL + NMETA; row += NW) {
    const float* src = row < NREAL ? p.in[I_X] + (size_t)row * DM : (row < METAROW + NMETA ? p.in[I_META] + (size_t)(row - METAROW) * DM : nullptr);
    float ss = 0.f;
    for (int i = 0; i < 4; ++i) {
      f32x4 v = src ? *(const f32x4*)(src + i * 256 + lane * 4) : (f32x4){0.f, 0.f, 0.f, 0.f};
      ss += v[0] * v[0] + v[1] * v[1] + v[2] * v[2] + v[3] * v[3];
      u32x2 o; o[0] = pack2(v[0], v[1]); o[1] = pack2(v[2], v[3]);
      *(u32x2*)(hb + (size_t)row * DM + i * 256 + lane * 4) = o;
      if (row >= NREAL) *(f32x4*)(hm + (size_t)(row - METAROW) * DM + i * 256 + lane * 4) = v;
    }
    ss = wave_sum(ss);
    if (lane == 0) rs[row] = rsqrtf(ss * (1.f / DM) + EPS);
  }
  float* rope = (float*)(wsb + WS_ROPE);
  for (int i = blockIdx.x * 512 + TX; i < 4112 * 16; i += gridDim.x * 512) {
    int pos = i >> 4, f = i & 15;
    float inv = exp2f(-(float)(2 * f) * (13.287712379549449f / 32.f));
    float ang = (float)pos * inv;
    rope[2 * i] = cosf(ang); rope[2 * i + 1] = sinf(ang);
  }
}

DEVI void row_pass(PRef p, const u16* y, const float* hsrc_real, const float* g, bool fin) { const int TX = opaque_tid(); unsigned char* const wsb = opq(p.ws);
  const int lane = TX & 63, gw = blockIdx.x * 8 + (TX >> 6), NW = gridDim.x * 8;
  u16* hb = (u16*)(wsb + WS_HB); float* rs = (float*)(wsb + WS_RS); float* hm = (float*)(wsb + WS_HM);
  const int NR = NREAL + NMETA;
  u32x2 yr[4]; f32x4 hr[4];
  if (gw < NR) { const float* hs = gw < NREAL ? hsrc_real + (size_t)gw * DM : hm + (size_t)(gw - METAROW) * DM;
    for (int i = 0; i < 4; ++i) { yr[i] = *(const u32x2*)(y + (size_t)gw * DM + i * 256 + lane * 4); hr[i] = *(const f32x4*)(hs + i * 256 + lane * 4); } }
  f32x4 gg[4]; for (int i = 0; i < 4; ++i) gg[i] = *(const f32x4*)(g + i * 256 + lane * 4);
  for (int row = gw; row < NR; row += NW) {
    const int nx = row + NW; u32x2 yn[4]; f32x4 hn[4];
    if (nx < NR) { const float* hs = nx < NREAL ? hsrc_real + (size_t)nx * DM : hm + (size_t)(nx - METAROW) * DM;
      for (int i = 0; i < 4; ++i) { yn[i] = *(const u32x2*)(y + (size_t)nx * DM + i * 256 + lane * 4); hn[i] = *(const f32x4*)(hs + i * 256 + lane * 4); } }
    float* hd = row < NREAL ? p.out + (size_t)row * DM : hm + (size_t)(row - METAROW) * DM;
    float yv[16]; float ss = 0.f;
    for (int i = 0; i < 4; ++i) { yv[4 * i] = blo(yr[i][0]); yv[4 * i + 1] = bhi(yr[i][0]); yv[4 * i + 2] = blo(yr[i][1]); yv[4 * i + 3] = bhi(yr[i][1]);
      for (int j = 0; j < 4; ++j) ss += yv[4 * i + j] * yv[4 * i + j]; }
    ss = wave_sum(ss);
    const float r = rsqrtf(ss * (1.f / DM) + EPS);
    float s2 = 0.f;
    for (int i = 0; i < 4; ++i) {
      f32x4 h = hr[i];
      for (int j = 0; j < 4; ++j) { h[j] += yv[4 * i + j] * r * gg[i][j]; s2 += h[j] * h[j]; }
      *(f32x4*)(hd + i * 256 + lane * 4) = h;
      if (!fin) { u32x2 o; o[0] = pack2(h[0], h[1]); o[1] = pack2(h[2], h[3]);
        *(u32x2*)(hb + (size_t)row * DM + i * 256 + lane * 4) = o; }
    }
    if (!fin) { s2 = wave_sum(s2);
      if (lane == 0) rs[row] = rsqrtf(s2 * (1.f / DM) + EPS); }
    for (int i = 0; i < 4; ++i) { yr[i] = yn[i]; hr[i] = hn[i]; }
  }
}

DEVI int prev_row(int t, int d) {
  if (t < NREAL) { int s = t & (SEQ - 1); return s >= d ? t - d : METAROW + NMETA + s - d; }
  int pp = t - METAROW; return pp >= d ? t - d : -1;
}
DEVI void phase_conv(PRef p, int l) { const int TX = opaque_tid(); unsigned char* const wsb = opq(p.ws);
  const int lane = TX & 63, gw = blockIdx.x * 8 + (TX >> 6), NW = gridDim.x * 8;
  u16* rest = (u16*)(wsb + WS_REST); u16* kr = (u16*)(wsb + WS_KR); const float* rope = (const float*)(wsb + WS_ROPE);
  const float* cw = p.in[I_CONVW] + (size_t)l * 3 * 256;
  float w0[4], w1[4], w2[4];
  for (int j = 0; j < 4; ++j) { w0[j] = cw[lane * 4 + j]; w1[j] = cw[256 + lane * 4 + j]; w2[j] = cw[512 + lane * 4 + j]; }
  auto ld = [&](int row, u32x2 (&d)[7]) {
    const u16* rr = rest + (size_t)row * NREST; const int r1 = prev_row(row, 1), r2 = prev_row(row, 2);
    d[0] = *(const u32x2*)(rr + RC_CB + lane * 4); d[1] = *(const u32x2*)(rr + RC_CC + lane * 4); d[2] = *(const u32x2*)(rr + RC_CV + lane * 4);
    d[3] = (u32x2){0, 0}; d[4] = d[3]; d[5] = d[3]; d[6] = d[3];
    if (r1 >= 0) { d[3] = *(const u32x2*)(rest + (size_t)r1 * NREST + RC_CC + lane * 4); d[4] = *(const u32x2*)(rest + (size_t)r1 * NREST + RC_CV + lane * 4); }
    if (r2 >= 0) { d[5] = *(const u32x2*)(rest + (size_t)r2 * NREST + RC_CC + lane * 4); d[6] = *(const u32x2*)(rest + (size_t)r2 * NREST + RC_CV + lane * 4); } };
  const int NR = NREAL + NMETA;
  u32x2 cur[7]; unsigned kcur = 0;
  if (gw < NR) { ld(gw, cur); if (lane < 32) kcur = rest[(size_t)gw * NREST + RC_KR + lane]; }
  for (int row = gw; row < NR; row += NW) {
    const int nx = row + NW; u32x2 nxt[7]; unsigned knx = 0;
    if (nx < NR) { ld(nx, nxt); if (lane < 32) knx = rest[(size_t)nx * NREST + RC_KR + lane]; }
    u16* rr = rest + (size_t)row * NREST;
    float o[4];
    for (int j = 0; j < 4; ++j) {
      unsigned a0 = cur[1][j >> 1], b0 = cur[2][j >> 1], a1 = cur[3][j >> 1], b1 = cur[4][j >> 1], a2 = cur[5][j >> 1], b2 = cur[6][j >> 1], g = cur[0][j >> 1];
      float u0 = (j & 1) ? bhi(a0) * bhi(b0) : blo(a0) * blo(b0);
      float u1 = (j & 1) ? bhi(a1) * bhi(b1) : blo(a1) * blo(b1);
      float u2 = (j & 1) ? bhi(a2) * bhi(b2) : blo(a2) * blo(b2);
      float gg = (j & 1) ? bhi(g) : blo(g);
      o[j] = gg * (w0[j] * u2 + w1[j] * u1 + w2[j] * u0);
    }
    u32x2 ov; ov[0] = pack2(o[0], o[1]); ov[1] = pack2(o[2], o[3]);
    *(u32x2*)(rr + RC_CB + lane * 4) = ov;
    { const int pos = row_pos(row);
      const float xm = b2f((u16)kcur), xo = b2f((u16)__shfl_xor((int)kcur, 16));
      if (lane < 32) { const int f = lane & 15; const float c = rope[(pos * 16 + f) * 2], sn = rope[(pos * 16 + f) * 2 + 1];
        kr[(size_t)row * 32 + lane] = f2b(lane < 16 ? xm * c - xo * sn : xm * c + xo * sn); } }
    for (int i = 0; i < 7; ++i) cur[i] = nxt[i]; kcur = knx;
  }
}

DEVI void chunk_rows(int b, int c, int& row0, int& len) { if (c == 0) { row0 = METAROW; len = NMETA; } else { row0 = b * SEQ + (c - 1) * 64; len = 64; } }
struct S5Const { float lr, li; float bre[16], bim[16]; };
DEVI void s5_consts(PRef p, int l, int g, int pp, S5Const& k) {
  const float are = p.in[I_ARE][(l * 16 + g) * 64 + pp], aim = p.in[I_AIM][(l * 16 + g) * 64 + pp];
  const float dt = expf(p.in[I_LSTEP][l * 16 + g]);
  const float mag = expf(are * dt);
  k.lr = mag * cosf(aim * dt); k.li = mag * sinf(aim * dt);
  const float den = are * are + aim * aim, xr = k.lr - 1.f, xi = k.li;
  const float zr = (xr * are + xi * aim) / den, zi = (xi * are - xr * aim) / den;
  const float* br = p.in[I_BRE] + ((size_t)(l * 16 + g) * 64 + pp) * 16; const float* bi = p.in[I_BIM] + ((size_t)(l * 16 + g) * 64 + pp) * 16;
  for (int i = 0; i < 16; ++i) { float a = br[i], b = bi[i]; k.bre[i] = zr * a - zi * b; k.bim[i] = zr * b + zi * a; }
}
DEVI void s5_load_u(PRef p, float* ul, int row0, int len) { const int TX = opaque_tid(); unsigned char* const wsb = opq(p.ws);
  const u16* rest = (const u16*)(wsb + WS_REST);
  for (int i = TX; i < 64 * 32; i += 512) { int r = i >> 5, c8 = (i & 31) * 8;
    u32x4 v = {0, 0, 0, 0}; if (r < len) v = *(const u32x4*)(rest + (size_t)(row0 + r) * NREST + RC_SU + c8);
    *(f32x4*)(ul + r * 256 + c8) = (f32x4){blo(v[0]), bhi(v[0]), blo(v[1]), bhi(v[1])}; *(f32x4*)(ul + r * 256 + c8 + 4) = (f32x4){blo(v[2]), bhi(v[2]), blo(v[3]), bhi(v[3])}; }
}
DEVI void s5_bu(const float* urow, const S5Const& k, float& bur, float& bui) {
  bur = 0.f; bui = 0.f;
#pragma unroll
  for (int q = 0; q < 4; ++q) { const f32x4 x = *(const f32x4*)(urow + 4 * q);
#pragma unroll
    for (int i = 0; i < 4; ++i) { bur += k.bre[4 * q + i] * x[i]; bui += k.bim[4 * q + i] * x[i]; } }
}
DEVI void s5_passA(PRef p, int l, unsigned char* lds) { const int TX = opaque_tid(); unsigned char* const wsb = opq(p.ws);
  u16* ulb = (u16*)lds; float* buL = (float*)(lds + 32768); float* send = (float*)(wsb + WS_S5);
  const u16* rest = (const u16*)(wsb + WS_REST);
  const int wave = TX >> 6, lane = TX & 63, fr = lane & 15, fq = lane >> 4;
  float* bw = buL + wave * 16 * 132;
  for (int it = blockIdx.x; it < NB * 64 + 1; it += gridDim.x) {
    const int b = it < NB * 64 ? it >> 6 : 0, c = it < NB * 64 ? 1 + (it & 63) : 0; int row0, len; chunk_rows(b, c, row0, len);
    __syncthreads();
    for (int i = TX; i < 64 * 32; i += 512) { int r = i >> 5, c8 = (i & 31) * 8;
      u32x4 v = {0, 0, 0, 0}; if (r < len) v = *(const u32x4*)(rest + (size_t)(row0 + r) * NREST + RC_SU + c8);
      *(u32x4*)(ulb + r * 256 + c8) = v; }
    __syncthreads();
    for (int gi = 0; gi < 2; ++gi) { const int g = wave * 2 + gi;
      const float are = p.in[I_ARE][(l * 16 + g) * 64 + lane], aim = p.in[I_AIM][(l * 16 + g) * 64 + lane];
      const float dt = expf(p.in[I_LSTEP][l * 16 + g]); const float mag = expf(are * dt);
      const float lr = mag * cosf(aim * dt), li = mag * sinf(aim * dt);
      { const float den = are * are + aim * aim, xr = lr - 1.f, xi = li;
        __builtin_amdgcn_wave_barrier();
        bw[lane] = (xr * are + xi * aim) / den; bw[64 + lane] = (xi * are - xr * aim) / den;
        __builtin_amdgcn_wave_barrier(); }
      bf16x8 bfr[4], bfi[4];
#pragma unroll
      for (int nt = 0; nt < 4; ++nt) { const int ps = 16 * nt + fr; const float zr = bw[ps], zi = bw[64 + ps];
        u32x4 wr4 = {0, 0, 0, 0}, wi4 = {0, 0, 0, 0};
        if (fq < 2) { const float* br = p.in[I_BRE] + ((size_t)(l * 16 + g) * 64 + ps) * 16 + 8 * fq; const float* bi = p.in[I_BIM] + ((size_t)(l * 16 + g) * 64 + ps) * 16 + 8 * fq;
          const f32x4 r0 = *(const f32x4*)br, r1 = *(const f32x4*)(br + 4), i0 = *(const f32x4*)bi, i1 = *(const f32x4*)(bi + 4);
          wr4[0] = cvtpk(zr * r0[0] - zi * i0[0], zr * r0[1] - zi * i0[1]); wr4[1] = cvtpk(zr * r0[2] - zi * i0[2], zr * r0[3] - zi * i0[3]);
          wr4[2] = cvtpk(zr * r1[0] - zi * i1[0], zr * r1[1] - zi * i1[1]); wr4[3] = cvtpk(zr * r1[2] - zi * i1[2], zr * r1[3] - zi * i1[3]);
          wi4[0] = cvtpk(zr * i0[0] + zi * r0[0], zr * i0[1] + zi * r0[1]); wi4[1] = cvtpk(zr * i0[2] + zi * r0[2], zr * i0[3] + zi * r0[3]);
          wi4[2] = cvtpk(zr * i1[0] + zi * r1[0], zr * i1[1] + zi * r1[1]); wi4[3] = cvtpk(zr * i1[2] + zi * r1[2], zr * i1[3] + zi * r1[3]); }
        bfr[nt] = __builtin_bit_cast(bf16x8, wr4); bfi[nt] = __builtin_bit_cast(bf16x8, wi4); }
      float sr = 0.f, si = 0.f;
      for (int sb = 0; sb < len; sb += 16) {
        u32x4 au = {0, 0, 0, 0}; if (fq < 2) au = *(const u32x4*)(ulb + (sb + fr) * 256 + g * 16 + 8 * fq);
        const bf16x8 af = __builtin_bit_cast(bf16x8, au);
        __builtin_amdgcn_wave_barrier();
#pragma unroll
        for (int nt = 0; nt < 4; ++nt) { const f32x4 z4 = {0.f, 0.f, 0.f, 0.f};
          const f32x4 dr = __builtin_amdgcn_mfma_f32_16x16x32_bf16(af, bfr[nt], z4, 0, 0, 0), di = __builtin_amdgcn_mfma_f32_16x16x32_bf16(af, bfi[nt], z4, 0, 0, 0);
#pragma unroll
          for (int r = 0; r < 4; ++r) { bw[(4 * fq + r) * 132 + 16 * nt + fr] = dr[r]; bw[(4 * fq + r) * 132 + 64 + 16 * nt + fr] = di[r]; } }
        __builtin_amdgcn_wave_barrier();
        for (int tt = 0; tt < 16; ++tt) { const float bur = bw[tt * 132 + lane], bui = bw[tt * 132 + 64 + lane];
          float nr = lr * sr - li * si + bur, ni = lr * si + li * sr + bui; sr = nr; si = ni; }
      }
      float* o = send + ((size_t)(c == 0 ? NB * NCH : b * NCH + c) * 16 + g) * 128; o[lane] = sr; o[64 + lane] = si; }
  }
}
DEVI void s5_scan(PRef p, int l, int blk0) { const int TX = opaque_tid(); unsigned char* const wsb = opq(p.ws);
  float* send = (float*)(wsb + WS_S5);
  const int lane = TX & 63, gw = ((int)blockIdx.x - blk0) * 8 + (TX >> 6);
  if (gw < 0 || gw >= NB * 16) return;
  const int b = gw >> 4, g = gw & 15;
  const float are = p.in[I_ARE][(l * 16 + g) * 64 + lane], aim = p.in[I_AIM][(l * 16 + g) * 64 + lane];
  const float dt = expf(p.in[I_LSTEP][l * 16 + g]); const float mag = expf(are * dt);
  float l16r = mag * cosf(aim * dt), l16i = mag * sinf(aim * dt);
  for (int i = 0; i < 4; ++i) { float a = l16r * l16r - l16i * l16i, bb = l16r * l16i; l16r = a; l16i = bb + bb; }
  float l64r = l16r, l64i = l16i; for (int i = 0; i < 2; ++i) { float a = l64r * l64r - l64i * l64i, bb = l64r * l64i; l64r = a; l64i = bb + bb; }
  float sr = 0.f, si = 0.f;
  for (int c0 = 0; c0 < NCH; c0 += 5) {
    float er[5], ei[5];
    for (int i = 0; i < 5; ++i) { const float* e = send + ((size_t)((c0 + i) == 0 ? NB * NCH : b * NCH + c0 + i) * 16 + g) * 128; er[i] = e[lane]; ei[i] = e[64 + lane]; }
    for (int i = 0; i < 5; ++i) { float* e = send + ((size_t)(b * NCH + c0 + i) * 16 + g) * 128; e[lane] = sr; e[64 + lane] = si;
      const float pr = (c0 + i) == 0 ? l16r : l64r, pi = (c0 + i) == 0 ? l16i : l64i;
      const float nr = pr * sr - pi * si + er[i], ni = pr * si + pi * sr + ei[i]; sr = nr; si = ni; }
  }
}
DEVI void s5_passB_item(PRef p, int l, int b, int c, unsigned char* lds) { const int TX = opaque_tid(); unsigned char* const wsb = opq(p.ws);
  u16* ulb = (u16*)lds;
  unsigned* sst = (unsigned*)(lds + 32768);
  float* buL = (float*)(lds + 32768 + 34816);
  const float* send = (const float*)(wsb + WS_S5); u16* rest = (u16*)(wsb + WS_REST);
  const int wave = TX >> 6, lane = TX & 63, fr = lane & 15, fq = lane >> 4;
  int row0, len; chunk_rows(b, c, row0, len);
  __syncthreads();
  for (int i = TX; i < 64 * 32; i += 512) { int r = i >> 5, c8 = (i & 31) * 8;
    u32x4 v = {0, 0, 0, 0}; if (r < len) v = *(const u32x4*)(rest + (size_t)(row0 + r) * NREST + RC_SU + c8);
    *(u32x4*)(ulb + r * 256 + c8) = v; }
  __syncthreads();
  unsigned* sw = sst + wave * 16 * 68; float* bw = buL + wave * 16 * 132;
  for (int gi = 0; gi < 2; ++gi) { const int g = wave * 2 + gi;
    const float are = p.in[I_ARE][(l * 16 + g) * 64 + lane], aim = p.in[I_AIM][(l * 16 + g) * 64 + lane];
    const float dt = expf(p.in[I_LSTEP][l * 16 + g]); const float mag = expf(are * dt);
    const float lr = mag * cosf(aim * dt), li = mag * sinf(aim * dt);
    { const float den = are * are + aim * aim, xr = lr - 1.f, xi = li;
      __builtin_amdgcn_wave_barrier();
      bw[lane] = (xr * are + xi * aim) / den; bw[64 + lane] = (xi * are - xr * aim) / den;
      __builtin_amdgcn_wave_barrier(); }
    bf16x8 bfr[4], bfi[4];
#pragma unroll
    for (int nt = 0; nt < 4; ++nt) { const int ps = 16 * nt + fr; const float zr = bw[ps], zi = bw[64 + ps];
      u32x4 wr4 = {0, 0, 0, 0}, wi4 = {0, 0, 0, 0};
      if (fq < 2) { const float* br = p.in[I_BRE] + ((size_t)(l * 16 + g) * 64 + ps) * 16 + 8 * fq; const float* bi = p.in[I_BIM] + ((size_t)(l * 16 + g) * 64 + ps) * 16 + 8 * fq;
        const f32x4 r0 = *(const f32x4*)br, r1 = *(const f32x4*)(br + 4), i0 = *(const f32x4*)bi, i1 = *(const f32x4*)(bi + 4);
        wr4[0] = cvtpk(zr * r0[0] - zi * i0[0], zr * r0[1] - zi * i0[1]); wr4[1] = cvtpk(zr * r0[2] - zi * i0[2], zr * r0[3] - zi * i0[3]);
        wr4[2] = cvtpk(zr * r1[0] - zi * i1[0], zr * r1[1] - zi * i1[1]); wr4[3] = cvtpk(zr * r1[2] - zi * i1[2], zr * r1[3] - zi * i1[3]);
        wi4[0] = cvtpk(zr * i0[0] + zi * r0[0], zr * i0[1] + zi * r0[1]); wi4[1] = cvtpk(zr * i0[2] + zi * r0[2], zr * i0[3] + zi * r0[3]);
        wi4[2] = cvtpk(zr * i1[0] + zi * r1[0], zr * i1[1] + zi * r1[1]); wi4[3] = cvtpk(zr * i1[2] + zi * r1[2], zr * i1[3] + zi * r1[3]); }
      bfr[nt] = __builtin_bit_cast(bf16x8, wr4); bfi[nt] = __builtin_bit_cast(bf16x8, wi4); }
    const float* e0 = send + ((size_t)(b * NCH + c) * 16 + g) * 128; float sr = e0[lane], si = e0[64 + lane];
    bf16x8 cf[4];
    for (int ks = 0; ks < 4; ++ks) { const int p0 = (32 * ks + 8 * fq) >> 1;
      const f32x4 cr = *(const f32x4*)(p.in[I_CRE] + ((size_t)(l * 16 + g) * 16 + fr) * 64 + p0), ci = *(const f32x4*)(p.in[I_CIM] + ((size_t)(l * 16 + g) * 16 + fr) * 64 + p0);
      u32x4 t4; for (int j = 0; j < 4; ++j) t4[j] = cvtpk(cr[j], -ci[j]);
      cf[ks] = __builtin_bit_cast(bf16x8, t4); }
    const float dsk = p.in[I_SD][l * 256 + g * 16 + fr];
    for (int sb = 0; sb < len; sb += 16) {
      u32x4 au = {0, 0, 0, 0}; if (fq < 2) au = *(const u32x4*)(ulb + (sb + fr) * 256 + g * 16 + 8 * fq);
      const bf16x8 af = __builtin_bit_cast(bf16x8, au);
      __builtin_amdgcn_wave_barrier();
#pragma unroll
      for (int nt = 0; nt < 4; ++nt) { const f32x4 z4 = {0.f, 0.f, 0.f, 0.f};
        const f32x4 dr = __builtin_amdgcn_mfma_f32_16x16x32_bf16(af, bfr[nt], z4, 0, 0, 0), di = __builtin_amdgcn_mfma_f32_16x16x32_bf16(af, bfi[nt], z4, 0, 0, 0);
#pragma unroll
        for (int r = 0; r < 4; ++r) { bw[(4 * fq + r) * 132 + 16 * nt + fr] = dr[r]; bw[(4 * fq + r) * 132 + 64 + 16 * nt + fr] = di[r]; } }
      __builtin_amdgcn_wave_barrier();
      for (int tt = 0; tt < 16; ++tt) { const float bur = bw[tt * 132 + lane], bui = bw[tt * 132 + 64 + lane];
        float nr = lr * sr - li * si + bur, ni = lr * si + li * sr + bui; sr = nr; si = ni;
        sw[tt * 68 + lane] = cvtpk(sr, si); }
      __builtin_amdgcn_wave_barrier();
      f32x4 d = {0.f, 0.f, 0.f, 0.f};
      for (int ks = 0; ks < 4; ++ks) { bf16x8 a = *(const bf16x8*)(sw + fr * 68 + 16 * ks + 4 * fq); d = __builtin_amdgcn_mfma_f32_16x16x32_bf16(a, cf[ks], d, 0, 0, 0); }
      for (int r = 0; r < 4; ++r) { const int t = sb + 4 * fq + r; const float u = b2f(ulb[t * 256 + g * 16 + fr]);
        rest[(size_t)(row0 + t) * NREST + RC_CV + g * 16 + fr] = f2b(d[r] + dsk * u); }
    }
  }
}

constexpr int MP = 72;
DEVI void mlstm_item(PRef p, int l, int b, int h, unsigned char* lds) { const int TX = opaque_tid(); unsigned char* const wsb = opq(p.ws);
  u16* Qs = (u16*)lds; u16* Ks = Qs + 64 * MP; u16* KTs = Ks + 64 * MP; u16* VTs = KTs + 64 * MP; u16* Cs = VTs + 80 * MP; u16* Ps = Cs + 80 * MP; u16* Os = Ps + 64 * MP;
  float* Hs = (float*)(Os + 64 * MP);
  float* sa = Hs + 64 * 65; float* sM = sa + 64; float* swi = sM + 64; float* sem = swi + 64; float* sden = sem + 64; float* swr = sden + 64; float* sdec = swr + 64; u16* VTw = (u16*)(sdec + 64);
  u16* rest = (u16*)(wsb + WS_REST); const float* gp = (const float*)(wsb + WS_GP);
  const int tid = TX, wave = tid >> 6, lane = tid & 63, fr = lane & 15, fq = lane >> 4;
  const float gbi = p.in[I_GATEB][l * 8 + h], gbf = p.in[I_GATEB][l * 8 + 4 + h];
  const int mt = wave >> 1, nh = wave & 1;
  __syncthreads();
  for (int i = tid; i < 80 * MP; i += 512) { Cs[i] = 0; int r = i / MP; VTs[i] = (r == 64) ? (u16)0x3F80 : (u16)0; }
  __syncthreads();
  f32x4 cst[3]; for (int i = 0; i < 3; ++i) cst[i] = (f32x4){0.f, 0.f, 0.f, 0.f};
  float m_prev = 0.f;
  const int lr = tid >> 3, c8 = (tid & 7) * 8;
  u32x4 qn = {0, 0, 0, 0}, kn = qn, vn = qn, on = qn; float gin = 0.f, gfn = 0.f;
  { int row0, len; chunk_rows(b, 0, row0, len);
    if (lr < len) { const u16* rp = rest + (size_t)(row0 + lr) * NREST + h * 64 + c8;
      qn = *(const u32x4*)(rp + RC_MQ); kn = *(const u32x4*)(rp + RC_MK); vn = *(const u32x4*)(rp + RC_MV); on = *(const u32x4*)(rp + RC_MO); }
    if (wave == 0 && lane < len) { const float* g8 = gp + (size_t)(row0 + lane) * 8; gin = g8[h]; gfn = g8[4 + h]; } }
  for (int c = 0; c < NCH; ++c) {
    int row0, len; chunk_rows(b, c, row0, len);
    const float gic = gin, gfc = gfn;
    { u32x4 q = qn, k = kn, v = vn, o = on;
      if (c + 1 < NCH) { int r1, l1; chunk_rows(b, c + 1, r1, l1); qn = (u32x4){0, 0, 0, 0}; kn = qn; vn = qn; on = qn;
        if (lr < l1) { const u16* rp = rest + (size_t)(r1 + lr) * NREST + h * 64 + c8;
          qn = *(const u32x4*)(rp + RC_MQ); kn = *(const u32x4*)(rp + RC_MK); vn = *(const u32x4*)(rp + RC_MV); on = *(const u32x4*)(rp + RC_MO); }
        if (wave == 0 && lane < l1) { const float* g8 = gp + (size_t)(r1 + lane) * 8; gin = g8[h]; gfn = g8[4 + h]; } }
      for (int j = 0; j < 4; ++j) k[j] = pack2(blo(k[j]) * 0.125f, bhi(k[j]) * 0.125f);
      *(u32x4*)(Qs + lr * MP + c8) = q; *(u32x4*)(Ks + lr * MP + c8) = k; *(u32x4*)(Os + lr * MP + c8) = o;
      for (int j = 0; j < 4; ++j) { KTs[(c8 + 2 * j) * MP + lr] = (u16)(k[j] & 0xffff); KTs[(c8 + 2 * j + 1) * MP + lr] = (u16)(k[j] >> 16);
        VTs[(c8 + 2 * j) * MP + lr] = (u16)(v[j] & 0xffff); VTs[(c8 + 2 * j + 1) * MP + lr] = (u16)(v[j] >> 16); } }
    if (wave == 0) {
      float ig = -INFINITY, lf = 0.f;
      if (lane < len) { ig = gic + gbi; float x = gfc + gbf; lf = fminf(x, 0.f) - __logf(1.f + __expf(-fabsf(x))); }
      float bc = lf; for (int o = 1; o < 64; o <<= 1) { float t = __shfl_up(bc, o); if (lane >= o) bc += t; }
      float a = ig - bc;
      float pm = a; for (int o = 1; o < 64; o <<= 1) { float t = __shfl_up(pm, o); if (lane >= o) pm = fmaxf(pm, t); }
      float M = fmaxf(m_prev, pm);
      float Mlast = __shfl(M, 63), blast = __shfl(bc, 63);
      sa[lane] = a; sM[lane] = M; swi[lane] = __expf(m_prev - M); sem[lane] = __expf(-(bc + M)); swr[lane] = __expf(a - Mlast);
      if (lane == 0) sdec[0] = __expf(m_prev - Mlast);
      m_prev = blast + Mlast;
    }
    __syncthreads();
    {
      for (int i = tid; i < 80 * 8; i += 512) { const int v = i >> 3, r8 = (i & 7) * 8; u32x4 x = *(const u32x4*)(VTs + v * MP + r8); u32x4 o;
        for (int j = 0; j < 4; ++j) o[j] = cvtpk(blo(x[j]) * swr[r8 + 2 * j], bhi(x[j]) * swr[r8 + 2 * j + 1]);
        *(u32x4*)(VTw + v * MP + r8) = o; } }
    for (int ni = 0; ni < 2; ++ni) { const int nt = nh * 2 + ni; f32x4 s = {0.f, 0.f, 0.f, 0.f};
      for (int ks = 0; ks < 2; ++ks) { bf16x8 a = *(const bf16x8*)(Qs + (mt * 16 + fr) * MP + 32 * ks + 8 * fq); bf16x8 bb = *(const bf16x8*)(Ks + (nt * 16 + fr) * MP + 32 * ks + 8 * fq);
        s = __builtin_amdgcn_mfma_f32_16x16x32_bf16(a, bb, s, 0, 0, 0); }
      const int r = nt * 16 + fr; const float ar = sa[r];
      for (int j = 0; j < 4; ++j) { const int srow = mt * 16 + 4 * fq + j; float w = (r <= srow) ? __expf(ar - sM[srow]) : 0.f; Ps[srow * MP + r] = f2b(s[j] * w); } }
    __syncthreads();
    f32x4 a1[3], a2[3]; const int ntl[3] = {nh * 2, nh * 2 + 1, 4}; const int ncnt = nh == 0 ? 3 : 2;
    for (int i = 0; i < 3; ++i) { a1[i] = (f32x4){0.f, 0.f, 0.f, 0.f}; a2[i] = a1[i]; }
    for (int ks = 0; ks < 2; ++ks) { bf16x8 pa = *(const bf16x8*)(Ps + (mt * 16 + fr) * MP + 32 * ks + 8 * fq); bf16x8 qa = *(const bf16x8*)(Qs + (mt * 16 + fr) * MP + 32 * ks + 8 * fq);
      for (int i = 0; i < 3; ++i) if (i < ncnt) { bf16x8 vb = *(const bf16x8*)(VTs + (ntl[i] * 16 + fr) * MP + 32 * ks + 8 * fq); bf16x8 cb = *(const bf16x8*)(Cs + (ntl[i] * 16 + fr) * MP + 32 * ks + 8 * fq);
        a1[i] = __builtin_amdgcn_mfma_f32_16x16x32_bf16(pa, vb, a1[i], 0, 0, 0); a2[i] = __builtin_amdgcn_mfma_f32_16x16x32_bf16(qa, cb, a2[i], 0, 0, 0); } }
    if (nh == 0 && fr == 0) for (int j = 0; j < 4; ++j) { const int srow = mt * 16 + 4 * fq + j; sden[srow] = a1[2][j] + swi[srow] * a2[2][j]; }
    __syncthreads();
    for (int i = 0; i < 2; ++i) for (int j = 0; j < 4; ++j) { const int srow = mt * 16 + 4 * fq + j, v = ntl[i] * 16 + fr;
      float num = a1[i][j] + swi[srow] * a2[i][j]; float hv = num * __builtin_amdgcn_rcpf(fmaxf(fabsf(sden[srow]), sem[srow]));
      hv *= sigm(b2f(Os[srow * MP + v])); Hs[srow * 65 + v] = hv; }
    { const float dec = sdec[0];
      const int tm[3] = {mt, mt, 4}, tn[3] = {nh * 2, nh * 2 + 1, wave}; const int tc = wave < 4 ? 3 : 2;
      for (int i = 0; i < 3; ++i) if (i < tc) { f32x4 acc = cst[i] * dec;
        for (int ks = 0; ks < 2; ++ks) { bf16x8 va = *(const bf16x8*)(VTw + (tm[i] * 16 + fr) * MP + 32 * ks + 8 * fq);
          bf16x8 kb = *(const bf16x8*)(KTs + (tn[i] * 16 + fr) * MP + 32 * ks + 8 * fq);
          acc = __builtin_amdgcn_mfma_f32_16x16x32_bf16(va, kb, acc, 0, 0, 0); }
        cst[i] = acc; } }
    __syncthreads();
    { const int tm[3] = {mt, mt, 4}, tn[3] = {nh * 2, nh * 2 + 1, wave}; const int tc = wave < 4 ? 3 : 2;
      for (int i = 0; i < 3; ++i) if (i < tc) for (int j = 0; j < 4; ++j) Cs[(tm[i] * 16 + 4 * fq + j) * MP + tn[i] * 16 + fr] = f2b(cst[i][j]); }
    { float hv[8]; float ss = 0.f; for (int j = 0; j < 8; ++j) { hv[j] = Hs[lr * 65 + c8 + j]; ss += hv[j] * hv[j]; }
      ss += __shfl_xor(ss, 1); ss += __shfl_xor(ss, 2); ss += __shfl_xor(ss, 4);
      const float r = rsqrtf(ss * (1.f / 64.f) + EPS); const float* ng = p.in[I_MNORM] + l * 256 + h * 64 + c8;
      if (lr < len && (c > 0 || b == 0)) { u32x4 o; for (int j = 0; j < 4; ++j) o[j] = pack2(hv[2 * j] * r * ng[2 * j], hv[2 * j + 1] * r * ng[2 * j + 1]);
        *(u32x4*)(rest + (size_t)(row0 + lr) * NREST + RC_CC + h * 64 + c8) = o; } }
  }
}

constexpr int MREC = 4160;
DEVI void mlstm_gates(PRef p, int l, int h, int row0, int len, int lane, const float* gp, float& a, float& bc) {
  const float gbi = p.in[I_GATEB][l * 8 + h], gbf = p.in[I_GATEB][l * 8 + 4 + h];
  float ig = -INFINITY, lf = 0.f;
  if (lane < len) { const float* g8 = gp + (size_t)(row0 + lane) * 8; ig = g8[h] + gbi; float x = g8[4 + h] + gbf; lf = fminf(x, 0.f) - __logf(1.f + __expf(-fabsf(x))); }
  bc = lf; for (int o = 1; o < 64; o <<= 1) { float t = __shfl_up(bc, o); if (lane >= o) bc += t; }
  a = ig - bc;
}
DEVI void mlstm_stepA(PRef p, int l, int b, int h, int c, unsigned char* lds) { const int TX = opaque_tid(); unsigned char* const wsb = opq(p.ws);
  u16* KTs = (u16*)lds; u16* VTs = KTs + 64 * MP; float* swr = (float*)(VTs + 80 * MP);
  const u16* rest = (const u16*)(wsb + WS_REST); const float* gp = (const float*)(wsb + WS_GP);
  u16* rec = (u16*)(wsb + WS_MSUM) + (size_t)((b * 4 + h) * NCH + c) * MREC; float* msc = (float*)(wsb + WS_MSC) + (size_t)((b * 4 + h) * NCH + c) * 4;
  const int tid = TX, wave = tid >> 6, lane = tid & 63, fr = lane & 15, fq = lane >> 4, mt = wave >> 1, nh = wave & 1;
  int row0, len; chunk_rows(b, c, row0, len);
  const int lr = tid >> 3, c8 = (tid & 7) * 8;
  __syncthreads();
  for (int i = tid; i < 16 * MP; i += 512) VTs[64 * MP + i] = (i < MP) ? (u16)0x3F80 : (u16)0;
  { u32x4 k = {0, 0, 0, 0}, v = k;
    if (lr < len) { const u16* rp = rest + (size_t)(row0 + lr) * NREST + h * 64 + c8; k = *(const u32x4*)(rp + RC_MK); v = *(const u32x4*)(rp + RC_MV); }
    for (int j = 0; j < 4; ++j) { const unsigned kk = pack2(blo(k[j]) * 0.125f, bhi(k[j]) * 0.125f);
      KTs[(c8 + 2 * j) * MP + lr] = (u16)(kk & 0xffff); KTs[(c8 + 2 * j + 1) * MP + lr] = (u16)(kk >> 16);
      VTs[(c8 + 2 * j) * MP + lr] = (u16)(v[j] & 0xffff); VTs[(c8 + 2 * j + 1) * MP + lr] = (u16)(v[j] >> 16); } }
  if (wave == 0) { float a, bc; mlstm_gates(p, l, h, row0, len, lane, gp, a, bc);
    float mx = a; for (int o = 32; o > 0; o >>= 1) mx = fmaxf(mx, __shfl_xor(mx, o));
    swr[lane] = expf(a - mx);
    if (lane == 0) msc[1] = mx;
    if (lane == 63) msc[0] = bc; }
  __syncthreads();
  const int tm[3] = {mt, mt, 4}, tn[3] = {nh * 2, nh * 2 + 1, wave}; const int tc = wave < 4 ? 3 : 2;
  for (int i = 0; i < 3; ++i) if (i < tc) { f32x4 acc = {0.f, 0.f, 0.f, 0.f};
    for (int ks = 0; ks < 2; ++ks) { bf16x8 va = *(const bf16x8*)(VTs + (tm[i] * 16 + fr) * MP + 32 * ks + 8 * fq);
      for (int j = 0; j < 8; ++j) va[j] = (short)f2b(b2f((u16)va[j]) * swr[32 * ks + 8 * fq + j]);
      bf16x8 kb = *(const bf16x8*)(KTs + (tn[i] * 16 + fr) * MP + 32 * ks + 8 * fq);
      acc = __builtin_amdgcn_mfma_f32_16x16x32_bf16(va, kb, acc, 0, 0, 0); }
    for (int j = 0; j < 4; ++j) { const int v = tm[i] * 16 + 4 * fq + j; if (v <= 64) rec[v * 64 + tn[i] * 16 + fr] = f2b(acc[j]); } }
}
DEVI void mlstm_scan(PRef p) { const int TX = opaque_tid(); unsigned char* const wsb = opq(p.ws);
  if (TX >= 64) return;
  const int lane = TX;
  for (int it = blockIdx.x; it < 256; it += gridDim.x) {
    const int bh = it >> 3, vs = it & 7;
    u16* base = (u16*)(wsb + WS_MSUM) + (size_t)bh * NCH * MREC; float* msc = (float*)(wsb + WS_MSC) + (size_t)bh * NCH * 4;
    const bool hasn = (vs == 0) && lane < 8;
    float st[8], sn[8]; for (int j = 0; j < 8; ++j) { st[j] = 0.f; sn[j] = 0.f; }
    float m_prev = 0.f;
    for (int c0 = 0; c0 < NCH; c0 += 5) {
      u32x4 d[5], dn[5]; float bl[5], ml[5];
      for (int i = 0; i < 5; ++i) { u16* r = base + (size_t)(c0 + i) * MREC; d[i] = *(const u32x4*)(r + vs * 512 + lane * 8);
        dn[i] = hasn ? *(const u32x4*)(r + 4096 + lane * 8) : (u32x4){0, 0, 0, 0}; bl[i] = msc[(c0 + i) * 4]; ml[i] = msc[(c0 + i) * 4 + 1]; }
      for (int i = 0; i < 5; ++i) { u16* r = base + (size_t)(c0 + i) * MREC;
        u32x4 o; for (int j = 0; j < 4; ++j) o[j] = pack2(st[2 * j], st[2 * j + 1]); *(u32x4*)(r + vs * 512 + lane * 8) = o;
        if (hasn) { u32x4 on; for (int j = 0; j < 4; ++j) on[j] = pack2(sn[2 * j], sn[2 * j + 1]); *(u32x4*)(r + 4096 + lane * 8) = on; }
        if (vs == 0 && lane == 0) msc[(c0 + i) * 4 + 2] = m_prev;
        const float Mx = fmaxf(m_prev, ml[i]), f1 = expf(m_prev - Mx), f2 = expf(ml[i] - Mx);
        for (int j = 0; j < 4; ++j) { st[2 * j] = f1 * st[2 * j] + f2 * blo(d[i][j]); st[2 * j + 1] = f1 * st[2 * j + 1] + f2 * bhi(d[i][j]);
          sn[2 * j] = f1 * sn[2 * j] + f2 * blo(dn[i][j]); sn[2 * j + 1] = f1 * sn[2 * j + 1] + f2 * bhi(dn[i][j]); }
        m_prev = bl[i] + Mx; }
    }
  }
}
DEVI void mlstm_stepC(PRef p, int l, int b, int h, int c, unsigned char* lds) { const int TX = opaque_tid(); unsigned char* const wsb = opq(p.ws);
  u16* Qs = (u16*)lds; u16* Ks = Qs + 64 * MP; u16* VTs = Ks + 64 * MP; u16* Cs = VTs + 80 * MP; u16* Ps = Cs + 80 * MP; u16* Os = Ps + 64 * MP;
  float* Hs = (float*)(Os + 64 * MP);
  float* sa = Hs + 64 * 65; float* sM = sa + 64; float* swi = sM + 64; float* sem = swi + 64; float* sden = sem + 64;
  u16* rest = (u16*)(wsb + WS_REST); const float* gp = (const float*)(wsb + WS_GP);
  const u16* rec = (const u16*)(wsb + WS_MSUM) + (size_t)((b * 4 + h) * NCH + c) * MREC; const float* msc = (const float*)(wsb + WS_MSC) + (size_t)((b * 4 + h) * NCH + c) * 4;
  const int tid = TX, wave = tid >> 6, lane = tid & 63, fr = lane & 15, fq = lane >> 4;
  const int mt = wave >> 1, nh = wave & 1;
  int row0, len; chunk_rows(b, c, row0, len);
  const int lr = tid >> 3, c8 = (tid & 7) * 8;
  __syncthreads();
  for (int i = tid; i < 16 * MP; i += 512) { VTs[64 * MP + i] = (i < MP) ? (u16)0x3F80 : (u16)0; if (i >= MP) Cs[64 * MP + i] = 0; }
  { u32x4 q = {0, 0, 0, 0}, k = q, v = q, o = q;
    if (lr < len) { const u16* rp = rest + (size_t)(row0 + lr) * NREST + h * 64 + c8;
      q = *(const u32x4*)(rp + RC_MQ); k = *(const u32x4*)(rp + RC_MK); v = *(const u32x4*)(rp + RC_MV); o = *(const u32x4*)(rp + RC_MO); }
    const u32x4 cin = *(const u32x4*)(rec + lr * 64 + c8);
    for (int j = 0; j < 4; ++j) k[j] = pack2(blo(k[j]) * 0.125f, bhi(k[j]) * 0.125f);
    *(u32x4*)(Qs + lr * MP + c8) = q; *(u32x4*)(Ks + lr * MP + c8) = k; *(u32x4*)(Os + lr * MP + c8) = o; *(u32x4*)(Cs + lr * MP + c8) = cin;
    if (tid < 8) *(u32x4*)(Cs + 64 * MP + tid * 8) = *(const u32x4*)(rec + 4096 + tid * 8);
    for (int j = 0; j < 4; ++j) { VTs[(c8 + 2 * j) * MP + lr] = (u16)(v[j] & 0xffff); VTs[(c8 + 2 * j + 1) * MP + lr] = (u16)(v[j] >> 16); } }
  if (wave == 0) { float a, bc; mlstm_gates(p, l, h, row0, len, lane, gp, a, bc);
    const float m_prev = msc[2];
    float pm = a; for (int o = 1; o < 64; o <<= 1) { float t = __shfl_up(pm, o); if (lane >= o) pm = fmaxf(pm, t); }
    const float M = fmaxf(m_prev, pm);
    sa[lane] = a; sM[lane] = M; swi[lane] = expf(m_prev - M); sem[lane] = expf(-(bc + M)); }
  __syncthreads();
  for (int ni = 0; ni < 2; ++ni) { const int nt = nh * 2 + ni; f32x4 s = {0.f, 0.f, 0.f, 0.f};
    for (int ks = 0; ks < 2; ++ks) { bf16x8 a = *(const bf16x8*)(Qs + (mt * 16 + fr) * MP + 32 * ks + 8 * fq); bf16x8 bb = *(const bf16x8*)(Ks + (nt * 16 + fr) * MP + 32 * ks + 8 * fq);
      s = __builtin_amdgcn_mfma_f32_16x16x32_bf16(a, bb, s, 0, 0, 0); }
    const int r = nt * 16 + fr; const float ar = sa[r];
    for (int j = 0; j < 4; ++j) { const int srow = mt * 16 + 4 * fq + j; float w = (r <= srow) ? expf(ar - sM[srow]) : 0.f; Ps[srow * MP + r] = f2b(s[j] * w); } }
  __syncthreads();
  f32x4 a1[3], a2[3]; const int ntl[3] = {nh * 2, nh * 2 + 1, 4}; const int ncnt = nh == 0 ? 3 : 2;
  for (int i = 0; i < 3; ++i) { a1[i] = (f32x4){0.f, 0.f, 0.f, 0.f}; a2[i] = a1[i]; }
  for (int ks = 0; ks < 2; ++ks) { bf16x8 pa = *(const bf16x8*)(Ps + (mt * 16 + fr) * MP + 32 * ks + 8 * fq); bf16x8 qa = *(const bf16x8*)(Qs + (mt * 16 + fr) * MP + 32 * ks + 8 * fq);
    for (int i = 0; i < 3; ++i) if (i < ncnt) { bf16x8 vb = *(const bf16x8*)(VTs + (ntl[i] * 16 + fr) * MP + 32 * ks + 8 * fq); bf16x8 cb = *(const bf16x8*)(Cs + (ntl[i] * 16 + fr) * MP + 32 * ks + 8 * fq);
      a1[i] = __builtin_amdgcn_mfma_f32_16x16x32_bf16(pa, vb, a1[i], 0, 0, 0); a2[i] = __builtin_amdgcn_mfma_f32_16x16x32_bf16(qa, cb, a2[i], 0, 0, 0); } }
  if (nh == 0 && fr == 0) for (int j = 0; j < 4; ++j) { const int srow = mt * 16 + 4 * fq + j; sden[srow] = a1[2][j] + swi[srow] * a2[2][j]; }
  __syncthreads();
  for (int i = 0; i < 2; ++i) for (int j = 0; j < 4; ++j) { const int srow = mt * 16 + 4 * fq + j, v = ntl[i] * 16 + fr;
    float num = a1[i][j] + swi[srow] * a2[i][j]; float hv = num / fmaxf(fabsf(sden[srow]), sem[srow]);
    hv *= sigm(b2f(Os[srow * MP + v])); Hs[srow * 65 + v] = hv; }
  __syncthreads();
  { float hv[8]; float ss = 0.f; for (int j = 0; j < 8; ++j) { hv[j] = Hs[lr * 65 + c8 + j]; ss += hv[j] * hv[j]; }
    ss += __shfl_xor(ss, 1); ss += __shfl_xor(ss, 2); ss += __shfl_xor(ss, 4);
    const float r = rsqrtf(ss * (1.f / 64.f) + EPS); const float* ng = p.in[I_MNORM] + l * 256 + h * 64 + c8;
    if (lr < len) { u32x4 o; for (int j = 0; j < 4; ++j) o[j] = pack2(hv[2 * j] * r * ng[2 * j], hv[2 * j + 1] * r * ng[2 * j + 1]);
      *(u32x4*)(rest + (size_t)(row0 + lr) * NREST + RC_CC + h * 64 + c8) = o; } }
}

constexpr int KP = 104, VP = 72;
DEVI void attn_item(PRef p, int b, int hh, int qb, bool meta, unsigned char* lds) { const int TX = opaque_tid(); unsigned char* const wsb = opq(p.ws);
  u16* Kl = (u16*)lds;
  u16* Vl = Kl + 2 * 64 * KP;
  const u16* Q = (const u16*)(wsb + WS_Q); const u16* KN = (const u16*)(wsb + WS_KN); const u16* KR = (const u16*)(wsb + WS_KR); const u16* VT = (const u16*)(wsb + WS_VT);
  u16* rest = (u16*)(wsb + WS_REST);
  const int tid = TX, wave = tid >> 6, lane = tid & 63, r31 = lane & 31, h2 = lane >> 5;
  const int ntile = meta ? 1 : 4 * qb + 5;
  const int mychunk = meta ? (wave == 0 ? 0 : -1) : 4 * qb + 1 + (wave >> 1);
  const int qrow = meta ? METAROW + r31 : b * SEQ + qb * 256 + wave * 32 + r31;
  bf16x8 qf[6];
  for (int ks = 0; ks < 6; ++ks) qf[ks] = *(const bf16x8*)(Q + (size_t)qrow * 768 + hh * 96 + 16 * ks + 8 * h2);
  f32x16 o0, o1; for (int i = 0; i < 16; ++i) { o0[i] = 0.f; o1[i] = 0.f; }
  float mrun = 0.f, lsum = 0.f;
  f32x16 cinit; for (int i = 0; i < 16; ++i) cinit[i] = 0.f;
  u32x4 kreg0, kreg1, vreg;
  auto gload = [&](int j) {
    const int krow0 = j == 0 ? METAROW : b * SEQ + (j - 1) * 64;
    { int i = tid; int r = i / 12, c = i % 12; kreg0 = c < 8 ? *(const u32x4*)(KN + (size_t)(krow0 + r) * 512 + hh * 64 + c * 8) : *(const u32x4*)(KR + (size_t)(krow0 + r) * 32 + (c - 8) * 8); }
    if (tid < 256) { int i = tid + 512; int r = i / 12, c = i % 12; kreg1 = c < 8 ? *(const u32x4*)(KN + (size_t)(krow0 + r) * 512 + hh * 64 + c * 8) : *(const u32x4*)(KR + (size_t)(krow0 + r) * 32 + (c - 8) * 8); }
    { int v = tid >> 3, c = tid & 7; vreg = *(const u32x4*)(VT + (size_t)(hh * 64 + v) * MROWS + krow0 + c * 8); }
  };
  auto lstore = [&](int buf) {
    u16* kl = Kl + buf * 64 * KP; u16* vl = Vl + buf * 64 * VP;
    { int i = tid; int r = i / 12, c = i % 12; *(u32x4*)(kl + r * KP + c * 8) = kreg0; }
    if (tid < 256) { int i = tid + 512; int r = i / 12, c = i % 12; *(u32x4*)(kl + r * KP + c * 8) = kreg1; }
    { int v = tid >> 3, c = tid & 7; *(u32x4*)(vl + v * VP + c * 8) = vreg; }
  };
  __syncthreads();
  gload(0); lstore(0);
  for (int j = 0; j < ntile; ++j) {
    __syncthreads();
    if (j + 1 < ntile) gload(j + 1);
    if (j <= mychunk) {
      const u16* kl = Kl + (j & 1) * 64 * KP; const u16* vl = Vl + (j & 1) * 64 * VP;
      f32x16 s0, s1;
#pragma unroll
      for (int ks = 0; ks < 6; ++ks) {
        bf16x8 k0 = *(const bf16x8*)(kl + r31 * KP + 16 * ks + 8 * h2); bf16x8 k1 = *(const bf16x8*)(kl + (32 + r31) * KP + 16 * ks + 8 * h2);
        s0 = __builtin_amdgcn_mfma_f32_32x32x16_bf16(k0, qf[ks], ks == 0 ? cinit : s0, 0, 0, 0); s1 = __builtin_amdgcn_mfma_f32_32x32x16_bf16(k1, qf[ks], ks == 0 ? cinit : s1, 0, 0, 0);
      }
      if (j == 0) { for (int i = 8; i < 16; ++i) s0[i] = -INFINITY; for (int i = 0; i < 16; ++i) s1[i] = -INFINITY; }
      float mx = s0[0]; for (int i = 1; i < 16; ++i) mx = fmaxf(mx, s0[i]); for (int i = 0; i < 16; ++i) mx = fmaxf(mx, s1[i]);
      mx = fmaxf(mx, __shfl_xor(mx, 32));
      const float d = (j == 0) ? mx : fmaxf(mx, 0.f);
      float ps = 0.f;
      if (j == 0 || __any(d > 8.f)) {
        const float alpha = (j == 0) ? 1.f : __builtin_amdgcn_exp2f(-d);
        for (int i = 0; i < 16; ++i) { s0[i] = __builtin_amdgcn_exp2f(s0[i] - d); ps += s0[i]; s1[i] = __builtin_amdgcn_exp2f(s1[i] - d); ps += s1[i]; }
        lsum = lsum * alpha + ps;
        for (int i = 0; i < 16; ++i) { o0[i] *= alpha; o1[i] *= alpha; }
        mrun = (j == 0) ? d : mrun + d;
        for (int i = 0; i < 16; ++i) cinit[i] = -mrun;
      } else {
        for (int i = 0; i < 16; ++i) { s0[i] = __builtin_amdgcn_exp2f(s0[i]); ps += s0[i]; s1[i] = __builtin_amdgcn_exp2f(s1[i]); ps += s1[i]; }
        lsum += ps;
      }
      for (int kt = 0; kt < 2; ++kt) for (int s = 0; s < 2; ++s) {
        u32x4 pp; for (int jj = 0; jj < 4; ++jj) pp[jj] = kt == 0 ? cvtpk(s0[8 * s + 2 * jj], s0[8 * s + 2 * jj + 1]) : cvtpk(s1[8 * s + 2 * jj], s1[8 * s + 2 * jj + 1]);
        bf16x8 pb = __builtin_bit_cast(bf16x8, pp);
        const int key0 = 32 * kt + 16 * s + 8 * h2;
        const bf16x8 va = *(const bf16x8*)(vl + r31 * VP + key0), vc = *(const bf16x8*)(vl + (32 + r31) * VP + key0);
        o0 = __builtin_amdgcn_mfma_f32_32x32x16_bf16(va, pb, o0, 0, 0, 0);
        o1 = __builtin_amdgcn_mfma_f32_32x32x16_bf16(vc, pb, o1, 0, 0, 0);
      }
    }
    if (j + 1 < ntile) lstore((j + 1) & 1);
  }
  if (mychunk >= 0) {
    lsum += __shfl_xor(lsum, 32);
    const float inv = __builtin_amdgcn_rcpf(lsum);
    u16* orow = rest + (size_t)qrow * NREST + RC_CQ + hh * 64;
    for (int g = 0; g < 4; ++g) { const int v0 = 8 * g + 4 * h2;
      u32x2 w0; w0[0] = cvtpk(o0[4 * g] * inv, o0[4 * g + 1] * inv); w0[1] = cvtpk(o0[4 * g + 2] * inv, o0[4 * g + 3] * inv); *(u32x2*)(orow + v0) = w0;
      u32x2 w1; w1[0] = cvtpk(o1[4 * g] * inv, o1[4 * g + 1] * inv); w1[1] = cvtpk(o1[4 * g + 2] * inv, o1[4 * g + 3] * inv); *(u32x2*)(orow + 32 + v0) = w1; }
  }
}

template <class Epi>
DEVI void thin_gemm(unsigned char* lds, const Gemm g, int nN, const Epi& E, int wg0 = 0) { const int TX = opaque_tid();
  const int wid = __builtin_amdgcn_readfirstlane(TX >> 6), lane = TX & 63, fr = lane & 15, fq = lane >> 4;
  int K = g.K; asm volatile("" : "+s"(K));
  f32x4* P = (f32x4*)lds;
  for (int un = (int)((blockIdx.x + gridDim.x - wg0) % gridDim.x); un < nN * 4; un += gridDim.x) {
    const int pn = un >> 2, wc = un & 3;
    f32x4 pacc[4];
#pragma unroll
    for (int t = 0; t < 4; ++t) pacc[t] = (f32x4){0.f, 0.f, 0.f, 0.f};
    const u16* ap = g.A + (size_t)(METAROW + fr) * g.lda + fq * 8;
    const u16* bp = g.Bt + (size_t)(pn * 256 + wc * 32) * g.ldb + fq * 8;
    const unsigned o0 = (unsigned)(perm32(fr) * g.ldb), o1 = (unsigned)(perm32(16 + fr) * g.ldb);
#pragma unroll 4
    for (int k = wid * 32; k < K; k += 256) {
      const bf16x8 a = *(const bf16x8*)(ap + k);
      bf16x8 bv[4];
#pragma unroll
      for (int t = 0; t < 4; ++t) { const int bj = t >> 1, n = t & 1; bv[t] = *(const bf16x8*)(bp + (size_t)(bj * 128) * g.ldb + (n ? o1 : o0) + k); }
#pragma unroll
      for (int t = 0; t < 4; ++t) pacc[t] = __builtin_amdgcn_mfma_f32_16x16x32_bf16(bv[t], a, pacc[t], 0, 0, 0);
    }
    __syncthreads();
#pragma unroll
    for (int t = 0; t < 4; ++t) P[(wid * 4 + t) * 64 + lane] = pacc[t];
    __syncthreads();
    if (wid == 0) {
      f32x4 acc[2][2][4][2];
#pragma unroll
      for (int bj = 0; bj < 2; ++bj)
#pragma unroll
        for (int n = 0; n < 2; ++n) { f32x4 sum = {0.f, 0.f, 0.f, 0.f};
#pragma unroll
          for (int w = 0; w < 8; ++w) sum += P[(w * 4 + bj * 2 + n) * 64 + lane];
          acc[0][bj][0][n] = sum; }
      Unit u; u.pm = 128; u.pn = pn;
      E.template run<true>(acc, u, 0, wc, fr, fq);
    }
    __syncthreads();
  }
}
#define LDS3 ((LAS unsigned char*)lds)
constexpr size_t WS_SSQ = WS_GP + (size_t)MROWS * 8 * 4;
struct EpiIn {
  const float* rs; u8* gates; u16* rest; float* gp; float* ssq;
  DEVI void operator()(AccRef acc, const Unit& u, int wr, int wc, int fr, int fq) const { run<false>(acc, u, wr, wc, fr, fq); }
  template <bool THIN> DEVI void run(AccRef acc, const Unit& u, int wr, int wc, int fr, int fq) const {
    const int pn = u.pn;
    float rsv[2][4];
    EPI_ROWS({ rsv[ai][m] = rs[row]; })
    EPI_ROWS({ const float r = rsv[ai][m];
      _Pragma("unroll") for (int bj = 0; bj < 2; ++bj) { const int col0 = pn * 256 + bj * 128 + wc * 32 + 8 * fq;
        float x[8]; _Pragma("unroll") for (int e = 0; e < 4; ++e) { x[e] = acc[ai][bj][m][0][e] * r; x[4 + e] = acc[ai][bj][m][1][e] * r; }
        if (pn < 16) { unsigned b[8]; _Pragma("unroll") for (int e = 0; e < 8; ++e) b[e] = (unsigned)(sigm(x[e]) * 255.f + 0.5f);
          u32x2 o; o[0] = b[0] | (b[1] << 8) | (b[2] << 16) | (b[3] << 24); o[1] = b[4] | (b[5] << 8) | (b[6] << 16) | (b[7] << 24);
          *(u32x2*)(gates + (size_t)row * 4096 + col0) = o; }
        else { const int rc = col0 - 4096; u32x4 o; _Pragma("unroll") for (int e = 0; e < 4; ++e) o[e] = cvtpk_e(x[2 * e], x[2 * e + 1]);
          *(u32x4*)(rest + (size_t)row * NREST + rc) = o;
          if (rc == RC_MI) { *(f32x4*)(gp + (size_t)row * 8) = (f32x4){x[0], x[1], x[2], x[3]}; *(f32x4*)(gp + (size_t)row * 8 + 4) = (f32x4){x[4], x[5], x[6], x[7]}; }
          const int slot = pn == 24 ? bj : (pn == 25 ? (bj == 0 ? 2 : 3) : (pn == 26 && bj == 0 ? 4 : -1));
          if (slot >= 0) { float ss = 0.f; _Pragma("unroll") for (int e = 0; e < 8; ++e) ss += x[e] * x[e];
            ss += __shfl_xor(ss, 16); ss += __shfl_xor(ss, 32);
            if (fq == 0) ssq[(size_t)row * 20 + slot * 4 + wc] = ss; } } } })
  }
};
struct EpiQ {
  const float* ssq; const float* rope; u16* Q;
  DEVI void operator()(AccRef acc, const Unit& u, int wr, int wc, int fr, int fq) const { run<false>(acc, u, wr, wc, fr, fq); }
  template <bool THIN> DEVI void run(AccRef acc, const Unit& u, int wr, int wc, int fr, int fq) const {
    const float QS = 0.10206207261596577f * 1.4426950408889634f;
    constexpr int NA = THIN ? 1 : 2, NMM = THIN ? 1 : 4;
#pragma unroll
    for (int ai = 0; ai < NA; ++ai) {
      float ssv[NMM];
#pragma unroll
      for (int m = 0; m < NMM; ++m) { const int row = u.pm * 256 + ai * 128 + wr * 64 + m * 16 + fr; const float* sp = ssq + (size_t)row * 20;
        const f32x4 s0 = *(const f32x4*)sp, s1 = *(const f32x4*)(sp + 4), s2 = *(const f32x4*)(sp + 8);
        ssv[m] = (s0[0] + s0[1] + s0[2] + s0[3]) + (s1[0] + s1[1] + s1[2] + s1[3]) + (s2[0] + s2[1] + s2[2] + s2[3]); }
#pragma unroll
      for (int m = 0; m < NMM; ++m) { const int row = u.pm * 256 + ai * 128 + wr * 64 + m * 16 + fr;
        const float sc = rsqrtf(ssv[m] * (1.f / 384.f) + EPS) * QS; const int pos = row_pos(row);
#pragma unroll
        for (int bj = 0; bj < 2; ++bj) { const int cb = u.pn * 256 + bj * 128 + wc * 32, col0 = cb + 8 * fq;
          float x[8];
#pragma unroll
          for (int e = 0; e < 4; ++e) { x[e] = acc[ai][bj][m][0][e] * sc; x[4 + e] = acc[ai][bj][m][1][e] * sc; }
          if ((cb % 96) == 64) {
#pragma unroll
            for (int e = 0; e < 8; ++e) { const float other = __shfl_xor(x[e], 32); const int i = 8 * (fq & 1) + e;
              const float c = rope[(pos * 16 + i) * 2], s = rope[(pos * 16 + i) * 2 + 1];
              x[e] = fq < 2 ? x[e] * c - other * s : x[e] * c + other * s; } }
          u32x4 o;
#pragma unroll
          for (int e = 0; e < 4; ++e) o[e] = cvtpk_e(x[2 * e], x[2 * e + 1]);
          *(u32x4*)(Q + (size_t)row * 768 + col0) = o; }
        __builtin_amdgcn_sched_barrier(0); }
    }
  }
};
struct EpiKV {
  const float* ssq; u16* KN; u16* VT;
  DEVI void operator()(AccRef acc, const Unit& u, int wr, int wc, int fr, int fq) const { run<false>(acc, u, wr, wc, fr, fq); }
  template <bool THIN> DEVI void run(AccRef acc, const Unit& u, int wr, int wc, int fr, int fq) const {
    constexpr int NA = THIN ? 1 : 2, NMM = THIN ? 1 : 4;
#pragma unroll
    for (int ai = 0; ai < NA; ++ai) {
      float ssv[NMM];
#pragma unroll
      for (int m = 0; m < NMM; ++m) { const int row = u.pm * 256 + ai * 128 + wr * 64 + m * 16 + fr; const float* sp = ssq + (size_t)row * 20 + 12;
        const f32x4 s0 = *(const f32x4*)sp, s1 = *(const f32x4*)(sp + 4);
        ssv[m] = (s0[0] + s0[1] + s0[2] + s0[3]) + (s1[0] + s1[1] + s1[2] + s1[3]); }
#pragma unroll
      for (int m = 0; m < NMM; ++m) { const int row = u.pm * 256 + ai * 128 + wr * 64 + m * 16 + fr;
        const float sc = rsqrtf(ssv[m] * (1.f / 256.f) + EPS);
#pragma unroll
        for (int bj = 0; bj < 2; ++bj) { const int col0 = u.pn * 256 + bj * 128 + wc * 32 + 8 * fq, hd = col0 >> 7, d0 = col0 & 127;
          float x[8];
#pragma unroll
          for (int e = 0; e < 4; ++e) { x[e] = acc[ai][bj][m][0][e] * sc; x[4 + e] = acc[ai][bj][m][1][e] * sc; }
          if (d0 < 64) { u32x4 o;
#pragma unroll
            for (int e = 0; e < 4; ++e) o[e] = cvtpk_e(x[2 * e], x[2 * e + 1]);
            *(u32x4*)(KN + (size_t)row * 512 + hd * 64 + d0) = o; }
          else {
#pragma unroll
            for (int e = 0; e < 8; ++e) VT[(size_t)(hd * 64 + d0 - 64 + e) * MROWS + ((row & ~12) | ((row & 4) << 1) | ((row & 8) >> 1))] = (u16)cvtpk_e(x[e], x[e]); } }
        __builtin_amdgcn_sched_barrier(0); }
    }
  }
};
struct EpiGlu {
  u16* rest;
  DEVI void operator()(AccRef acc, const Unit& u, int wr, int wc, int fr, int fq) const { run<false>(acc, u, wr, wc, fr, fq); }
  template <bool THIN> DEVI void run(AccRef acc, const Unit& u, int wr, int wc, int fr, int fq) const {
    EPI_ROWS({ float x[8]; _Pragma("unroll") for (int e = 0; e < 4; ++e) { x[e] = acc[ai][0][m][0][e] * sigm(acc[ai][1][m][0][e]); x[4 + e] = acc[ai][0][m][1][e] * sigm(acc[ai][1][m][1][e]); }
      u32x4 o; _Pragma("unroll") for (int e = 0; e < 4; ++e) o[e] = cvtpk_e(x[2 * e], x[2 * e + 1]);
      *(u32x4*)(rest + (size_t)row * NREST + RC_SU + u.pn * 128 + wc * 32 + 8 * fq) = o; })
  }
};
struct EpiMerge {
  const u8* gates; u16* mg; int bi;
  DEVI void operator()(AccRef acc, const Unit& u, int wr, int wc, int fr, int fq) const { run<false>(acc, u, wr, wc, fr, fq); }
  template <bool THIN> DEVI void run(AccRef acc, const Unit& u, int wr, int wc, int fr, int fq) const {
    constexpr int NA = THIN ? 1 : 2, NMM = THIN ? 1 : 4;
    u32x2 gb[NA][NMM][2];
#pragma unroll
    for (int ai = 0; ai < NA; ++ai)
#pragma unroll
      for (int m = 0; m < NMM; ++m)
#pragma unroll
        for (int bj = 0; bj < 2; ++bj) { const int row = u.pm * 256 + ai * 128 + wr * 64 + m * 16 + fr, col0 = u.pn * 256 + bj * 128 + wc * 32 + 8 * fq;
          gb[ai][m][bj] = *(const u32x2*)(gates + (size_t)row * 4096 + bi * 1024 + col0); }
#pragma unroll
    for (int ai = 0; ai < NA; ++ai) {
      u32x4 old[NMM][2];
#pragma unroll
      for (int m = 0; m < NMM; ++m)
#pragma unroll
        for (int bj = 0; bj < 2; ++bj) { const int row = u.pm * 256 + ai * 128 + wr * 64 + m * 16 + fr, col0 = u.pn * 256 + bj * 128 + wc * 32 + 8 * fq;
          old[m][bj] = bi ? *(const u32x4*)(mg + (size_t)row * 1024 + col0) : (u32x4){0, 0, 0, 0}; }
#pragma unroll
      for (int m = 0; m < NMM; ++m)
#pragma unroll
        for (int bj = 0; bj < 2; ++bj) { const int row = u.pm * 256 + ai * 128 + wr * 64 + m * 16 + fr, col0 = u.pn * 256 + bj * 128 + wc * 32 + 8 * fq;
          float x[8];
#pragma unroll
          for (int e = 0; e < 8; ++e) { const float g = (float)((gb[ai][m][bj][e >> 2] >> (8 * (e & 3))) & 255u) * (1.f / 255.f); x[e] = g * (e < 4 ? acc[ai][bj][m][0][e] : acc[ai][bj][m][1][e - 4]); }
#pragma unroll
          for (int e = 0; e < 4; ++e) { x[2 * e] += blo(old[m][bj][e]); x[2 * e + 1] += bhi(old[m][bj][e]); }
          u32x4 o;
#pragma unroll
          for (int e = 0; e < 4; ++e) o[e] = cvtpk_e(x[2 * e], x[2 * e + 1]);
          *(u32x4*)(mg + (size_t)row * 1024 + col0) = o; }
    }
  }
};
template <int MODE> struct EpiPlain {
  const float* rs; u16* out; int ldo;
  DEVI void operator()(AccRef acc, const Unit& u, int wr, int wc, int fr, int fq) const { run<false>(acc, u, wr, wc, fr, fq); }
  template <bool THIN> DEVI void run(AccRef acc, const Unit& u, int wr, int wc, int fr, int fq) const {
    float rsv[2][4];
    EPI_ROWS({ rsv[ai][m] = MODE == 1 ? rs[row] : 1.f; })
    EPI_ROWS({ const float r = rsv[ai][m];
      _Pragma("unroll") for (int bj = 0; bj < 2; ++bj) { const int col0 = u.pn * 256 + bj * 128 + wc * 32 + 8 * fq;
        float x[8]; _Pragma("unroll") for (int e = 0; e < 4; ++e) { x[e] = acc[ai][bj][m][0][e]; x[4 + e] = acc[ai][bj][m][1][e]; }
        if (MODE == 1) { _Pragma("unroll") for (int e = 0; e < 8; ++e) { float t = fmaxf(x[e] * r, 0.f); x[e] = t * t; } }
        u32x4 o; _Pragma("unroll") for (int e = 0; e < 4; ++e) o[e] = cvtpk_e(x[2 * e], x[2 * e + 1]);
        *(u32x4*)(out + (size_t)row * ldo + col0) = o; } })
  }
};
DEVI void phase_inproj(PRef p, unsigned char* lds) { unsigned char* const wsb = opq(p.ws);
  Gemm g{(const u16*)(wsb + WS_HB), (const u16*)(wsb + WS_W + W_IN), 1024, 1024, 1024};
  StaticOrder S; S.init(129, NIN / 256, gridDim.x, blockIdx.x);
  EpiIn E{(const float*)(wsb + WS_RS), wsb + WS_GATES, (u16*)(wsb + WS_REST), (float*)(wsb + WS_GP), (float*)(wsb + WS_SSQ)};
  gemm_phase(LDS3, g, S, E);
}
DEVI void phase_upq(PRef p, unsigned char* lds) { unsigned char* const wsb = opq(p.ws);
  Gemm g{(const u16*)(wsb + WS_REST) + RC_CQ, (const u16*)(wsb + WS_W + W_UQ), NREST, 384, 384};
  StaticOrder S; S.init(129, 3, gridDim.x, blockIdx.x);
  EpiQ E{(const float*)(wsb + WS_SSQ), (const float*)(wsb + WS_ROPE), (u16*)(wsb + WS_Q)};
  gemm_phase(LDS3, g, S, E);
}
DEVI void phase_upkv(PRef p, unsigned char* lds) { unsigned char* const wsb = opq(p.ws);
  Gemm g{(const u16*)(wsb + WS_REST) + RC_CKV, (const u16*)(wsb + WS_W + W_UKV), NREST, 256, 256};
  StaticOrder S; S.init(128, 4, gridDim.x, blockIdx.x);
  EpiKV E{(const float*)(wsb + WS_SSQ), (u16*)(wsb + WS_KN), (u16*)(wsb + WS_VT)};
  thin_gemm(lds, g, S.nN, E);
  gemm_phase(LDS3, g, S, E);
}
DEVI void phase_glu(PRef p, unsigned char* lds, bool meta) { unsigned char* const wsb = opq(p.ws);
  Gemm g{(const u16*)(wsb + WS_REST) + RC_CV, (const u16*)(wsb + WS_W + W_GLU), NREST, 256, 256};
  StaticOrder S; S.init(128, 2, gridDim.x, blockIdx.x);
  EpiGlu E{(u16*)(wsb + WS_REST)};
  if (meta) thin_gemm(lds, g, S.nN, E);
  gemm_phase(LDS3, g, S, E);
}
DEVI void phase_merge(PRef p, unsigned char* lds, bool meta) { unsigned char* const wsb = opq(p.ws);
  const u16* rest = (const u16*)(wsb + WS_REST); const u16* Bt = (const u16*)(wsb + WS_W + W_BR);
  const int aoff[4] = {RC_CB, RC_CC, RC_SU, RC_CQ}; const int koff[4] = {0, 256, 512, 768}; const int kk[4] = {256, 256, 256, 512};
  StaticOrder S; S.init(128, 4, gridDim.x, blockIdx.x);
  for (int bi = 0; bi < 4; ++bi) {
    Gemm g{rest + aoff[bi], Bt + koff[bi], NREST, 1280, kk[bi]};
    EpiMerge E{wsb + WS_GATES, (u16*)(wsb + WS_MERGED), bi};
    if (meta) thin_gemm(lds, g, S.nN, E);
  gemm_phase(LDS3, g, S, E);
  }
}
template <int MODE> DEVI void phase_gemm_plain(PRef p, unsigned char* lds, const u16* A, int lda, const u16* Bt, int K, int N, u16* out, int ldo, bool meta) { unsigned char* const wsb = opq(p.ws);
  Gemm g{A, Bt, lda, K, K};
  StaticOrder S; S.init(128, N / 256, gridDim.x, blockIdx.x);
  EpiPlain<MODE> E{(const float*)(wsb + WS_RS), out, ldo};
  if (meta) thin_gemm(lds, g, S.nN, E);
  gemm_phase(LDS3, g, S, E);
}

#define XB_TMO      128
#define XB_XCNT(j)  (256  + 64 * (j))
#define XB_XSUB(j)  (1280 + 64 * (j))
#define XB_XGEN(j)  (2304 + 64 * (j))
#define XB_TOP      3328
#define XB_TOPGEN   3392
#define XCD_BAR_WORDS 3456
#define XB_SPIN_CAP (1u << 18)
DEVI unsigned xb_ld(unsigned* p) { return __hip_atomic_load(p, __ATOMIC_RELAXED, __HIP_MEMORY_SCOPE_AGENT); }
DEVI unsigned xb_add(unsigned* p, unsigned v) { return __hip_atomic_fetch_add(p, v, __ATOMIC_RELAXED, __HIP_MEMORY_SCOPE_AGENT); }
DEVI unsigned xb_xcc_id() { return (unsigned)__builtin_amdgcn_s_getreg((3 << 11) | 20) & 0xFu; }
#define XB_SPIN(cond, bar) do { unsigned _sp = 0; while (cond) { __builtin_amdgcn_s_sleep(1); \
    if ((++_sp & 255u) == 0u) { if (xb_ld(&(bar)[XB_TMO])) break; if (_sp > XB_SPIN_CAP) { atomicAdd(&(bar)[XB_TMO], 1u); break; } } } } while (0)
struct XcdBarrier { unsigned* bar; unsigned x; volatile __attribute__((address_space(3))) unsigned* st; };
DEVI XcdBarrier xcd_barrier_post(unsigned* bar, volatile __attribute__((address_space(3))) unsigned* st) {
  XcdBarrier b; b.bar = bar; b.x = xb_xcc_id(); b.st = st;
  if (threadIdx.x == 0) (void)xb_add(&bar[XB_XCNT(b.x)], 1u);
  return b;
}
DEVI void xcd_barrier_complete(unsigned* bar, unsigned x, unsigned& nloc, unsigned& nx) {
  const unsigned G = gridDim.x * gridDim.y * gridDim.z;
  unsigned sum, cnt, mine, sp = 0u;
  for (;;) {
    sum = 0u; cnt = 0u; mine = 0u;
#pragma unroll
    for (unsigned j = 0; j < 16; ++j) { const unsigned c = xb_ld(&bar[XB_XCNT(j)]); sum += c; cnt += (c > 0u) ? 1u : 0u; mine = (j == x) ? c : mine; }
    if (sum == G) break;
    __builtin_amdgcn_s_sleep(1);
    if ((++sp & 255u) == 0u) { if (xb_ld(&bar[XB_TMO])) break; if (sp > XB_SPIN_CAP) { atomicAdd(&bar[XB_TMO], 1u); break; } }
  }
  nloc = mine > 0u ? mine : 1u; nx = cnt > 0u ? cnt : 1u;
}
__device__ __attribute__((noinline)) void xcd_barrier(const XcdBarrier b) {
  asm volatile("s_waitcnt vmcnt(0)" ::: "memory");
  __syncthreads();
  if (threadIdx.x == 0) {
    unsigned* bar = b.bar;
    __builtin_amdgcn_s_waitcnt(0);
    unsigned nloc = b.st[0], nx = b.st[1];
    if (nloc == 0u) { xcd_barrier_complete(bar, b.x, nloc, nx); b.st[0] = nloc; b.st[1] = nx; }
    const unsigned old = xb_add(&bar[XB_XSUB(b.x)], 1u);
    const unsigned gen = old / nloc;
    if (old + 1u == (gen + 1u) * nloc) {
      __builtin_amdgcn_fence(__ATOMIC_RELEASE, "agent");
      asm volatile("s_waitcnt vmcnt(0)" ::: "memory");
      const unsigned og = xb_add(&bar[XB_TOP], 1u);
      const unsigned tg = og / nx;
      if (og + 1u == (tg + 1u) * nx) xb_add(&bar[XB_TOPGEN], 1u);
      else XB_SPIN(xb_ld(&bar[XB_TOPGEN]) == tg, bar);
      __builtin_amdgcn_fence(__ATOMIC_ACQUIRE, "agent");
      xb_add(&bar[XB_XGEN(b.x)], 1u);
      asm volatile("s_waitcnt vmcnt(0)" ::: "memory");
    } else {
      XB_SPIN(xb_ld(&bar[XB_XGEN(b.x)]) == gen, bar);
      __builtin_amdgcn_fence(__ATOMIC_ACQUIRE, "agent");
      asm volatile("s_waitcnt vmcnt(0)" ::: "memory");
    }
  }
  __syncthreads();
}

#ifndef PHM
#define PHM 0xFFFF
#endif
__global__ void __launch_bounds__(512, 2) mega(Params p_unused) {
#define p (*kparams())
  extern __shared__ __attribute__((aligned(16))) unsigned char lds[];
  cg::grid_group grid = cg::this_grid();
  unsigned* ctl = (unsigned*)(p.ws + WS_CTL);
  __shared__ uint4 s_misc;
  if (threadIdx.x == 0) s_misc = make_uint4(0u, 0u, 0u, 0u);
  __syncthreads();
  XcdBarrier xbar = xcd_barrier_post(ctl, (volatile __attribute__((address_space(3))) unsigned*)&s_misc);
  u16* W = (u16*)(p.ws + WS_W);
  if (PHM & 1) { prep_layer(p, 0, (float*)lds);
  phase0_act(p); }
  if (p.ws == nullptr) grid.sync();
  xcd_barrier(xbar);
  for (int l = 0; l < 2; ++l) {
    if (PHM & 2) phase_inproj(p, lds);
    xcd_barrier(xbar);
    if (PHM & 4) { phase_upq(p, lds);
    phase_upkv(p, lds); }
    if (PHM & 8) phase_conv(p, l);
    if (PHM & 16) s5_passA(p, l, lds);
    xcd_barrier(xbar);
    if (blockIdx.x < 32) mlstm_item(p, l, blockIdx.x >> 2, blockIdx.x & 3, lds);
    else if (blockIdx.x < 48) {
      s5_scan(p, l, 32);
      __threadfence(); __syncthreads();
      if (threadIdx.x == 0) __hip_atomic_fetch_add(ctl + 24 + l, 1u, __ATOMIC_RELEASE, __HIP_MEMORY_SCOPE_AGENT);
    }
    for (;;) {
      __syncthreads();
      if (threadIdx.x == 0) s_misc.z = atomicAdd(ctl + 16 + l, 1u);
      __syncthreads();
      int it = (int)s_misc.z;
      if (it >= 1032 + 513) break;
      if (it < 1024) { const int qb = 15 - it / 64, bh = it % 64; attn_item(p, bh >> 3, bh & 7, qb, false, lds); }
      else if (it < 1032) attn_item(p, 0, it - 1024, 0, true, lds);
      else { const int k = it - 1032;
        if (threadIdx.x == 0) { unsigned spins = 0; while (__hip_atomic_load(ctl + 24 + l, __ATOMIC_RELAXED, __HIP_MEMORY_SCOPE_AGENT) < 16u && ++spins < (1u << 22)) __builtin_amdgcn_s_sleep(2); }
        __syncthreads(); __builtin_amdgcn_fence(__ATOMIC_ACQUIRE, "agent");
        if (k == 0) s5_passB_item(p, l, 0, 0, lds); else s5_passB_item(p, l, (k - 1) >> 6, 1 + ((k - 1) & 63), lds); }
    }
    xcd_barrier(xbar);
    const bool meta_live = (l == 0);
    if (PHM & 256) phase_glu(p, lds, meta_live);
    xcd_barrier(xbar);
    if (PHM & 512) phase_merge(p, lds, meta_live);
    xcd_barrier(xbar);
    if (PHM & 1024) phase_gemm_plain<0>(p, lds, (const u16*)(p.ws + WS_MERGED), 1024, W + W_OUT / 2, 1024, 1024, (u16*)(p.ws + WS_YOUT), 1024, meta_live);
    xcd_barrier(xbar);
    row_pass(p, (const u16*)(p.ws + WS_YOUT), l == 0 ? p.in[I_X] : p.out, p.in[I_NG] + (size_t)(l * 4 + 1) * DM, false);
    xcd_barrier(xbar);
    if (PHM & 4096) phase_gemm_plain<1>(p, lds, (const u16*)(p.ws + WS_HB), 1024, W + W_1 / 2, 1024, 4096, (u16*)(p.ws + WS_FF1), 4096, meta_live);
    xcd_barrier(xbar);
    if (PHM & 8192) phase_gemm_plain<0>(p, lds, (const u16*)(p.ws + WS_FF1), 4096, W + W_2 / 2, 4096, 1024, (u16*)(p.ws + WS_MERGED), 1024, meta_live);
    xcd_barrier(xbar);
    row_pass(p, (const u16*)(p.ws + WS_MERGED), p.out, p.in[I_NG] + (size_t)(l * 4 + 3) * DM, l == 1);
    if ((PHM & 1) && l == 0) prep_layer(p, 1, (float*)lds);
    xcd_barrier(xbar);
  }
}

#undef p
extern "C" void kernel_launch(void* const* d_in, const int* in_sizes, int n_in, void* d_out, int out_size, void* d_ws, size_t ws_size, hipStream_t stream) {
  static int grid = 0;
  if (grid == 0) {
    if (ws_size < WS_END) { fprintf(stderr, "workspace too small: %zu < %zu\n", ws_size, (size_t)WS_END); grid = -1; return; }
    int dev = 0, cus = 0, per_cu = 0;
    (void)hipGetDevice(&dev);
    (void)hipDeviceGetAttribute(&cus, hipDeviceAttributeMultiprocessorCount, dev);
    (void)hipFuncSetAttribute((const void*)mega, hipFuncAttributeMaxDynamicSharedMemorySize, LDS_BYTES);
    (void)hipOccupancyMaxActiveBlocksPerMultiprocessor(&per_cu, (const void*)mega, 512, LDS_BYTES);
    if (per_cu < 1) per_cu = 1;
    grid = cus * 1;
    (void)hipGetLastError();
  }
  if (grid < 0) return;
  (void)hipMemsetAsync((char*)d_ws + WS_CTL, 0, 32768, stream);
  Params p{};
  for (int i = 0; i < 24; ++i) p.in[i] = (const float*)d_in[i];
  p.out = (float*)d_out; p.ws = (unsigned char*)d_ws;
  void* args[] = {&p};
  hipError_t e = hipLaunchCooperativeKernel((const void*)mega, dim3(grid), dim3(512), args, LDS_BYTES, stream);
  if (e != hipSuccess) fprintf(stderr, "cooperative launch failed: %s (grid %d)\n", hipGetErrorString(e), grid);
}
```
